# Optimizing an MI355X kernel written in HIP

```python
import math
import jax, jax.numpy as jnp
from jax import lax
import numpy as np

D_MODEL = 1024
BATCH = 8
SEQ = 2048
DEPTH = 1
DEC_BATCH = 128
DEC_SEQ = 4
PAST_LEN = 16384
PAGE_SIZE = 128

H_A = 4
DK_A = 128
DV_A = 128
QK_A = H_A * DK_A
VW_A = H_A * DV_A
QKV_W = 2 * QK_A + VW_A
CONV_A = 4
CHUNK_A = 64
H_B = 4
E_B = 128
DV_B = 128
HE_B = H_B * E_B
VW_B = H_B * DV_B
CHUNK_B = 32
D_FF = 2816
CONV_F = 3
EPS = 1e-6

IN_SPLITS = (QK_A, QK_A, VW_A, H_A, H_A, VW_A, HE_B, HE_B, VW_B, VW_B, D_MODEL, D_MODEL)
N_IN = sum(IN_SPLITS)

kernel_name = "gdn_hgrn2_convffn_hybrid_step"


def _rmsnorm(x, g):
    xf = x.astype(jnp.float32)
    y = xf * lax.rsqrt(jnp.mean(xf * xf, axis=-1, keepdims=True) + EPS) * g.astype(jnp.float32)
    return y.astype(x.dtype)


def _head_rmsnorm(o, g):
    return o * lax.rsqrt(jnp.mean(o * o, axis=-1, keepdims=True) + EPS) * g.astype(jnp.float32)


def _l2norm(x):
    return x * lax.rsqrt(jnp.sum(x * x, axis=-1, keepdims=True) + EPS)


def _causal_conv(x, buf, w):
    width = w.shape[0]
    L = x.shape[1]
    xp = jnp.concatenate([buf.astype(x.dtype), x], axis=1)
    y = xp[:, 0:L] * w[0]
    for j in range(1, width):
        y = y + xp[:, j:j + L] * w[j]
    return y, xp[:, xp.shape[1] - (width - 1):]


def _to_chunks(t, C):
    B, L, H, D = t.shape
    return t.reshape(B, L // C, C, H, D).transpose(1, 0, 3, 2, 4)


def _from_chunks(t):
    n, B, H, C, D = t.shape
    return t.transpose(1, 0, 3, 2, 4).reshape(B, n * C, H, D)


def _gated_delta(q, k, v, beta, g, S0):
    L = q.shape[1]
    C = math.gcd(L, CHUNK_A)
    q, k, v = _to_chunks(q, C), _to_chunks(k, C), _to_chunks(v, C)
    beta = _to_chunks(beta[..., None], C)[..., 0]
    G = jnp.cumsum(_to_chunks(g[..., None], C)[..., 0], axis=-1)
    idx = jnp.arange(C)
    causal = idx[:, None] >= idx[None, :]
    strict = idx[:, None] > idx[None, :]
    decay = jnp.exp(jnp.where(causal, G[..., :, None] - G[..., None, :], -jnp.inf))
    kb = k * beta[..., None]
    lmat = jnp.where(strict, jnp.einsum('nbhid,nbhjd->nbhij', kb, k) * decay, 0.0)
    eye = jnp.eye(C, dtype=q.dtype)
    a_mat = eye + lmat
    T = lax.linalg.triangular_solve(a_mat, jnp.broadcast_to(eye, a_mat.shape), left_side=True, lower=True)
    value = jnp.einsum('nbhij,nbhje->nbhie', T, v * beta[..., None])
    kcd = jnp.einsum('nbhij,nbhjd->nbhid', T, kb * jnp.exp(G)[..., None])
    attn = jnp.einsum('nbhid,nbhjd->nbhij', q, k) * decay
    G_last = G[..., -1]
    qg = q * jnp.exp(G)[..., None]
    kg = k * jnp.exp(G_last[..., None] - G)[..., None]

    def step(S, xs):
        value_n, kcd_n, attn_n, qg_n, kg_n, gl_n = xs
        u = value_n - jnp.einsum('bhcd,bhde->bhce', kcd_n, S)
        o = jnp.einsum('bhcd,bhde->bhce', qg_n, S) + jnp.einsum('bhij,bhje->bhie', attn_n, u)
        S = S * jnp.exp(gl_n)[..., None, None] + jnp.einsum('bhcd,bhce->bhde', kg_n, u)
        return S, o

    S, o = lax.scan(step, S0, (value, kcd, attn, qg, kg, G_last))
    return _from_chunks(o), S


def _hgrn2(q, k, v, logf, S0):
    L = q.shape[1]
    C = math.gcd(L, CHUNK_B)
    q, k, v = _to_chunks(q, C), _to_chunks(k, C), _to_chunks(v, C)
    Bc = jnp.cumsum(_to_chunks(logf, C), axis=-2)
    Bl = Bc[..., -1, :]
    qg = q * jnp.exp(Bc)
    kg = k * jnp.exp(Bl[..., None, :] - Bc)
    idx = jnp.arange(C)
    causal = (idx[:, None] >= idx[None, :])[:, :, None]

    def step(S, xs):
        q_n, k_n, v_n, b_n, qg_n, kg_n, bl_n = xs
        dec = jnp.exp(jnp.where(causal, b_n[..., :, None, :] - b_n[..., None, :, :], -jnp.inf))
        attn = jnp.einsum('bhie,bhje,bhije->bhij', q_n, k_n, dec)
        o = jnp.einsum('bhce,bhev->bhcv', qg_n, S) + jnp.einsum('bhij,bhjv->bhiv', attn, v_n)
        S = S * jnp.exp(bl_n)[..., None] + jnp.einsum('bhce,bhcv->bhev', kg_n, v_n)
        return S, o

    S, o = lax.scan(step, S0, (q, k, v, Bc, qg, kg, Bl))
    return _from_chunks(o), S


def _layer(x, conv_buf, s_delta, s_hgrn, ffn_buf, lb, g_attn, w_in, w_conv_a, a_log, dt_bias,
           g_out_a, w_branch_a, g_out_b, w_branch_b, w_out, g_ffn, w_ffn_gate, w_ffn_up,
           w_ffn_conv, w_ffn_down):
    f32 = jnp.float32
    dt = x.dtype
    B, L, _ = x.shape
    h = _rmsnorm(x, g_attn)
    z = h @ w_in
    offs = np.cumsum(IN_SPLITS)[:-1].tolist()
    qa, ka, va, aa, ba, oga, qb, fb, ib, ogb, gate_a, gate_b = jnp.split(z, offs, axis=-1)

    qkv, new_conv = _causal_conv(jnp.concatenate([qa, ka, va], axis=-1), conv_buf, w_conv_a)
    qkv = jax.nn.silu(qkv.astype(f32))
    q = qkv[..., :QK_A].reshape(B, L, H_A, DK_A)
    k = qkv[..., QK_A:2 * QK_A].reshape(B, L, H_A, DK_A)
    v = qkv[..., 2 * QK_A:].reshape(B, L, H_A, DV_A)
    q = _l2norm(q) * (DK_A ** -0.5)
    k = _l2norm(k)
    beta = jax.nn.sigmoid(ba.astype(f32))
    g = -jnp.exp(a_log.astype(f32)) * jax.nn.softplus(aa.astype(f32) + dt_bias.astype(f32))
    o_a, s_delta_new = _gated_delta(q, k, v, beta, g, s_delta.astype(f32))
    o_a = _head_rmsnorm(o_a, g_out_a) * jax.nn.silu(oga.astype(f32).reshape(B, L, H_A, DV_A))
    y_a = o_a.reshape(B, L, VW_A).astype(dt) @ w_branch_a

    qh = jax.nn.silu(qb.astype(f32)).reshape(B, L, H_B, E_B)
    f = lb + (1.0 - lb) * jax.nn.sigmoid(fb.astype(f32).reshape(B, L, H_B, E_B))
    o_b, s_hgrn_new = _hgrn2(qh, 1.0 - f, ib.astype(f32).reshape(B, L, H_B, DV_B), jnp.log(f), s_hgrn.astype(f32))
    o_b = _head_rmsnorm(o_b, g_out_b) * jax.nn.silu(ogb.astype(f32).reshape(B, L, H_B, DV_B))
    y_b = o_b.reshape(B, L, VW_B).astype(dt) @ w_branch_b

    mix = jax.nn.sigmoid(gate_a) * y_a + jax.nn.sigmoid(gate_b) * y_b
    x = x + (mix @ w_out).astype(dt)

    h2 = _rmsnorm(x, g_ffn)
    gc, new_ffn = _causal_conv(h2 @ w_ffn_gate, ffn_buf, w_ffn_conv)
    x = x + ((jax.nn.silu(gc) * (h2 @ w_ffn_up)) @ w_ffn_down).astype(dt)
    return x, new_conv, s_delta_new, s_hgrn_new, new_ffn


def setup_inputs(seed: int = 0) -> dict:
    key = jax.random.key(seed)
    ks = jax.random.split(key, 24)
    f32 = jnp.float32

    def nrm(k, shape, scale):
        return jax.random.normal(k, shape, f32) * scale

    dt_init = jnp.exp(jax.random.uniform(ks[10], (DEPTH, H_A), f32, math.log(1e-3), math.log(1e-1)))
    return {
        "x_prompt": nrm(ks[0], (BATCH, SEQ, D_MODEL), 1.0),
        "x_sample": nrm(ks[1], (DEC_BATCH, DEC_SEQ, D_MODEL), 1.0),
        "cache_conv_qkv": nrm(ks[2], (DEPTH, DEC_BATCH, CONV_A - 1, QKV_W), 1.0),
        "state_delta": nrm(ks[3], (DEPTH, DEC_BATCH, H_A, DK_A, DV_A), 0.05),
        "state_hgrn": nrm(ks[4], (DEPTH, DEC_BATCH, H_B, E_B, DV_B), 0.1),
        "cache_ffn_conv": nrm(ks[5], (DEPTH, DEC_BATCH, CONV_F - 1, D_FF), 1.0),
        "g_attn": 1.0 + nrm(ks[6], (DEPTH, D_MODEL), 0.02),
        "w_in": nrm(ks[7], (DEPTH, D_MODEL, N_IN), D_MODEL ** -0.5),
        "w_conv_a": nrm(ks[8], (DEPTH, CONV_A, QKV_W), CONV_A ** -0.5),
        "a_log": jnp.log(jax.random.uniform(ks[9], (DEPTH, H_A), f32, 1.0, 16.0)),
        "dt_bias": dt_init + jnp.log(-jnp.expm1(-dt_init)),
        "g_out_a": 1.0 + nrm(ks[11], (DEPTH, DV_A), 0.02),
        "w_branch_a": nrm(ks[12], (DEPTH, VW_A, D_MODEL), VW_A ** -0.5),
        "lb_logits": nrm(ks[13], (DEPTH + 1, HE_B), 0.5),
        "g_out_b": 1.0 + nrm(ks[14], (DEPTH, DV_B), 0.02),
        "w_branch_b": nrm(ks[15], (DEPTH, VW_B, D_MODEL), VW_B ** -0.5),
        "w_out": nrm(ks[16], (DEPTH, D_MODEL, D_MODEL), D_MODEL ** -0.5),
        "g_ffn": 1.0 + nrm(ks[17], (DEPTH, D_MODEL), 0.02),
        "w_ffn_gate": nrm(ks[18], (DEPTH, D_MODEL, D_FF), D_MODEL ** -0.5),
        "w_ffn_up": nrm(ks[19], (DEPTH, D_MODEL, D_FF), D_MODEL ** -0.5),
        "w_ffn_conv": nrm(ks[20], (DEPTH, CONV_F, D_FF), CONV_F ** -0.5),
        "w_ffn_down": nrm(ks[21], (DEPTH, D_FF, D_MODEL), D_FF ** -0.5),
        "g_final": 1.0 + nrm(ks[22], (D_MODEL,), 0.02),
    }


def reference(x_prompt, x_sample, cache_conv_qkv, state_delta, state_hgrn, cache_ffn_conv,
              g_attn, w_in, w_conv_a, a_log, dt_bias, g_out_a, w_branch_a, lb_logits,
              g_out_b, w_branch_b, w_out, g_ffn, w_ffn_gate, w_ffn_up, w_ffn_conv,
              w_ffn_down, g_final):
    f32 = jnp.float32
    lb_all = jnp.cumsum(jax.nn.softmax(lb_logits.astype(f32), axis=0), axis=0)
    xp, xs = x_prompt, x_sample
    Bp = x_prompt.shape[0]
    p_conv, p_delta, p_hgrn, p_ffn = [], [], [], []
    s_conv, s_delta, s_hgrn, s_ffn = [], [], [], []
    for l in range(DEPTH):
        lb = lb_all[l].reshape(H_B, E_B)
        lw = (g_attn[l], w_in[l], w_conv_a[l], a_log[l], dt_bias[l], g_out_a[l], w_branch_a[l],
              g_out_b[l], w_branch_b[l], w_out[l], g_ffn[l], w_ffn_gate[l], w_ffn_up[l],
              w_ffn_conv[l], w_ffn_down[l])
        xp, c1, d1, h1, f1 = _layer(
            xp, jnp.zeros((Bp, CONV_A - 1, QKV_W), xp.dtype), jnp.zeros((Bp, H_A, DK_A, DV_A), f32),
            jnp.zeros((Bp, H_B, E_B, DV_B), f32), jnp.zeros((Bp, CONV_F - 1, D_FF), xp.dtype), lb, *lw)
        xs, c2, d2, h2, f2 = _layer(
            xs, cache_conv_qkv[l], state_delta[l], state_hgrn[l], cache_ffn_conv[l], lb, *lw)
        p_conv.append(c1); p_delta.append(d1); p_hgrn.append(h1); p_ffn.append(f1)
        s_conv.append(c2); s_delta.append(d2); s_hgrn.append(h2); s_ffn.append(f2)
    y_prompt = _rmsnorm(xp, g_final)
    y_sample = _rmsnorm(xs, g_final)
    return (y_prompt, y_sample,
            jnp.stack(p_conv), jnp.stack(p_delta), jnp.stack(p_hgrn), jnp.stack(p_ffn),
            jnp.stack(s_conv), jnp.stack(s_delta), jnp.stack(s_hgrn), jnp.stack(s_ffn))
```

```cpp
#include <hip/hip_runtime.h>
#include <hip/hip_cooperative_groups.h>
#include <cstdio>
#include <cstdint>
namespace cg = cooperative_groups;

#ifndef MULTI_LAUNCH
#define MULTI_LAUNCH 0
#endif

typedef unsigned short u16;
typedef __attribute__((ext_vector_type(8))) short bf16x8;
typedef __attribute__((ext_vector_type(4))) float f32x4;

constexpr int TP = 16384, TS = 512, TT = TP + TS;
constexpr int DM = 1024, NIN = 6152, DFF = 2816;
constexpr float EPS = 1e-6f;
constexpr int NTHR = 256;
#define VTID (threadIdx.x & 255)
constexpr int SMEM_HALF = 77824;
constexpr int SMEM_BYTES = 2 * SMEM_HALF + 16;

constexpr size_t O_YP = 0;
constexpr size_t O_YS = O_YP + (size_t)TP * DM;
constexpr size_t O_CONVP = O_YS + (size_t)TS * DM;
constexpr size_t O_DELTAP = O_CONVP + 8 * 3 * 1536;
constexpr size_t O_HGRNP = O_DELTAP + 8 * 4 * 128 * 128;
constexpr size_t O_FFNP = O_HGRNP + 8 * 4 * 128 * 128;
constexpr size_t O_CONVS = O_FFNP + 8 * 2 * DFF;
constexpr size_t O_DELTAS = O_CONVS + 128 * 3 * 1536;
constexpr size_t O_HGRNS = O_DELTAS + (size_t)128 * 4 * 128 * 128;
constexpr size_t O_FFNS = O_HGRNS + (size_t)128 * 4 * 128 * 128;

constexpr size_t al(size_t x) { return (x + 255) & ~(size_t)255; }
constexpr size_t W_MAIN = 0;
constexpr size_t W_G2 = W_MAIN + (size_t)3072 * 1024 * 2;
constexpr size_t W_A = W_G2 + (size_t)3072 * 1024 * 2;
constexpr size_t W_B = W_A + (size_t)1024 * 512 * 2;
constexpr size_t W_OUT = W_B + (size_t)1024 * 512 * 2;
constexpr size_t SM_GDEC = W_OUT + (size_t)1024 * 1024 * 2;
constexpr size_t SM_BETA = al(SM_GDEC + (size_t)TT * 16);
constexpr size_t SM_ROWSS = al(SM_BETA + (size_t)TT * 16);
constexpr size_t Z1 = al(SM_ROWSS + (size_t)TT * 4);
constexpr size_t Z1_SIZE = (size_t)TT * 3072 * 2;
constexpr size_t RB = al(Z1 + Z1_SIZE);
constexpr size_t D_QF = RB;
constexpr size_t D_KCD = D_QF + (size_t)1024 * 16384;
constexpr size_t D_KNT = D_KCD + (size_t)1024 * 16384;
constexpr size_t D_VALT = D_KNT + (size_t)1024 * 16384;
constexpr size_t D_ATT = D_VALT + (size_t)1024 * 16384;
constexpr size_t D_GC = D_ATT + (size_t)1024 * 8192;
constexpr size_t H_QG = D_GC + (size_t)1024 * 256;
constexpr size_t H_KGT = H_QG + (size_t)2048 * 8192;
constexpr size_t H_VT = H_KGT + (size_t)2048 * 8192;
constexpr size_t H_ATT = H_VT + (size_t)2048 * 8192;
constexpr size_t H_EBL = H_ATT + (size_t)2048 * 2048;
constexpr size_t RB_END1 = H_EBL + (size_t)2048 * 512;
constexpr size_t Z2 = RB;
constexpr size_t X1B = RB;
constexpr size_t ACT = RB + (size_t)TT * 1024 * 2;
constexpr size_t RB_END2 = ACT + (size_t)TT * DFF * 2;
constexpr size_t WS_NEED = (RB_END1 > RB_END2 ? RB_END1 : RB_END2);
constexpr size_t BAR_OFF = al(WS_NEED);
constexpr size_t Z2S = BAR_OFF + 16384;
static_assert(Z2S + (size_t)TS * 3072 * 2 <= (size_t)268435456, "workspace too large");
constexpr size_t W_GU = Z1;
constexpr size_t W_DOWN = W_GU + (size_t)5632 * 1024 * 2;
constexpr size_t MIX = W_DOWN + (size_t)1024 * DFF * 2;
constexpr size_t HALO_G = MIX + (size_t)TT * 1024 * 2;
constexpr size_t HEAD_G = HALO_G + (size_t)264 * 2 * DFF * 4;
constexpr size_t HEAD_U = HEAD_G + (size_t)264 * 2 * DFF * 4;
constexpr size_t PART = HEAD_U + (size_t)264 * 2 * DFF * 4;
static_assert(PART + (size_t)11 * TS * 1024 * 4 <= Z1 + Z1_SIZE, "z1 reuse overflow");
constexpr size_t YB_H = 0;
constexpr size_t YB_OA = (size_t)TT * 1024 * 2;
constexpr size_t YB_OB = YB_OA + (size_t)TT * 512 * 2;

struct Params {
  const float *x_prompt, *x_sample, *cache_conv, *state_delta, *state_hgrn, *cache_ffn;
  const float *g_attn, *w_in, *w_conv_a, *a_log, *dt_bias, *g_out_a, *w_branch_a, *lb_logits, *g_out_b,
      *w_branch_b, *w_out, *g_ffn, *w_ffn_gate, *w_ffn_up, *w_ffn_conv, *w_ffn_down, *g_final;
  float* out;
  char* ws;
};

__device__ __forceinline__ const unsigned short* z2row(const Params& p, int row) {
  return row < TP ? reinterpret_cast<const unsigned short*>(p.ws + Z2) + (size_t)row * 3072
                  : reinterpret_cast<const unsigned short*>(p.ws + Z2S) + (size_t)(row - TP) * 3072;
}
__device__ __forceinline__ u16 f2bf(float f) {
  unsigned u = __float_as_uint(f);
  u += 0x7fffu + ((u >> 16) & 1u);
  return (u16)(u >> 16);
}
__device__ __forceinline__ float bf2f(u16 h) { return __uint_as_float(((unsigned)h) << 16); }
__device__ __forceinline__ unsigned pack2(float a, float b) { return (unsigned)f2bf(a) | ((unsigned)f2bf(b) << 16); }
__device__ __forceinline__ float lo2f(unsigned u) { return __uint_as_float(u << 16); }
__device__ __forceinline__ float hi2f(unsigned u) { return __uint_as_float(u & 0xffff0000u); }
__device__ __forceinline__ float silu_f(float x) { return x / (1.f + __expf(-x)); }
__device__ __forceinline__ float sigmoid_f(float x) { return 1.f / (1.f + __expf(-x)); }
__device__ __forceinline__ float wave_sum(float v) {
#pragma unroll
  for (int o = 32; o >= 1; o >>= 1) v += __shfl_xor(v, o, 64);
  return v;
}
__device__ __forceinline__ void lds_barrier() {
  __builtin_amdgcn_fence(__ATOMIC_RELEASE, "workgroup", "local");
  __builtin_amdgcn_s_barrier();
  __builtin_amdgcn_fence(__ATOMIC_ACQUIRE, "workgroup", "local");
}
__device__ __forceinline__ f32x4 mfma16(bf16x8 a, bf16x8 b, f32x4 c) {
  return __builtin_amdgcn_mfma_f32_16x16x32_bf16(a, b, c, 0, 0, 0);
}
__device__ __forceinline__ bf16x8 lds_frag(const u16* base, int ld, int row0, int k0, int lane) {
  return *reinterpret_cast<const bf16x8*>(base + (row0 + (lane & 15)) * ld + k0 + 8 * (lane >> 4));
}
__device__ __forceinline__ void store_frags(const u16* lds, int ld, int R, int K, u16* dst, int t, int nt) {
  const int nkb = K >> 5, total = (R >> 4) * nkb * 64;
  for (int idx = t; idx < total; idx += nt) {
    int f = idx >> 6, pl = idx & 63, rb = f / nkb, kb = f - rb * nkb;
    uint4 v = *reinterpret_cast<const uint4*>(lds + (rb * 16 + (pl & 15)) * ld + kb * 32 + 8 * (pl >> 4));
    *reinterpret_cast<uint4*>(dst + (size_t)idx * 8) = v;
  }
}
__device__ __forceinline__ void store_frags_T(const u16* lds, int ld, int R2, int K2, u16* dst, int t, int nt) {
  const int nkb = K2 >> 5, total = (R2 >> 4) * nkb * 64;
  for (int idx = t; idx < total; idx += nt) {
    int f = idx >> 6, pl = idx & 63, rb = f / nkb, kb = f - rb * nkb;
    int d = rb * 16 + (pl & 15), c0 = kb * 32 + 8 * (pl >> 4);
    unsigned r[4];
#pragma unroll
    for (int j = 0; j < 4; ++j) {
      unsigned a = lds[(c0 + 2 * j) * ld + d], b = lds[(c0 + 2 * j + 1) * ld + d];
      r[j] = a | (b << 16);
    }
    *reinterpret_cast<uint4*>(dst + (size_t)idx * 8) = make_uint4(r[0], r[1], r[2], r[3]);
  }
}

#define XB_TMO 128
#define XB_XCNT(j) (256 + 64 * (j))
#define XB_XSUB(j) (1280 + 64 * (j))
#define XB_XGEN(j) (2304 + 64 * (j))
#define XB_TOP 3328
#define XB_TOPGEN 3392
#define XCD_BAR_WORDS 3456
#define XB_SPIN_CAP (1u << 18)
#define LAS __attribute__((address_space(3)))
__device__ __forceinline__ unsigned xb_ld(unsigned* p) { return __hip_atomic_load(p, __ATOMIC_RELAXED, __HIP_MEMORY_SCOPE_AGENT); }
__device__ __forceinline__ unsigned xb_add(unsigned* p, unsigned v) { return __hip_atomic_fetch_add(p, v, __ATOMIC_RELAXED, __HIP_MEMORY_SCOPE_AGENT); }
__device__ __forceinline__ unsigned xb_xcc_id() { return (unsigned)__builtin_amdgcn_s_getreg((3 << 11) | 20) & 0xFu; }
#define XB_SPIN(cond, bar) do { unsigned _sp = 0; while (cond) { __builtin_amdgcn_s_sleep(1); \
    if ((++_sp & 255u) == 0u) { if (xb_ld(&(bar)[XB_TMO])) break; if (_sp > XB_SPIN_CAP) { atomicAdd(&(bar)[XB_TMO], 1u); break; } } } } while (0)
struct XcdBarrier { unsigned* bar; unsigned x; volatile LAS unsigned* st; };
__device__ __forceinline__ XcdBarrier xcd_barrier_post(unsigned* bar, volatile LAS unsigned* st) {
  XcdBarrier b; b.bar = bar; b.x = xb_xcc_id(); b.st = st;
  if (threadIdx.x == 0) (void)xb_add(&bar[XB_XCNT(b.x)], 1u);
  return b;
}
__device__ __forceinline__ void xcd_barrier_complete(unsigned* bar, unsigned x, unsigned& nloc, unsigned& nx) {
  const unsigned G = gridDim.x * gridDim.y * gridDim.z;
  unsigned sum, cnt, mine, sp = 0u;
  for (;;) {
    sum = 0u; cnt = 0u; mine = 0u;
#pragma unroll
    for (unsigned j = 0; j < 16; ++j) { const unsigned c = xb_ld(&bar[XB_XCNT(j)]); sum += c; cnt += (c > 0u) ? 1u : 0u; mine = (j == x) ? c : mine; }
    if (sum == G) break;
    __builtin_amdgcn_s_sleep(1);
    if ((++sp & 255u) == 0u) { if (xb_ld(&bar[XB_TMO])) break; if (sp > XB_SPIN_CAP) { atomicAdd(&bar[XB_TMO], 1u); break; } }
  }
  nloc = mine > 0u ? mine : 1u; nx = cnt > 0u ? cnt : 1u;
}
__device__ __forceinline__ void xcd_barrier(const XcdBarrier& b) {
  asm volatile("s_waitcnt vmcnt(0)" ::: "memory");
  __syncthreads();
  if (threadIdx.x == 0) {
    unsigned* bar = b.bar;
    __builtin_amdgcn_s_waitcnt(0);
    unsigned nloc = b.st[0], nx = b.st[1];
    if (nloc == 0u) { xcd_barrier_complete(bar, b.x, nloc, nx); b.st[0] = nloc; b.st[1] = nx; }
    const unsigned old = xb_add(&bar[XB_XSUB(b.x)], 1u);
    const unsigned gen = old / nloc;
    if (old + 1u == (gen + 1u) * nloc) {
      __builtin_amdgcn_fence(__ATOMIC_RELEASE, "agent");
      asm volatile("s_waitcnt vmcnt(0)" ::: "memory");
      const unsigned og = xb_add(&bar[XB_TOP], 1u);
      const unsigned tg = og / nx;
      if (og + 1u == (tg + 1u) * nx) xb_add(&bar[XB_TOPGEN], 1u);
      else XB_SPIN(xb_ld(&bar[XB_TOPGEN]) == tg, bar);
      __builtin_amdgcn_fence(__ATOMIC_ACQUIRE, "agent");
      xb_add(&bar[XB_XGEN(b.x)], 1u);
      asm volatile("s_waitcnt vmcnt(0)" ::: "memory");
    } else {
      XB_SPIN(xb_ld(&bar[XB_XGEN(b.x)]) == gen, bar);
      __builtin_amdgcn_fence(__ATOMIC_ACQUIRE, "agent");
      asm volatile("s_waitcnt vmcnt(0)" ::: "memory");
    }
  }
  __syncthreads();
}

__device__ __forceinline__ void wt_block(const float* __restrict__ src, int ld, int K, u16* __restrict__ dst, const float* __restrict__ kscale,
                         float* lds) {
  const int t = VTID;
  for (int k0 = 0; k0 < K; k0 += 64) {
    {
      int n = t & 31, kk = t >> 5;
#pragma unroll
      for (int i = 0; i < 8; ++i) {
        int k = kk + 8 * i;
        float v = src[(size_t)(k0 + k) * ld + n];
        if (kscale) v *= kscale[k0 + k];
        lds[k * 33 + n] = v;
      }
    }
    __syncthreads();
    {
      int kp = t & 31, nn = t >> 5;
#pragma unroll
      for (int i = 0; i < 4; ++i) {
        int n = nn + 8 * i;
        unsigned v = pack2(lds[(2 * kp) * 33 + n], lds[(2 * kp + 1) * 33 + n]);
        *reinterpret_cast<unsigned*>(dst + (size_t)n * K + k0 + 2 * kp) = v;
      }
    }
    __syncthreads();
  }
}

__device__ __forceinline__ void wt_chunk(const float* __restrict__ src, int ld, int K, u16* __restrict__ dst, const float* __restrict__ kscale, float* lds, int k0) {
  const int t = VTID;
  {
    const int n = t & 31, kk = t >> 5;
    float v[32];
#pragma unroll
    for (int i = 0; i < 32; ++i) v[i] = src[(size_t)(k0 + kk + 8 * i) * ld + n];
    if (kscale) {
#pragma unroll
      for (int i = 0; i < 32; ++i) v[i] *= kscale[k0 + kk + 8 * i];
    }
#pragma unroll
    for (int i = 0; i < 32; ++i) lds[(kk + 8 * i) * 33 + n] = v[i];
  }
  __syncthreads();
  {
    const int kp = t & 127, nn = t >> 7;
#pragma unroll
    for (int i = 0; i < 16; ++i) {
      const int n = nn + 2 * i;
      *reinterpret_cast<unsigned*>(dst + (size_t)n * K + k0 + 2 * kp) = pack2(lds[(2 * kp) * 33 + n], lds[(2 * kp + 1) * 33 + n]);
    }
  }
  __syncthreads();
}

__device__ __forceinline__ void phase_prep(const Params& p, char* smem, int bid, int nb) {
  float* wab = reinterpret_cast<float*>(smem);
  float* tl = reinterpret_cast<float*>(smem + 32768);
  const int t = VTID, lane = t & 63, w = t >> 6;
  for (int i = t; i < 8192; i += NTHR) wab[i] = p.w_in[(size_t)(i >> 3) * NIN + 1536 + (i & 7)];
  for (int i = bid * NTHR + t; i < TT; i += nb * NTHR) reinterpret_cast<float*>(p.ws + SM_ROWSS)[i] = 0.f;
  __syncthreads();
  const int NWT = 384 + 384 + 64 + 64 + 128;
  const int NROW = TT / 4;
  for (int item = bid; item < NWT + NROW; item += nb) {
    if (item < NWT) {
      if (item < 384) {
        int n = (item >> 2) * 32, k0 = (item & 3) * 256;
        int col = n < 1536 ? n : 2056 + (n - 1536);
        wt_chunk(p.w_in + col, NIN, 1024, reinterpret_cast<u16*>(p.ws + W_MAIN) + (size_t)n * 1024, nullptr, tl, k0);
      } else if (item < 768) {
        int n = ((item - 384) >> 2) * 32, k0 = (item & 3) * 256;
        int col = n < 2048 ? 4104 + n : (n < 2560 ? 1544 + (n - 2048) : 3592 + (n - 2560));
        wt_chunk(p.w_in + col, NIN, 1024, reinterpret_cast<u16*>(p.ws + W_G2) + (size_t)n * 1024, nullptr, tl, k0);
      } else if (item < 832) {
        int n = ((item - 768) >> 1) * 32, k0 = (item & 1) * 256;
        wt_chunk(p.w_branch_a + n, 1024, 512, reinterpret_cast<u16*>(p.ws + W_A) + (size_t)n * 512, nullptr, tl, k0);
      } else if (item < 896) {
        int n = ((item - 832) >> 1) * 32, k0 = (item & 1) * 256;
        wt_chunk(p.w_branch_b + n, 1024, 512, reinterpret_cast<u16*>(p.ws + W_B) + (size_t)n * 512, nullptr, tl, k0);
      } else {
        int n = ((item - 896) >> 2) * 32, k0 = (item & 3) * 256;
        wt_chunk(p.w_out + n, 1024, 1024, reinterpret_cast<u16*>(p.ws + W_OUT) + (size_t)n * 1024, nullptr, tl, k0);
      }
    } else {
      int row = (item - NWT) * 4 + w;
      const float* x = row < TP ? p.x_prompt + (size_t)row * DM : p.x_sample + (size_t)(row - TP) * DM;
      float4 xv[4];
      float ss = 0.f;
#pragma unroll
      for (int i = 0; i < 4; ++i) {
        xv[i] = *reinterpret_cast<const float4*>(x + i * 256 + lane * 4);
        ss += xv[i].x * xv[i].x + xv[i].y * xv[i].y + xv[i].z * xv[i].z + xv[i].w * xv[i].w;
      }
      ss = wave_sum(ss);
      float rstd = rsqrtf(ss * (1.f / DM) + EPS);
      float dot[8];
#pragma unroll
      for (int c = 0; c < 8; ++c) dot[c] = 0.f;
      u16* hrow = reinterpret_cast<u16*>(reinterpret_cast<char*>(p.out) + YB_H) + (size_t)row * DM;
#pragma unroll
      for (int i = 0; i < 4; ++i) {
        int k = i * 256 + lane * 4;
        float4 g = *reinterpret_cast<const float4*>(p.g_attn + k);
        float h0 = xv[i].x * rstd * g.x, h1 = xv[i].y * rstd * g.y, h2 = xv[i].z * rstd * g.z, h3 = xv[i].w * rstd * g.w;
        *reinterpret_cast<uint2*>(hrow + k) = make_uint2(pack2(h0, h1), pack2(h2, h3));
        float hh[4] = {h0, h1, h2, h3};
#pragma unroll
        for (int j = 0; j < 4; ++j) {
          float4 wa = *reinterpret_cast<const float4*>(wab + (k + j) * 8);
          float4 wb = *reinterpret_cast<const float4*>(wab + (k + j) * 8 + 4);
          dot[0] += hh[j] * wa.x; dot[1] += hh[j] * wa.y; dot[2] += hh[j] * wa.z; dot[3] += hh[j] * wa.w;
          dot[4] += hh[j] * wb.x; dot[5] += hh[j] * wb.y; dot[6] += hh[j] * wb.z; dot[7] += hh[j] * wb.w;
        }
      }
#pragma unroll
      for (int c = 0; c < 8; ++c) dot[c] = wave_sum(dot[c]);
      if (lane < 4) {
        float aa = lane == 0 ? dot[0] : lane == 1 ? dot[1] : lane == 2 ? dot[2] : dot[3];
        float xx = aa + p.dt_bias[lane];
        float sp = xx > 20.f ? xx : log1pf(__expf(xx));
        reinterpret_cast<float*>(p.ws + SM_GDEC)[(size_t)row * 4 + lane] = -__expf(p.a_log[lane]) * sp;
      } else if (lane < 8) {
        float ba = lane == 4 ? dot[4] : lane == 5 ? dot[5] : lane == 6 ? dot[6] : dot[7];
        reinterpret_cast<float*>(p.ws + SM_BETA)[(size_t)row * 4 + lane - 4] = sigmoid_f(ba);
      }
    }
  }
}

enum { EPI_Z1 = 0, EPI_Z2 = 1, EPI_MIXA = 2, EPI_MIXB = 3, EPI_WOUT = 4, EPI_FFN1 = 5, EPI_FFN2 = 6, EPI_FFN2S = 7 };
namespace pg8 {
constexpr int BM = 256, BK = 64, HALF = 128, HTB = HALF * BK * 2, STAGE_BYTES = 8 * HTB, NXCD = 8, WGM = 8;
__device__ __forceinline__ int lds_byte(int r, int c) { const int st = (r >> 4) * 2 + (c >> 5), rr = r & 15, cc = c & 31, ob = rr * 64 + cc * 2; return st * 1024 + (ob ^ (((ob >> 9) & 1) << 5)); }
__device__ __forceinline__ void stage_rc(int b, int& R, int& C) { const int st = b / 1024, sb = b % 1024, swz = sb ^ (((sb >> 9) & 1) << 5); R = (st >> 1) * 16 + swz / 64; C = (st & 1) * 32 + (swz % 64) / 2; }
__device__ __forceinline__ int perm32(int rho) { const int n = rho >> 4, i = rho & 15; return 8 * (i >> 2) + 4 * n + (i & 3); }
struct Unit { int pm, pn, ks; };
struct StaticOrder {
  int nM, nN, nwg, G, c;
  __device__ void init(int M, int N, int G_, int c_) { nM = M / BM; nN = N / BM; nwg = nM * nN; G = G_; c = c_; }
  __device__ bool next(int i, Unit& u) const {
    const long L = (long)i * G + c; if (L >= nwg) return false;
    int wgid = (int)L; { const int q = nwg / NXCD, r = nwg % NXCD, xcd = wgid % NXCD, off = wgid / NXCD; wgid = (xcd < r ? xcd * (q + 1) : r * (q + 1) + (xcd - r) * q) + off; }
    const int nig = WGM * nN, gid = wgid / nig, fm = gid * WGM, gsz = (nM - fm) < WGM ? (nM - fm) : WGM;
    u.pm = fm + ((wgid % nig) % gsz); u.pn = (wgid % nig) / gsz; return true;
  }
};
struct SchedStatic {
  StaticOrder S; int pm0;
  __device__ void init(int M, int N, int G, int c, int pm0_) { S.init(M, N, G, c); pm0 = pm0_; }
  __device__ bool next(int i, Unit& u) const { if (S.c >= S.G || !S.next(i, u)) return false; u.pm += pm0; u.ks = 0; return true; }
};
struct SchedSplit {
  int nN, nS, pm0, G, c, total;
  __device__ void init(int nM, int nN_, int nS_, int G_, int c_, int pm0_) { nN = nN_; nS = nS_; pm0 = pm0_; G = G_; c = c_; total = nM * nN_ * nS_; }
  __device__ bool next(int i, Unit& u) const {
    const int L = i * G + c; if (c >= G || L >= total) return false;
    u.ks = L % nS; const int t = L / nS; u.pn = t % nN; u.pm = pm0 + t / nN; return true;
  }
};
}

__device__ __forceinline__ float dpp_ror1(float v) { return __int_as_float(__builtin_amdgcn_update_dpp(0, __float_as_int(v), 0x121, 0xf, 0xf, false)); }
__device__ __forceinline__ float dpp_ror2(float v) { return __int_as_float(__builtin_amdgcn_update_dpp(0, __float_as_int(v), 0x122, 0xf, 0xf, false)); }

template <int MODE>
__device__ __forceinline__ void gemm_epilogue(const Params& p, f32x4 (&acc)[2][2][4][2], const pg8::Unit& u, int wr, int wc, int fr, int fq) {
  const int row0 = u.pm * 256 + wr * 64 + fr, col0 = u.pn * 256 + wc * 32 + 8 * fq;
  if constexpr (MODE == EPI_Z1 || MODE == EPI_Z2) {
#pragma unroll
    for (int ai = 0; ai < 2; ++ai)
#pragma unroll
      for (int m = 0; m < 4; ++m) {
        const int row = row0 + ai * 128 + m * 16;
        u16* rowp = (MODE == EPI_Z1 ? reinterpret_cast<u16*>(p.ws + Z1) + (size_t)row * 3072 : const_cast<u16*>(z2row(p, row))) + col0;
#pragma unroll
        for (int bj = 0; bj < 2; ++bj) {
          const f32x4 v0 = acc[ai][bj][m][0], v1 = acc[ai][bj][m][1];
          *reinterpret_cast<uint4*>(rowp + bj * 128) = make_uint4(pack2(v0[0], v0[1]), pack2(v0[2], v0[3]), pack2(v1[0], v1[1]), pack2(v1[2], v1[3]));
        }
        if (MODE == EPI_Z1 && u.pn < 6) {
          float* dst = nullptr;
          if (row < TP) {
            int pos = row & 2047;
            if (pos >= 2045) dst = p.out + O_CONVP + (size_t)((row >> 11) * 3 + pos - 2045) * 1536 + col0;
          } else {
            int pos = (row - TP) & 3;
            if (pos >= 1) dst = p.out + O_CONVS + (size_t)(((row - TP) >> 2) * 3 + pos - 1) * 1536 + col0;
          }
          if (dst) {
#pragma unroll
            for (int bj = 0; bj < 2; ++bj) {
              const f32x4 v0 = acc[ai][bj][m][0], v1 = acc[ai][bj][m][1];
              *reinterpret_cast<float4*>(dst + bj * 128) = make_float4(v0[0], v0[1], v0[2], v0[3]);
              *reinterpret_cast<float4*>(dst + bj * 128 + 4) = make_float4(v1[0], v1[1], v1[2], v1[3]);
            }
          }
        }
      }
  } else if constexpr (MODE == EPI_MIXA || MODE == EPI_MIXB) {
    u16* Mx = reinterpret_cast<u16*>(p.ws + MIX);
#pragma unroll
    for (int ai = 0; ai < 2; ++ai)
#pragma unroll
      for (int m = 0; m < 4; ++m) {
        const int row = row0 + ai * 128 + m * 16;
#pragma unroll
        for (int bj = 0; bj < 2; ++bj) {
          const int col = col0 + bj * 128;
          const uint4 gv = *reinterpret_cast<const uint4*>(z2row(p, row) + (MODE == EPI_MIXB ? 1024 : 0) + col);
          u16* mp = Mx + (size_t)row * 1024 + col;
          const f32x4 v0 = acc[ai][bj][m][0], v1 = acc[ai][bj][m][1];
          float r0 = v0[0] * sigmoid_f(lo2f(gv.x)), r1 = v0[1] * sigmoid_f(hi2f(gv.x));
          float r2 = v0[2] * sigmoid_f(lo2f(gv.y)), r3 = v0[3] * sigmoid_f(hi2f(gv.y));
          float r4 = v1[0] * sigmoid_f(lo2f(gv.z)), r5 = v1[1] * sigmoid_f(hi2f(gv.z));
          float r6 = v1[2] * sigmoid_f(lo2f(gv.w)), r7 = v1[3] * sigmoid_f(hi2f(gv.w));
          if (MODE == EPI_MIXB) {
            const uint4 mv = *reinterpret_cast<const uint4*>(mp);
            r0 += lo2f(mv.x); r1 += hi2f(mv.x); r2 += lo2f(mv.y); r3 += hi2f(mv.y);
            r4 += lo2f(mv.z); r5 += hi2f(mv.z); r6 += lo2f(mv.w); r7 += hi2f(mv.w);
          }
          *reinterpret_cast<uint4*>(mp) = make_uint4(pack2(r0, r1), pack2(r2, r3), pack2(r4, r5), pack2(r6, r7));
        }
        asm volatile("" ::: "memory");
      }
  } else if constexpr (MODE == EPI_WOUT) {
    float* rowss = reinterpret_cast<float*>(p.ws + SM_ROWSS);
    u16* XB = reinterpret_cast<u16*>(p.ws + X1B);
#pragma unroll
    for (int ai = 0; ai < 2; ++ai)
#pragma unroll
      for (int m = 0; m < 4; ++m) {
        const int row = row0 + ai * 128 + m * 16;
        const float* x = (row < TP ? p.x_prompt + (size_t)row * DM : p.x_sample + (size_t)(row - TP) * DM) + col0;
        float* y = p.out + O_YP + (size_t)row * DM + col0;
        float ss = 0.f;
#pragma unroll
        for (int bj = 0; bj < 2; ++bj) {
          const float4 x0 = *reinterpret_cast<const float4*>(x + bj * 128), x1 = *reinterpret_cast<const float4*>(x + bj * 128 + 4);
          const f32x4 a0 = acc[ai][bj][m][0], a1 = acc[ai][bj][m][1];
          const float4 v0 = make_float4(a0[0] + x0.x, a0[1] + x0.y, a0[2] + x0.z, a0[3] + x0.w);
          const float4 v1 = make_float4(a1[0] + x1.x, a1[1] + x1.y, a1[2] + x1.z, a1[3] + x1.w);
          *reinterpret_cast<float4*>(y + bj * 128) = v0;
          *reinterpret_cast<float4*>(y + bj * 128 + 4) = v1;
          *reinterpret_cast<uint4*>(XB + (size_t)row * DM + col0 + bj * 128) =
              make_uint4(pack2(v0.x, v0.y), pack2(v0.z, v0.w), pack2(v1.x, v1.y), pack2(v1.z, v1.w));
          ss += v0.x * v0.x + v0.y * v0.y + v0.z * v0.z + v0.w * v0.w + v1.x * v1.x + v1.y * v1.y + v1.z * v1.z + v1.w * v1.w;
        }
        ss += __shfl_xor(ss, 16, 64);
        ss += __shfl_xor(ss, 32, 64);
        if (fq == 0) atomicAdd(rowss + row, ss);
        asm volatile("" ::: "memory");
      }
  } else if constexpr (MODE == EPI_FFN2) {
#pragma unroll
    for (int ai = 0; ai < 2; ++ai)
#pragma unroll
      for (int m = 0; m < 4; ++m) {
        float* y = p.out + O_YP + (size_t)(row0 + ai * 128 + m * 16) * DM + col0;
#pragma unroll
        for (int bj = 0; bj < 2; ++bj) {
          float4 y0 = *reinterpret_cast<const float4*>(y + bj * 128), y1 = *reinterpret_cast<const float4*>(y + bj * 128 + 4);
          const f32x4 a0 = acc[ai][bj][m][0], a1 = acc[ai][bj][m][1];
          y0.x += a0[0]; y0.y += a0[1]; y0.z += a0[2]; y0.w += a0[3];
          y1.x += a1[0]; y1.y += a1[1]; y1.z += a1[2]; y1.w += a1[3];
          *reinterpret_cast<float4*>(y + bj * 128) = y0;
          *reinterpret_cast<float4*>(y + bj * 128 + 4) = y1;
        }
        asm volatile("" ::: "memory");
      }
  } else if constexpr (MODE == EPI_FFN2S) {
    float* part = reinterpret_cast<float*>(p.ws + PART) + (size_t)u.ks * TS * 1024;
#pragma unroll
    for (int ai = 0; ai < 2; ++ai)
#pragma unroll
      for (int m = 0; m < 4; ++m) {
        float* y = part + (size_t)(row0 + ai * 128 + m * 16 - TP) * 1024 + col0;
#pragma unroll
        for (int bj = 0; bj < 2; ++bj) {
          const f32x4 a0 = acc[ai][bj][m][0], a1 = acc[ai][bj][m][1];
          *reinterpret_cast<float4*>(y + bj * 128) = make_float4(a0[0], a0[1], a0[2], a0[3]);
          *reinterpret_cast<float4*>(y + bj * 128 + 4) = make_float4(a1[0], a1[1], a1[2], a1[3]);
        }
      }
  } else if constexpr (MODE == EPI_FFN1) {
    const float* rowss = reinterpret_cast<const float*>(p.ws + SM_ROWSS);
    u16* ACTp = reinterpret_cast<u16*>(p.ws + ACT);
    float* haloG = reinterpret_cast<float*>(p.ws + HALO_G);
    float* headG = reinterpret_cast<float*>(p.ws + HEAD_G);
    float* headU = reinterpret_cast<float*>(p.ws + HEAD_U);
    const int ch = u.pn * 128 + wc * 32 + 8 * fq;
    float w0[8], w1[8], w2[8];
#pragma unroll
    for (int c = 0; c < 8; ++c) { w0[c] = p.w_ffn_conv[ch + c]; w1[c] = p.w_ffn_conv[DFF + ch + c]; w2[c] = p.w_ffn_conv[2 * DFF + ch + c]; }
#pragma unroll
    for (int ai = 0; ai < 2; ++ai) {
      const int blk = u.pm * 4 + ai * 2 + wr;
      float gprev[8];
#pragma unroll
      for (int c = 0; c < 8; ++c) gprev[c] = 0.f;
#pragma unroll
      for (int m = 0; m < 4; ++m) {
        const int row = row0 + ai * 128 + m * 16;
        const int r64 = m * 16 + fr;
        const float rs = rsqrtf(rowss[row] * (1.f / DM) + EPS);
        float g0[8], uu[8];
#pragma unroll
        for (int c = 0; c < 4; ++c) {
          g0[c] = acc[ai][0][m][0][c] * rs; g0[4 + c] = acc[ai][0][m][1][c] * rs;
          uu[c] = acc[ai][1][m][0][c] * rs; uu[4 + c] = acc[ai][1][m][1][c] * rs;
        }
        const bool prompt = row < TP;
        int pos, b;
        if (prompt) { pos = row & 2047; b = row >> 11; } else { pos = (row - TP) & 3; b = (row - TP) >> 2; }
        const bool defer = (pos >= 1 && r64 < 1) || (pos >= 2 && r64 < 2);
        float gm1[8], gm2[8];
#pragma unroll
        for (int c = 0; c < 8; ++c) {
          float a1 = dpp_ror1(g0[c]), b1 = dpp_ror1(gprev[c]);
          float a2 = dpp_ror2(g0[c]), b2 = dpp_ror2(gprev[c]);
          gm1[c] = fr >= 1 ? a1 : b1;
          gm2[c] = fr >= 2 ? a2 : b2;
        }
        if (pos < 1) {
#pragma unroll
          for (int c = 0; c < 8; ++c) gm1[c] = prompt ? 0.f : p.cache_ffn[(size_t)(b * 2 + 1) * DFF + ch + c];
        }
        if (pos < 2) {
#pragma unroll
          for (int c = 0; c < 8; ++c) gm2[c] = prompt ? 0.f : p.cache_ffn[(size_t)(b * 2 + pos) * DFF + ch + c];
        }
        if (r64 >= 62) {
          float* d = haloG + (size_t)(blk * 2 + r64 - 62) * DFF + ch;
          *reinterpret_cast<float4*>(d) = make_float4(g0[0], g0[1], g0[2], g0[3]);
          *reinterpret_cast<float4*>(d + 4) = make_float4(g0[4], g0[5], g0[6], g0[7]);
        }
        {
          float* d = nullptr;
          if (prompt) { if (pos >= 2046) d = p.out + O_FFNP + (size_t)(b * 2 + pos - 2046) * DFF + ch; }
          else { if (pos >= 2) d = p.out + O_FFNS + (size_t)(b * 2 + pos - 2) * DFF + ch; }
          if (d) {
            *reinterpret_cast<float4*>(d) = make_float4(g0[0], g0[1], g0[2], g0[3]);
            *reinterpret_cast<float4*>(d + 4) = make_float4(g0[4], g0[5], g0[6], g0[7]);
          }
        }
        if (defer) {
          float* dg = headG + (size_t)(blk * 2 + r64) * DFF + ch;
          float* du = headU + (size_t)(blk * 2 + r64) * DFF + ch;
          *reinterpret_cast<float4*>(dg) = make_float4(g0[0], g0[1], g0[2], g0[3]);
          *reinterpret_cast<float4*>(dg + 4) = make_float4(g0[4], g0[5], g0[6], g0[7]);
          *reinterpret_cast<float4*>(du) = make_float4(uu[0], uu[1], uu[2], uu[3]);
          *reinterpret_cast<float4*>(du + 4) = make_float4(uu[4], uu[5], uu[6], uu[7]);
        } else {
          float r[8];
#pragma unroll
          for (int c = 0; c < 8; ++c) r[c] = silu_f(w0[c] * gm2[c] + w1[c] * gm1[c] + w2[c] * g0[c]) * uu[c];
          *reinterpret_cast<uint4*>(ACTp + (size_t)row * DFF + ch) = make_uint4(pack2(r[0], r[1]), pack2(r[2], r[3]), pack2(r[4], r[5]), pack2(r[6], r[7]));
        }
#pragma unroll
        for (int c = 0; c < 8; ++c) gprev[c] = g0[c];
        asm volatile("" ::: "memory");
      }
    }
  }
}

template <int MODE, class Sched>
__device__ __forceinline__ void gemm_phase8(const Params& p, const u16* Ag, const u16* Btg, int ld, int Kunit, LAS unsigned char* lds, const Sched& S) {
  using namespace pg8;
  const int tid = threadIdx.x, wid = __builtin_amdgcn_readfirstlane(tid >> 6), lane = tid & 63, wr = wid >> 2, wc = wid & 3, fr = lane & 15, fq = lane >> 4;
  const int nt = Kunit / BK;
  unsigned voffA[2], voffB[2];
#pragma unroll
  for (int i = 0; i < 2; ++i) { int R, C; stage_rc(tid * 16 + i * 8192, R, C); const int Rb = (R & ~31) + perm32(R & 31);
    voffA[i] = (unsigned)(R * ld + C) * 2u; voffB[i] = (unsigned)(Rb * ld + C) * 2u; }
  const size_t kstep = (size_t)(BK * 2);
  const size_t hstep = (size_t)HALF * ld * 2;
  const size_t tstep = 2 * hstep;
  const size_t kub = (size_t)Kunit * 2;
  const unsigned ldsw = (unsigned)wid * 1024u;
  const int aoff = lds_byte(wr * 64 + fr, fq * 8), boff = lds_byte(wc * 32 + fr, fq * 8);
#define PG8_SA(b, h) (((b) * 2 + (h)) * HTB)
#define PG8_SB(b, h) ((4 + (b) * 2 + (h)) * HTB)
#define PG8_STAGE(bufoff, gbase, voff) do { _Pragma("unroll") for (int _i = 0; _i < 2; ++_i) \
    __builtin_amdgcn_global_load_lds((const unsigned*)((const char*)(gbase) + (voff)[_i]), (LAS unsigned*)(lds + (bufoff) + ldsw + _i * 8192), 16, 0, 0); } while (0)
#define PG8_LDA(dst, b, h) do { _Pragma("unroll") for (int m = 0; m < 4; ++m) _Pragma("unroll") for (int k = 0; k < 2; ++k) dst[m][k] = *(const LAS bf16x8*)(lds + PG8_SA(b, h) + aoff + m * 2048 + k * 1024); } while (0)
#define PG8_LDB(dst, b, h) do { _Pragma("unroll") for (int n = 0; n < 2; ++n) _Pragma("unroll") for (int k = 0; k < 2; ++k) dst[n][k] = *(const LAS bf16x8*)(lds + PG8_SB(b, h) + boff + n * 2048 + k * 1024); } while (0)
#define PG8_MMA(ai, bj, At, Bt) do { __builtin_amdgcn_s_setprio(1); _Pragma("unroll") for (int m = 0; m < 4; ++m) _Pragma("unroll") for (int n = 0; n < 2; ++n) _Pragma("unroll") for (int k = 0; k < 2; ++k) \
    acc[ai][bj][m][n] = __builtin_amdgcn_mfma_f32_16x16x32_bf16(Bt[n][k], At[m][k], acc[ai][bj][m][n], 0, 0, 0); __builtin_amdgcn_s_setprio(0); } while (0)
#define PG8_WAIT_V(n) asm volatile("s_waitcnt vmcnt(" #n ")" ::: "memory")
#define PG8_WAIT_L(n) asm volatile("s_waitcnt lgkmcnt(" #n ")" ::: "memory")
#define PG8_BAR __builtin_amdgcn_s_barrier()
#define PG8_SCHED __builtin_amdgcn_sched_barrier(0)
  Unit cur, nxt; int ui = 0;
  if (!S.next(0, cur)) return;
  f32x4 acc[2][2][4][2];
#pragma unroll
  for (int a = 0; a < 2; ++a)
#pragma unroll
    for (int b = 0; b < 2; ++b)
#pragma unroll
      for (int m = 0; m < 4; ++m)
#pragma unroll
        for (int n = 0; n < 2; ++n) acc[a][b][m][n] = (f32x4){0.f, 0.f, 0.f, 0.f};
  bf16x8 At[4][2], B0[2][2], B1[2][2];
  const char* cA = (const char*)Ag + (size_t)cur.pm * tstep + cur.ks * kub; const char* cB = (const char*)Btg + (size_t)cur.pn * tstep + cur.ks * kub;
  PG8_STAGE(PG8_SB(0, 0), cB, voffB); PG8_STAGE(PG8_SA(0, 0), cA, voffA); PG8_STAGE(PG8_SB(0, 1), cB + hstep, voffB); PG8_STAGE(PG8_SA(0, 1), cA + hstep, voffA);
  if (wr == 1) PG8_BAR;
  PG8_WAIT_V(4); PG8_BAR;
  PG8_STAGE(PG8_SB(1, 0), cB + kstep, voffB); PG8_STAGE(PG8_SA(1, 0), cA + kstep, voffA); PG8_STAGE(PG8_SB(1, 1), cB + hstep + kstep, voffB);
  PG8_WAIT_V(6); PG8_BAR;
  for (;;) {
    const bool has_next = S.next(ui + 1, nxt);
    const char* nA = has_next ? (const char*)Ag + (size_t)nxt.pm * tstep + nxt.ks * kub : cA; const char* nB = has_next ? (const char*)Btg + (size_t)nxt.pn * tstep + nxt.ks * kub : cB;
    for (int t = 0; t < nt; t += 2) {
      const bool last = (t == nt - 2);
      const char* a1 = cA + (size_t)(t + 1) * kstep;
      const char* a2 = last ? nA : cA + (size_t)(t + 2) * kstep; const char* b2 = last ? nB : cB + (size_t)(t + 2) * kstep;
      const char* a3 = a2 + kstep; const char* b3 = b2 + kstep;
      PG8_LDB(B0, 0, 0); PG8_SCHED; PG8_LDA(At, 0, 0); PG8_STAGE(PG8_SA(1, 1), a1 + hstep, voffA);
      PG8_WAIT_L(8); PG8_BAR; PG8_WAIT_L(0); PG8_MMA(0, 0, At, B0); PG8_BAR; PG8_SCHED;
      PG8_LDB(B1, 0, 1); PG8_STAGE(PG8_SB(0, 0), b2, voffB);
      PG8_BAR; PG8_WAIT_L(0); PG8_MMA(0, 1, At, B1); PG8_BAR;
      PG8_LDA(At, 0, 1); PG8_STAGE(PG8_SA(0, 0), a2, voffA);
      PG8_BAR; PG8_WAIT_L(0); PG8_MMA(1, 0, At, B0); PG8_BAR; PG8_SCHED;
      PG8_STAGE(PG8_SB(0, 1), b2 + hstep, voffB);
      PG8_WAIT_V(6); PG8_BAR; PG8_MMA(1, 1, At, B1); PG8_BAR;
      PG8_LDB(B0, 1, 0); PG8_SCHED; PG8_LDA(At, 1, 0); PG8_STAGE(PG8_SA(0, 1), a2 + hstep, voffA);
      PG8_WAIT_L(8); PG8_BAR; PG8_WAIT_L(0); PG8_MMA(0, 0, At, B0); PG8_BAR; PG8_SCHED;
      PG8_LDB(B1, 1, 1); PG8_STAGE(PG8_SB(1, 0), b3, voffB);
      PG8_BAR; PG8_WAIT_L(0); PG8_MMA(0, 1, At, B1); PG8_BAR;
      PG8_LDA(At, 1, 1); PG8_STAGE(PG8_SA(1, 0), a3, voffA);
      PG8_BAR; PG8_WAIT_L(0); PG8_MMA(1, 0, At, B0); PG8_BAR; PG8_SCHED;
      PG8_STAGE(PG8_SB(1, 1), b3 + hstep, voffB);
      PG8_WAIT_V(6); PG8_BAR; PG8_MMA(1, 1, At, B1); PG8_BAR;
    }
    gemm_epilogue<MODE>(p, acc, cur, wr, wc, fr, fq);
    if (!has_next) break;
#pragma unroll
    for (int a = 0; a < 2; ++a)
#pragma unroll
      for (int b = 0; b < 2; ++b)
#pragma unroll
        for (int m = 0; m < 4; ++m)
#pragma unroll
          for (int n = 0; n < 2; ++n) acc[a][b][m][n] = (f32x4){0.f, 0.f, 0.f, 0.f};
    cur = nxt; cA = nA; cB = nB; ++ui;
  }
  PG8_WAIT_V(0);
  if (wr == 0) PG8_BAR;
  PG8_BAR;
#undef PG8_SA
#undef PG8_SB
#undef PG8_STAGE
#undef PG8_LDA
#undef PG8_LDB
#undef PG8_MMA
#undef PG8_WAIT_V
#undef PG8_WAIT_L
#undef PG8_BAR
#undef PG8_SCHED
}


template <int PASS>
__device__ __forceinline__ void delta_rowpass(const Params& p, int t0, int n, int h, int w, int lane, float Gv, u16* RA, u16* RBk,
                                              u16* RC) {
  const u16* Zp = reinterpret_cast<const u16*>(p.ws + Z1);
  const float* betap = reinterpret_cast<const float*>(p.ws + SM_BETA);
  const int c1 = (PASS == 0 ? 0 : 512) + h * 128 + 2 * lane;
  const int c2 = (PASS == 0 ? 512 : 1024) + h * 128 + 2 * lane;
  float w1[4][2], w2[4][2];
#pragma unroll
  for (int j = 0; j < 4; ++j) {
    w1[j][0] = p.w_conv_a[j * 1536 + c1]; w1[j][1] = p.w_conv_a[j * 1536 + c1 + 1];
    w2[j][0] = p.w_conv_a[j * 1536 + c2]; w2[j][1] = p.w_conv_a[j * 1536 + c2 + 1];
  }
  const int r0 = 16 * w;
  const u16* zbase = Zp + (size_t)(t0 + r0) * 3072;
  float h1[3][2], h2[3][2];
#pragma unroll
  for (int j = 0; j < 3; ++j) {
    unsigned ua = 0u, ub = 0u;
    if (n * 64 + r0 + j - 3 >= 0) {
      ua = *reinterpret_cast<const unsigned*>(zbase + (ptrdiff_t)(j - 3) * 3072 + c1);
      ub = *reinterpret_cast<const unsigned*>(zbase + (ptrdiff_t)(j - 3) * 3072 + c2);
    }
    h1[j][0] = lo2f(ua); h1[j][1] = hi2f(ua); h2[j][0] = lo2f(ub); h2[j][1] = hi2f(ub);
  }
  unsigned qa0, qa1, qa2, qa3, qa4, qa5, qb0, qb1, qb2, qb3, qb4, qb5;
#define RLOAD(i, A_, B_) A_ = *reinterpret_cast<const unsigned*>(zbase + (size_t)(i) * 3072 + c1); B_ = *reinterpret_cast<const unsigned*>(zbase + (size_t)(i) * 3072 + c2);
  RLOAD(0, qa0, qb0) RLOAD(1, qa1, qb1) RLOAD(2, qa2, qb2) RLOAD(3, qa3, qb3) RLOAD(4, qa4, qb4) RLOAD(5, qa5, qb5)
#pragma unroll 1
  for (int rr = 0; rr < 16; ++rr) {
    const int r = r0 + rr;
    const unsigned ua = qa0, ub = qb0;
    qa0 = qa1; qa1 = qa2; qa2 = qa3; qa3 = qa4; qa4 = qa5;
    qb0 = qb1; qb1 = qb2; qb2 = qb3; qb3 = qb4; qb4 = qb5;
    if (rr + 6 < 16) { RLOAD(rr + 6, qa5, qb5) }
    const float a0 = lo2f(ua), a1 = hi2f(ua), b0 = lo2f(ub), b1 = hi2f(ub);
    float y10 = silu_f(w1[0][0] * h1[0][0] + w1[1][0] * h1[1][0] + w1[2][0] * h1[2][0] + w1[3][0] * a0);
    float y11 = silu_f(w1[0][1] * h1[0][1] + w1[1][1] * h1[1][1] + w1[2][1] * h1[2][1] + w1[3][1] * a1);
    float y20 = silu_f(w2[0][0] * h2[0][0] + w2[1][0] * h2[1][0] + w2[2][0] * h2[2][0] + w2[3][0] * b0);
    float y21 = silu_f(w2[0][1] * h2[0][1] + w2[1][1] * h2[1][1] + w2[2][1] * h2[2][1] + w2[3][1] * b1);
    const float bt = betap[(size_t)(t0 + r) * 4 + h];
    if (PASS == 0) {
      float qs = wave_sum(y10 * y10 + y11 * y11), ks = wave_sum(y20 * y20 + y21 * y21);
      float qn = rsqrtf(qs + EPS) * 0.08838834764831845f, kn = rsqrtf(ks + EPS);
      float k0 = y20 * kn, k1 = y21 * kn;
      *reinterpret_cast<unsigned*>(RA + r * 136 + 2 * lane) = pack2(k0, k1);
      *reinterpret_cast<unsigned*>(RBk + r * 136 + 2 * lane) = pack2(k0 * bt, k1 * bt);
      *reinterpret_cast<unsigned*>(RC + r * 136 + 2 * lane) = pack2(y10 * qn, y11 * qn);
    } else {
      float ks = wave_sum(y10 * y10 + y11 * y11);
      float sc = rsqrtf(ks + EPS) * bt * __expf(__shfl(Gv, r, 64));
      RA[(2 * lane) * 72 + r] = f2bf(y10 * sc);
      RA[(2 * lane + 1) * 72 + r] = f2bf(y11 * sc);
      RC[(2 * lane) * 72 + r] = f2bf(y20 * bt);
      RC[(2 * lane + 1) * 72 + r] = f2bf(y21 * bt);
    }
#pragma unroll
    for (int c = 0; c < 2; ++c) {
      h1[0][c] = h1[1][c]; h1[1][c] = h1[2][c];
      h2[0][c] = h2[1][c]; h2[1][c] = h2[2][c];
    }
    h1[2][0] = a0; h1[2][1] = a1; h2[2][0] = b0; h2[2][1] = b1;
  }
#undef RLOAD
}

__device__ __forceinline__ void m1_delta_item(const Params& p, int item, char* smem) {
  const int tid = VTID, lane = tid & 63, w = tid >> 6, lr = lane & 15, lq = lane >> 4;
  const int h = item & 3, n = (item >> 2) & 31, b = item >> 7;
  const int t0 = b * 2048 + n * 64;
  u16* RA = reinterpret_cast<u16*>(smem);
  u16* RBk = reinterpret_cast<u16*>(smem + 18432);
  u16* RC = reinterpret_cast<u16*>(smem + 36864);
  u16* RD = reinterpret_cast<u16*>(smem + 55296);
  float* Gs = reinterpret_cast<float*>(smem + 73728);
  const float* gdec = reinterpret_cast<const float*>(p.ws + SM_GDEC);

  float Gv = gdec[(size_t)(t0 + lane) * 4 + h];
#pragma unroll
  for (int o = 1; o < 64; o <<= 1) {
    float tv = __shfl_up(Gv, o, 64);
    if (lane >= o) Gv += tv;
  }
  if (w == 0) {
    Gs[lane] = Gv;
    reinterpret_cast<float*>(p.ws + D_GC)[(size_t)item * 64 + lane] = Gv;
  }
  delta_rowpass<0>(p, t0, n, h, w, lane, Gv, RA, RBk, RC);
  __syncthreads();
  {
    f32x4 accL[4], accA[4];
#pragma unroll
    for (int jb = 0; jb < 4; ++jb) { accL[jb] = (f32x4){0.f, 0.f, 0.f, 0.f}; accA[jb] = (f32x4){0.f, 0.f, 0.f, 0.f}; }
#pragma unroll
    for (int ks = 0; ks < 4; ++ks) {
      bf16x8 a1 = lds_frag(RBk, 136, 16 * w, ks * 32, lane);
      bf16x8 a2 = lds_frag(RC, 136, 16 * w, ks * 32, lane);
#pragma unroll
      for (int jb = 0; jb < 4; ++jb) {
        if (jb <= w) {
          bf16x8 bb = lds_frag(RA, 136, 16 * jb, ks * 32, lane);
          accL[jb] = mfma16(a1, bb, accL[jb]);
          accA[jb] = mfma16(a2, bb, accA[jb]);
        }
      }
    }
    __syncthreads();
    float* Lm = reinterpret_cast<float*>(RBk);
#pragma unroll
    for (int jb = 0; jb < 4; ++jb)
#pragma unroll
      for (int j = 0; j < 4; ++j) {
        int i = 16 * w + 4 * lq + j, jj = jb * 16 + lr;
        float dec = __expf(fminf(Gs[i] - Gs[jj], 0.f));
        float lv = (i > jj) ? accL[jb][j] * dec : 0.f;
        float av = (i >= jj) ? accA[jb][j] * dec : 0.f;
        Lm[i * 64 + jj] = lv;
        RD[i * 72 + jj] = f2bf(av);
      }
  }
  __syncthreads();
  store_frags(RC, 136, 64, 128, reinterpret_cast<u16*>(p.ws + D_QF) + (size_t)item * 8192, tid, NTHR);
  store_frags(RD, 72, 64, 64, reinterpret_cast<u16*>(p.ws + D_ATT) + (size_t)item * 4096, tid, NTHR);
  store_frags_T(RA, 136, 128, 64, reinterpret_cast<u16*>(p.ws + D_KNT) + (size_t)item * 8192, tid, NTHR);
  __syncthreads();
  {
    const float* Lm = reinterpret_cast<const float*>(RBk);
    float* Tm = reinterpret_cast<float*>(RA);
    float* Ms = reinterpret_cast<float*>(RC) + w * 256;
    {
      const int c = lane & 15, i0 = 16 * w;
      float tc[16];
#pragma unroll
      for (int r = 0; r < 16; ++r) {
        float a = (r == c) ? 1.f : 0.f;
#pragma unroll
        for (int k = 0; k < r; ++k) a -= Lm[(i0 + r) * 64 + i0 + k] * tc[k];
        tc[r] = a;
      }
      if (lane < 16) {
#pragma unroll
        for (int r = 0; r < 16; ++r) Tm[(i0 + r) * 64 + i0 + c] = tc[r];
      }
    }
    __syncthreads();
    {
      const int j = w;
      for (int i = j + 1; i < 4; ++i) {
        f32x4 macc = (f32x4){0.f, 0.f, 0.f, 0.f};
        for (int k = j; k < i; ++k) {
#pragma unroll
          for (int ks = 0; ks < 4; ++ks) {
            float av = Lm[(16 * i + lr) * 64 + 16 * k + 4 * ks + lq];
            float bv = Tm[(16 * k + 4 * ks + lq) * 64 + 16 * j + lr];
            macc = __builtin_amdgcn_mfma_f32_16x16x4f32(av, bv, macc, 0, 0, 0);
          }
        }
#pragma unroll
        for (int r = 0; r < 4; ++r) Ms[(4 * lq + r) * 16 + lr] = macc[r];
        __builtin_amdgcn_wave_barrier();
        f32x4 tacc = (f32x4){0.f, 0.f, 0.f, 0.f};
#pragma unroll
        for (int ks = 0; ks < 4; ++ks) {
          float av = Tm[(16 * i + lr) * 64 + 16 * i + 4 * ks + lq];
          float bv = Ms[(4 * ks + lq) * 16 + lr];
          tacc = __builtin_amdgcn_mfma_f32_16x16x4f32(av, bv, tacc, 0, 0, 0);
        }
#pragma unroll
        for (int r = 0; r < 4; ++r) Tm[(16 * i + 4 * lq + r) * 64 + 16 * j + lr] = -tacc[r];
        __builtin_amdgcn_wave_barrier();
      }
    }
    __syncthreads();
    {
      u16* Tb = RD + 64 * 72;
      for (int idx = tid; idx < 4096; idx += NTHR) {
        int r = idx >> 6, c = idx & 63;
        float v = ((c >> 4) <= (r >> 4)) ? Tm[idx] : 0.f;
        Tb[r * 72 + c] = f2bf(v);
      }
    }
    __syncthreads();
  }
  delta_rowpass<1>(p, t0, n, h, w, lane, Gv, RA, RBk, RC);
  __syncthreads();
  {
    const u16* Tm = RD + 64 * 72;
    bf16x8 tf[4][2];
#pragma unroll
    for (int cb = 0; cb < 4; ++cb)
#pragma unroll
      for (int ks = 0; ks < 2; ++ks) tf[cb][ks] = lds_frag(Tm, 72, cb * 16, ks * 32, lane);
    u16* valt = reinterpret_cast<u16*>(p.ws + D_VALT) + (size_t)item * 8192;
#pragma unroll
    for (int ee = 0; ee < 2; ++ee) {
      int eb = 2 * w + ee;
      bf16x8 a0 = lds_frag(RC, 72, eb * 16, 0, lane), a1 = lds_frag(RC, 72, eb * 16, 32, lane);
#pragma unroll
      for (int cb = 0; cb < 4; ++cb) {
        f32x4 c = (f32x4){0.f, 0.f, 0.f, 0.f};
        c = mfma16(a0, tf[cb][0], c);
        c = mfma16(a1, tf[cb][1], c);
        *reinterpret_cast<uint2*>(valt + ((size_t)(eb * 4 + cb) * 64 + lane) * 4) = make_uint2(pack2(c[0], c[1]), pack2(c[2], c[3]));
      }
    }
#pragma unroll
    for (int dd = 0; dd < 2; ++dd) {
      int db = 2 * w + dd;
      bf16x8 b0 = lds_frag(RA, 72, db * 16, 0, lane), b1 = lds_frag(RA, 72, db * 16, 32, lane);
#pragma unroll
      for (int cb = 0; cb < 4; ++cb) {
        f32x4 c = (f32x4){0.f, 0.f, 0.f, 0.f};
        c = mfma16(tf[cb][0], b0, c);
        c = mfma16(tf[cb][1], b1, c);
#pragma unroll
        for (int j = 0; j < 4; ++j) RBk[(cb * 16 + 4 * lq + j) * 136 + db * 16 + lr] = f2bf(c[j]);
      }
    }
  }
  __syncthreads();
  store_frags(RBk, 136, 64, 128, reinterpret_cast<u16*>(p.ws + D_KCD) + (size_t)item * 8192, tid, NTHR);
  __syncthreads();
}

__device__ __forceinline__ void m1_hgrn_item(const Params& p, int item, char* smem) {
  const int tid = VTID, lane = tid & 63, w = tid >> 6, lr = lane & 15, lq = lane >> 4;
  const int h = item & 3, n = (item >> 2) & 63, b = item >> 8;
  const int t0 = b * 2048 + n * 32;
  u16* QG = reinterpret_cast<u16*>(smem);
  u16* QR = reinterpret_cast<u16*>(smem + 8704);
  u16* KR = reinterpret_cast<u16*>(smem + 17408);
  u16* KGT = reinterpret_cast<u16*>(smem + 26112);
  u16* VT = reinterpret_cast<u16*>(smem + 36352);
  float* tot = reinterpret_cast<float*>(smem + 46592);
  float* bls = tot + 128;
  const u16* Zp = reinterpret_cast<const u16*>(p.ws + Z1);
  const int e = tid & 127, half = tid >> 7;
  const int he = h * 128 + e;
  const float lb = sigmoid_f(p.lb_logits[he] - p.lb_logits[512 + he]);
  float q[16], k[16], bc[16];
  float run = 0.f;
#pragma unroll
  for (int i = 0; i < 16; ++i) {
    const u16* zr = Zp + (size_t)(t0 + half * 16 + i) * 3072;
    float qb = bf2f(zr[1536 + he]), fb = bf2f(zr[2048 + he]);
    float f = lb + (1.f - lb) * sigmoid_f(fb);
    run += __logf(f);
    q[i] = silu_f(qb); k[i] = 1.f - f; bc[i] = run;
    VT[e * 40 + half * 16 + i] = zr[2560 + he];
  }
  if (half == 0) tot[e] = run;
  __syncthreads();
  const float bref = tot[e];
  if (half == 1) {
#pragma unroll
    for (int i = 0; i < 16; ++i) bc[i] += bref;
    bls[e] = bc[15];
  }
  __syncthreads();
  const float bl = bls[e];
  if (half == 0) reinterpret_cast<float*>(p.ws + H_EBL)[(size_t)item * 128 + e] = __expf(bl);
#pragma unroll
  for (int i = 0; i < 16; ++i) {
    int r = half * 16 + i;
    QG[r * 136 + e] = f2bf(q[i] * __expf(bc[i]));
    QR[r * 136 + e] = f2bf(q[i] * __expf(bc[i] - bref));
    KR[r * 136 + e] = f2bf(k[i] * __expf(bref - bc[i]));
    KGT[e * 40 + r] = f2bf(k[i] * __expf(bl - bc[i]));
  }
  __syncthreads();
  {
    const int ib = w >> 1, jb = w & 1;
    f32x4 c = (f32x4){0.f, 0.f, 0.f, 0.f};
    if (jb <= ib) {
#pragma unroll
      for (int ks = 0; ks < 4; ++ks) c = mfma16(lds_frag(QR, 136, ib * 16, ks * 32, lane), lds_frag(KR, 136, jb * 16, ks * 32, lane), c);
    }
    u16* att = reinterpret_cast<u16*>(p.ws + H_ATT) + (size_t)item * 1024;
#pragma unroll
    for (int j = 0; j < 4; ++j) {
      int i = ib * 16 + 4 * lq + j, jj = jb * 16 + lr;
      float v = (i >= jj) ? c[j] : 0.f;
      att[(ib * 64 + (i & 15) + 16 * (jj >> 3)) * 8 + (jj & 7)] = f2bf(v);
    }
  }
  store_frags(QG, 136, 32, 128, reinterpret_cast<u16*>(p.ws + H_QG) + (size_t)item * 4096, tid, NTHR);
  store_frags(KGT, 40, 128, 32, reinterpret_cast<u16*>(p.ws + H_KGT) + (size_t)item * 4096, tid, NTHR);
  store_frags(VT, 40, 128, 32, reinterpret_cast<u16*>(p.ws + H_VT) + (size_t)item * 4096, tid, NTHR);
  __syncthreads();
}

struct DPre {
  bf16x8 kcd[4], q[4], att[2], knt[2][2];
  uint2 val[2];
  float gc, gl;
  float4 gi;
};
__device__ __forceinline__ void m2d_loadA(const Params& p, int base, int es, int w, int lane, DPre& d) {
  const int lr = lane & 15, lq = lane >> 4;
  const bf16x8* kcd = reinterpret_cast<const bf16x8*>(p.ws + D_KCD + (size_t)base * 16384);
  const uint2* val = reinterpret_cast<const uint2*>(p.ws + D_VALT + (size_t)base * 16384);
  const float* gc = reinterpret_cast<const float*>(p.ws + D_GC) + (size_t)base * 64;
#pragma unroll
  for (int ks = 0; ks < 4; ++ks) d.kcd[ks] = kcd[(w * 4 + ks) * 64 + lane];
#pragma unroll
  for (int eb = 0; eb < 2; ++eb) d.val[eb] = val[((es * 2 + eb) * 4 + w) * 64 + lane];
  d.gc = gc[w * 16 + lr];
  d.gl = gc[63];
  d.gi = *reinterpret_cast<const float4*>(gc + 16 * w + 4 * lq);
}
__device__ __forceinline__ void m2d_loadB(const Params& p, int base, int w, int lane, DPre& d) {
  const bf16x8* qf = reinterpret_cast<const bf16x8*>(p.ws + D_QF + (size_t)base * 16384);
  const bf16x8* att = reinterpret_cast<const bf16x8*>(p.ws + D_ATT + (size_t)base * 8192);
#pragma unroll
  for (int ks = 0; ks < 4; ++ks) d.q[ks] = qf[(w * 4 + ks) * 64 + lane];
#pragma unroll
  for (int ks = 0; ks < 2; ++ks) d.att[ks] = att[(w * 2 + ks) * 64 + lane];
}
__device__ __forceinline__ void m2d_loadC(const Params& p, int base, int w, int lane, DPre& d) {
  const bf16x8* knt = reinterpret_cast<const bf16x8*>(p.ws + D_KNT + (size_t)base * 16384);
#pragma unroll
  for (int ks = 0; ks < 2; ++ks) {
    d.knt[0][ks] = knt[((2 * w) * 2 + ks) * 64 + lane];
    d.knt[1][ks] = knt[((2 * w + 1) * 2 + ks) * 64 + lane];
  }
}

__device__ __forceinline__ void m2_delta_item(const Params& p, int item, char* smem) {
  const int tid = VTID, lane = tid & 63, w = tid >> 6, lr = lane & 15, lq = lane >> 4;
  const int es = item & 3, h = (item >> 2) & 3, b = item >> 4;
  u16* Sb = reinterpret_cast<u16*>(smem);
  u16* Ub = reinterpret_cast<u16*>(smem + 17408);
  u16* Usb = reinterpret_cast<u16*>(smem + 22016);
  for (int i = tid; i < 32 * 136; i += NTHR) Sb[i] = 0;
  f32x4 accS[2][2];
#pragma unroll
  for (int i = 0; i < 2; ++i)
#pragma unroll
    for (int j = 0; j < 2; ++j) accS[i][j] = (f32x4){0.f, 0.f, 0.f, 0.f};
  u16* OA = reinterpret_cast<u16*>(reinterpret_cast<char*>(p.out) + YB_OA);
  DPre cur;
  m2d_loadA(p, (b * 32 + 0) * 4 + h, es, w, lane, cur);
  m2d_loadB(p, (b * 32 + 0) * 4 + h, w, lane, cur);
  m2d_loadC(p, (b * 32 + 0) * 4 + h, w, lane, cur);
  __syncthreads();
  for (int n = 0; n < 32; ++n) {
    const int nbase = (b * 32 + (n + 1 < 32 ? n + 1 : n)) * 4 + h;
    const u16* Sc = Sb + (n & 1) * (32 * 136);
    u16* Sn = Sb + ((n + 1) & 1) * (32 * 136);
    f32x4 accP[2];
    accP[0] = (f32x4){0.f, 0.f, 0.f, 0.f}; accP[1] = accP[0];
#pragma unroll
    for (int ks = 0; ks < 4; ++ks) {
      accP[0] = mfma16(lds_frag(Sc, 136, 0, ks * 32, lane), cur.kcd[ks], accP[0]);
      accP[1] = mfma16(lds_frag(Sc, 136, 16, ks * 32, lane), cur.kcd[ks], accP[1]);
    }
    const float egc = __expf(cur.gl - cur.gc);
    const float egl = __expf(cur.gl);
    const float egi[4] = {__expf(cur.gi.x), __expf(cur.gi.y), __expf(cur.gi.z), __expf(cur.gi.w)};
    float vv[2][4];
#pragma unroll
    for (int eb = 0; eb < 2; ++eb) { vv[eb][0] = lo2f(cur.val[eb].x); vv[eb][1] = hi2f(cur.val[eb].x); vv[eb][2] = lo2f(cur.val[eb].y); vv[eb][3] = hi2f(cur.val[eb].y); }
    m2d_loadA(p, nbase, es, w, lane, cur);
#pragma unroll
    for (int eb = 0; eb < 2; ++eb) {
#pragma unroll
      for (int j = 0; j < 4; ++j) {
        float u = vv[eb][j] - accP[eb][j];
        int e = eb * 16 + 4 * lq + j, c = 16 * w + lr;
        Ub[e * 72 + c] = f2bf(u);
        Usb[e * 72 + c] = f2bf(u * egc);
      }
    }
    lds_barrier();
    {
      f32x4 accO[2];
      accO[0] = (f32x4){0.f, 0.f, 0.f, 0.f}; accO[1] = accO[0];
#pragma unroll
      for (int ks = 0; ks < 4; ++ks) {
        accO[0] = mfma16(cur.q[ks], lds_frag(Sc, 136, 0, ks * 32, lane), accO[0]);
        accO[1] = mfma16(cur.q[ks], lds_frag(Sc, 136, 16, ks * 32, lane), accO[1]);
      }
#pragma unroll
      for (int eb = 0; eb < 2; ++eb)
#pragma unroll
        for (int j = 0; j < 4; ++j) accO[eb][j] *= egi[j];
#pragma unroll
      for (int ks = 0; ks < 2; ++ks) {
        accO[0] = mfma16(cur.att[ks], lds_frag(Ub, 72, 0, ks * 32, lane), accO[0]);
        accO[1] = mfma16(cur.att[ks], lds_frag(Ub, 72, 16, ks * 32, lane), accO[1]);
      }
      m2d_loadB(p, nbase, w, lane, cur);
#pragma unroll
      for (int eb = 0; eb < 2; ++eb)
#pragma unroll
        for (int j = 0; j < 4; ++j) {
          int tok = b * 2048 + n * 64 + 16 * w + 4 * lq + j;
          OA[(size_t)tok * 512 + h * 128 + es * 32 + eb * 16 + lr] = f2bf(accO[eb][j]);
        }
    }
    {
#pragma unroll
      for (int eb = 0; eb < 2; ++eb) {
        bf16x8 a0 = lds_frag(Usb, 72, eb * 16, 0, lane), a1 = lds_frag(Usb, 72, eb * 16, 32, lane);
#pragma unroll
        for (int dd = 0; dd < 2; ++dd) {
#pragma unroll
          for (int j = 0; j < 4; ++j) accS[eb][dd][j] *= egl;
          accS[eb][dd] = mfma16(a0, cur.knt[dd][0], accS[eb][dd]);
          accS[eb][dd] = mfma16(a1, cur.knt[dd][1], accS[eb][dd]);
#pragma unroll
          for (int j = 0; j < 4; ++j) Sn[(eb * 16 + 4 * lq + j) * 136 + (2 * w + dd) * 16 + lr] = f2bf(accS[eb][dd][j]);
        }
      }
    }
    m2d_loadC(p, nbase, w, lane, cur);
    lds_barrier();
  }
  float* outp = p.out + O_DELTAP + (size_t)(b * 4 + h) * 16384;
#pragma unroll
  for (int eb = 0; eb < 2; ++eb)
#pragma unroll
    for (int dd = 0; dd < 2; ++dd) {
      int d = (2 * w + dd) * 16 + lr, e0 = es * 32 + eb * 16 + 4 * lq;
      *reinterpret_cast<float4*>(outp + (size_t)d * 128 + e0) =
          make_float4(accS[eb][dd][0], accS[eb][dd][1], accS[eb][dd][2], accS[eb][dd][3]);
    }
  __syncthreads();
}

struct HPre {
  bf16x8 qg[4], att, vt[2], kgt[2];
  float ebl[2];
};
__device__ __forceinline__ HPre m2h_load(const Params& p, int base, int vs, int w, int lane) {
  HPre d;
  const int lr = lane & 15;
  const bf16x8* qg = reinterpret_cast<const bf16x8*>(p.ws + H_QG + (size_t)base * 8192);
  const bf16x8* att = reinterpret_cast<const bf16x8*>(p.ws + H_ATT + (size_t)base * 2048);
  const bf16x8* vt = reinterpret_cast<const bf16x8*>(p.ws + H_VT + (size_t)base * 8192);
  const bf16x8* kgt = reinterpret_cast<const bf16x8*>(p.ws + H_KGT + (size_t)base * 8192);
  const float* ebl = reinterpret_cast<const float*>(p.ws + H_EBL) + (size_t)base * 128;
  const int ib = w >> 1;
#pragma unroll
  for (int ks = 0; ks < 4; ++ks) d.qg[ks] = qg[(ib * 4 + ks) * 64 + lane];
  d.att = att[ib * 64 + lane];
  d.vt[0] = vt[(vs * 2 + 0) * 64 + lane];
  d.vt[1] = vt[(vs * 2 + 1) * 64 + lane];
  d.kgt[0] = kgt[(2 * w) * 64 + lane];
  d.kgt[1] = kgt[(2 * w + 1) * 64 + lane];
  d.ebl[0] = ebl[(2 * w) * 16 + lr];
  d.ebl[1] = ebl[(2 * w + 1) * 16 + lr];
  return d;
}

__device__ __forceinline__ void m2_hgrn_item(const Params& p, int item, char* smem) {
  const int tid = VTID, lane = tid & 63, w = tid >> 6, lr = lane & 15, lq = lane >> 4;
  const int vs = item & 3, h = (item >> 2) & 3, b = item >> 4;
  u16* Sb = reinterpret_cast<u16*>(smem);
  for (int i = tid; i < 32 * 136; i += NTHR) Sb[i] = 0;
  f32x4 accS[2][2];
#pragma unroll
  for (int i = 0; i < 2; ++i)
#pragma unroll
    for (int j = 0; j < 2; ++j) accS[i][j] = (f32x4){0.f, 0.f, 0.f, 0.f};
  u16* OB = reinterpret_cast<u16*>(reinterpret_cast<char*>(p.out) + YB_OB);
  const int ib = w >> 1, vb = w & 1;
  HPre cur = m2h_load(p, (b * 64 + 0) * 4 + h, vs, w, lane), nxt = cur;
  __syncthreads();
  for (int n = 0; n < 64; ++n) {
    if (n + 1 < 64) nxt = m2h_load(p, (b * 64 + n + 1) * 4 + h, vs, w, lane);
    const u16* Sc = Sb + (n & 1) * (32 * 136);
    u16* Sn = Sb + ((n + 1) & 1) * (32 * 136);
    {
      f32x4 o = (f32x4){0.f, 0.f, 0.f, 0.f};
#pragma unroll
      for (int ks = 0; ks < 4; ++ks) o = mfma16(cur.qg[ks], lds_frag(Sc, 136, vb * 16, ks * 32, lane), o);
      o = mfma16(cur.att, vb ? cur.vt[1] : cur.vt[0], o);
#pragma unroll
      for (int j = 0; j < 4; ++j) {
        int tok = b * 2048 + n * 32 + ib * 16 + 4 * lq + j;
        OB[(size_t)tok * 512 + h * 128 + vs * 32 + vb * 16 + lr] = f2bf(o[j]);
      }
    }
#pragma unroll
    for (int v2 = 0; v2 < 2; ++v2)
#pragma unroll
      for (int dd = 0; dd < 2; ++dd) {
#pragma unroll
        for (int j = 0; j < 4; ++j) accS[v2][dd][j] *= cur.ebl[dd];
        accS[v2][dd] = mfma16(cur.vt[v2], cur.kgt[dd], accS[v2][dd]);
#pragma unroll
        for (int j = 0; j < 4; ++j) Sn[(v2 * 16 + 4 * lq + j) * 136 + (2 * w + dd) * 16 + lr] = f2bf(accS[v2][dd][j]);
      }
    lds_barrier();
    cur = nxt;
  }
  float* outp = p.out + O_HGRNP + (size_t)(b * 4 + h) * 16384;
#pragma unroll
  for (int v2 = 0; v2 < 2; ++v2)
#pragma unroll
    for (int dd = 0; dd < 2; ++dd) {
      int e = (2 * w + dd) * 16 + lr, v0 = vs * 32 + v2 * 16 + 4 * lq;
      *reinterpret_cast<float4*>(outp + (size_t)e * 128 + v0) =
          make_float4(accS[v2][dd][0], accS[v2][dd][1], accS[v2][dd][2], accS[v2][dd][3]);
    }
  __syncthreads();
}

__device__ __forceinline__ void ms_delta_item(const Params& p, int item, char* smem) {
  const int tid = VTID, lane = tid & 63, w = tid >> 6;
  const int h = item & 3, b = item >> 2;
  const int R0 = TP + b * 4;
  float* qkv = reinterpret_cast<float*>(smem);
  float* red = reinterpret_cast<float*>(smem + 6144);
  const u16* Zp = reinterpret_cast<const u16*>(p.ws + Z1);
  for (int c = tid; c < 384; c += NTHR) {
    int col = c < 128 ? h * 128 + c : (c < 256 ? 512 + h * 128 + c - 128 : 1024 + h * 128 + c - 256);
    float xs[7];
#pragma unroll
    for (int j = 0; j < 3; ++j) xs[j] = p.cache_conv[(size_t)(b * 3 + j) * 1536 + col];
#pragma unroll
    for (int t = 0; t < 4; ++t) xs[3 + t] = bf2f(Zp[(size_t)(R0 + t) * 3072 + col]);
    float wc[4];
#pragma unroll
    for (int j = 0; j < 4; ++j) wc[j] = p.w_conv_a[j * 1536 + col];
#pragma unroll
    for (int t = 0; t < 4; ++t) {
      float y = xs[t] * wc[0] + xs[t + 1] * wc[1] + xs[t + 2] * wc[2] + xs[t + 3] * wc[3];
      qkv[t * 384 + c] = silu_f(y);
    }
  }
  __syncthreads();
  {
    const int t = w;
    float q0 = qkv[t * 384 + lane], q1 = qkv[t * 384 + 64 + lane];
    float k0 = qkv[t * 384 + 128 + lane], k1 = qkv[t * 384 + 192 + lane];
    float qs = wave_sum(q0 * q0 + q1 * q1), ks = wave_sum(k0 * k0 + k1 * k1);
    float qn = rsqrtf(qs + EPS) * 0.08838834764831845f, kn = rsqrtf(ks + EPS);
    qkv[t * 384 + lane] = q0 * qn; qkv[t * 384 + 64 + lane] = q1 * qn;
    qkv[t * 384 + 128 + lane] = k0 * kn; qkv[t * 384 + 192 + lane] = k1 * kn;
  }
  __syncthreads();
  const int e = tid & 127, dh = tid >> 7;
  float S[64];
  const float* s0 = p.state_delta + (size_t)(b * 4 + h) * 16384 + (size_t)(dh * 64) * 128 + e;
#pragma unroll
  for (int dd = 0; dd < 64; ++dd) S[dd] = s0[(size_t)dd * 128];
  const float* gdec = reinterpret_cast<const float*>(p.ws + SM_GDEC);
  const float* betap = reinterpret_cast<const float*>(p.ws + SM_BETA);
  u16* OA = reinterpret_cast<u16*>(reinterpret_cast<char*>(p.out) + YB_OA);
  for (int t = 0; t < 4; ++t) {
    const float a = __expf(gdec[(size_t)(R0 + t) * 4 + h]), bt = betap[(size_t)(R0 + t) * 4 + h];
    const float* qv = qkv + t * 384 + dh * 64;
    const float* kv = qkv + t * 384 + 128 + dh * 64;
    float rp = 0.f;
#pragma unroll
    for (int dd = 0; dd < 64; ++dd) rp += S[dd] * kv[dd];
    red[((t * 2 + 0) * 2 + dh) * 128 + e] = rp;
    __syncthreads();
    float r = a * (red[((t * 2 + 0) * 2 + 0) * 128 + e] + red[((t * 2 + 0) * 2 + 1) * 128 + e]);
    float u = bt * (qkv[t * 384 + 256 + e] - r);
    float op = 0.f;
#pragma unroll
    for (int dd = 0; dd < 64; ++dd) {
      S[dd] = a * S[dd] + kv[dd] * u;
      op += S[dd] * qv[dd];
    }
    red[((t * 2 + 1) * 2 + dh) * 128 + e] = op;
    __syncthreads();
    if (dh == 0) {
      float o = red[((t * 2 + 1) * 2 + 0) * 128 + e] + red[((t * 2 + 1) * 2 + 1) * 128 + e];
      OA[(size_t)(R0 + t) * 512 + h * 128 + e] = f2bf(o);
    }
  }
  float* so = p.out + O_DELTAS + (size_t)(b * 4 + h) * 16384 + (size_t)(dh * 64) * 128 + e;
#pragma unroll
  for (int dd = 0; dd < 64; ++dd) so[(size_t)dd * 128] = S[dd];
  __syncthreads();
}

__device__ __forceinline__ void ms_hgrn_item(const Params& p, int item, char* smem) {
  const int tid = VTID;
  const int h = item & 3, b = item >> 2;
  const int R0 = TP + b * 4;
  float* qs = reinterpret_cast<float*>(smem);
  float* fs = qs + 512;
  float* vsm = fs + 512;
  float* red = vsm + 512;
  const u16* Zp = reinterpret_cast<const u16*>(p.ws + Z1);
  for (int i = tid; i < 512; i += NTHR) {
    int t = i >> 7, e = i & 127, he = h * 128 + e;
    const u16* zr = Zp + (size_t)(R0 + t) * 3072;
    float lb = sigmoid_f(p.lb_logits[he] - p.lb_logits[512 + he]);
    qs[i] = silu_f(bf2f(zr[1536 + he]));
    fs[i] = lb + (1.f - lb) * sigmoid_f(bf2f(zr[2048 + he]));
    vsm[i] = bf2f(zr[2560 + he]);
  }
  __syncthreads();
  const int v = tid & 127, eh = tid >> 7;
  float S[64];
  const float* s0 = p.state_hgrn + (size_t)(b * 4 + h) * 16384 + (size_t)(eh * 64) * 128 + v;
#pragma unroll
  for (int ee = 0; ee < 64; ++ee) S[ee] = s0[(size_t)ee * 128];
  u16* OB = reinterpret_cast<u16*>(reinterpret_cast<char*>(p.out) + YB_OB);
  for (int t = 0; t < 4; ++t) {
    const float vv = vsm[t * 128 + v];
    const float* ft = fs + t * 128 + eh * 64;
    const float* qt = qs + t * 128 + eh * 64;
    float op = 0.f;
#pragma unroll
    for (int ee = 0; ee < 64; ++ee) {
      float f = ft[ee];
      S[ee] = f * S[ee] + (1.f - f) * vv;
      op += S[ee] * qt[ee];
    }
    red[(t * 2 + eh) * 128 + v] = op;
    __syncthreads();
    if (eh == 0) OB[(size_t)(R0 + t) * 512 + h * 128 + v] = f2bf(red[(t * 2) * 128 + v] + red[(t * 2 + 1) * 128 + v]);
  }
  float* so = p.out + O_HGRNS + (size_t)(b * 4 + h) * 16384 + (size_t)(eh * 64) * 128 + v;
#pragma unroll
  for (int ee = 0; ee < 64; ++ee) so[(size_t)ee * 128] = S[ee];
  __syncthreads();
}

__device__ __forceinline__ void phase_m3(const Params& p, char* smem, int bid, int nb) {
  const int tid = VTID, lane = tid & 63, w = tid >> 6;
  float* tl = reinterpret_cast<float*>(smem);
  const int NWT = 704 + 352;
  const int NTASK = (2 * TT) / 4;
  for (int item = bid; item < NWT + NTASK; item += nb) {
    if (item < NWT) {
      if (item < 704) {
        int blk = item >> 2, k0 = (item & 3) * 256;
        int grp = blk >> 3, sub = blk & 7, up = sub >> 2;
        wt_chunk((up ? p.w_ffn_up : p.w_ffn_gate) + grp * 128 + (sub & 3) * 32, DFF, 1024,
                 reinterpret_cast<u16*>(p.ws + W_GU) + (size_t)blk * 32 * 1024, p.g_ffn, tl, k0);
      } else {
        int q = item - 704;
        int n = (q / 11) * 32, k0 = (q % 11) * 256;
        wt_chunk(p.w_ffn_down + n, 1024, DFF, reinterpret_cast<u16*>(p.ws + W_DOWN) + (size_t)n * DFF, nullptr, tl, k0);
      }
    } else {
      int task = (item - NWT) * 4 + w;
      int tok = task >> 1, br = task & 1;
      u16* o = reinterpret_cast<u16*>(reinterpret_cast<char*>(p.out) + (br ? YB_OB : YB_OA)) + (size_t)tok * 512 + lane * 8;
      const u16* og = z2row(p, tok) + 2048 + br * 512 + lane * 8;
      const float* g = (br ? p.g_out_b : p.g_out_a) + (lane & 15) * 8;
      uint4 ov = *reinterpret_cast<const uint4*>(o), gv = *reinterpret_cast<const uint4*>(og);
      unsigned oo[4] = {ov.x, ov.y, ov.z, ov.w}, gg[4] = {gv.x, gv.y, gv.z, gv.w};
      float x[8], y[8];
#pragma unroll
      for (int j = 0; j < 4; ++j) { x[2 * j] = lo2f(oo[j]); x[2 * j + 1] = hi2f(oo[j]); y[2 * j] = lo2f(gg[j]); y[2 * j + 1] = hi2f(gg[j]); }
      float ss = 0.f;
#pragma unroll
      for (int j = 0; j < 8; ++j) ss += x[j] * x[j];
      ss += __shfl_xor(ss, 1, 64); ss += __shfl_xor(ss, 2, 64); ss += __shfl_xor(ss, 4, 64); ss += __shfl_xor(ss, 8, 64);
      float rstd = rsqrtf(ss * (1.f / 128.f) + EPS);
      unsigned r[4];
#pragma unroll
      for (int j = 0; j < 4; ++j)
        r[j] = pack2(x[2 * j] * rstd * g[2 * j] * silu_f(y[2 * j]), x[2 * j + 1] * rstd * g[2 * j + 1] * silu_f(y[2 * j + 1]));
      *reinterpret_cast<uint4*>(o) = make_uint4(r[0], r[1], r[2], r[3]);
    }
  }
}

__device__ __forceinline__ void phase_fixup(const Params& p, int bid, int nb) {
  const float* haloG = reinterpret_cast<const float*>(p.ws + HALO_G);
  const float* headG = reinterpret_cast<const float*>(p.ws + HEAD_G);
  const float* headU = reinterpret_cast<const float*>(p.ws + HEAD_U);
  u16* ACTp = reinterpret_cast<u16*>(p.ws + ACT);
  const int total = 256 * 2 * DFF;
  for (int i = bid * NTHR + VTID; i < total; i += nb * NTHR) {
    int ch = i % DFF, rr = (i / DFF) & 1, blk = i / (2 * DFF);
    if ((blk & 31) == 0) continue;
    float g0 = headG[(size_t)(blk * 2 + rr) * DFF + ch], u = headU[(size_t)(blk * 2 + rr) * DFF + ch];
    float gm1, gm2;
    if (rr == 0) { gm1 = haloG[(size_t)((blk - 1) * 2 + 1) * DFF + ch]; gm2 = haloG[(size_t)((blk - 1) * 2 + 0) * DFF + ch]; }
    else { gm1 = headG[(size_t)(blk * 2 + 0) * DFF + ch]; gm2 = haloG[(size_t)((blk - 1) * 2 + 1) * DFF + ch]; }
    float gc = p.w_ffn_conv[ch] * gm2 + p.w_ffn_conv[DFF + ch] * gm1 + p.w_ffn_conv[2 * DFF + ch] * g0;
    ACTp[(size_t)(blk * 64 + rr) * DFF + ch] = f2bf(silu_f(gc) * u);
  }
}

__device__ __forceinline__ void phase_final(const Params& p, int bid, int nb) {
  const int tid = VTID, lane = tid & 63, w = tid >> 6;
  for (int row = bid * 4 + w; row < TP; row += nb * 8) {
    const int rowB = row + nb * 4;
    const bool hasB = rowB < TP;
    float* ya = p.out + O_YP + (size_t)row * DM;
    float* yb = p.out + O_YP + (size_t)(hasB ? rowB : row) * DM;
    float4 xa[4], xb[4];
#pragma unroll
    for (int i = 0; i < 4; ++i) xa[i] = *reinterpret_cast<const float4*>(ya + i * 256 + lane * 4);
#pragma unroll
    for (int i = 0; i < 4; ++i) xb[i] = *reinterpret_cast<const float4*>(yb + i * 256 + lane * 4);
    float sa = 0.f, sb = 0.f;
#pragma unroll
    for (int i = 0; i < 4; ++i) {
      sa += xa[i].x * xa[i].x + xa[i].y * xa[i].y + xa[i].z * xa[i].z + xa[i].w * xa[i].w;
      sb += xb[i].x * xb[i].x + xb[i].y * xb[i].y + xb[i].z * xb[i].z + xb[i].w * xb[i].w;
    }
    sa = wave_sum(sa); sb = wave_sum(sb);
    const float ra = rsqrtf(sa * (1.f / DM) + EPS), rb = rsqrtf(sb * (1.f / DM) + EPS);
#pragma unroll
    for (int i = 0; i < 4; ++i) {
      float4 g = *reinterpret_cast<const float4*>(p.g_final + i * 256 + lane * 4);
      *reinterpret_cast<float4*>(ya + i * 256 + lane * 4) = make_float4(xa[i].x * ra * g.x, xa[i].y * ra * g.y, xa[i].z * ra * g.z, xa[i].w * ra * g.w);
      if (hasB) *reinterpret_cast<float4*>(yb + i * 256 + lane * 4) = make_float4(xb[i].x * rb * g.x, xb[i].y * rb * g.y, xb[i].z * rb * g.z, xb[i].w * rb * g.w);
    }
  }
  for (int row = TP + bid * 4 + w; row < TT; row += nb * 4) {
    float* y = p.out + O_YP + (size_t)row * DM;
    float4 xv[4];
    float ss = 0.f;
    const float* part = reinterpret_cast<const float*>(p.ws + PART) + (size_t)(row - TP) * 1024;
#pragma unroll
    for (int i = 0; i < 4; ++i) {
      xv[i] = *reinterpret_cast<const float4*>(y + i * 256 + lane * 4);
      for (int ks = 0; ks < 11; ++ks) {
        float4 pv = *reinterpret_cast<const float4*>(part + (size_t)ks * TS * 1024 + i * 256 + lane * 4);
        xv[i].x += pv.x; xv[i].y += pv.y; xv[i].z += pv.z; xv[i].w += pv.w;
      }
      ss += xv[i].x * xv[i].x + xv[i].y * xv[i].y + xv[i].z * xv[i].z + xv[i].w * xv[i].w;
    }
    ss = wave_sum(ss);
    float rstd = rsqrtf(ss * (1.f / DM) + EPS);
#pragma unroll
    for (int i = 0; i < 4; ++i) {
      float4 g = *reinterpret_cast<const float4*>(p.g_final + i * 256 + lane * 4);
      *reinterpret_cast<float4*>(y + i * 256 + lane * 4) =
          make_float4(xv[i].x * rstd * g.x, xv[i].y * rstd * g.y, xv[i].z * rstd * g.z, xv[i].w * rstd * g.w);
    }
  }
}

constexpr int NPHASE = 12;
__device__ __forceinline__ void run_phase(const Params& p, int ph, char* smem_all) {
  int half = threadIdx.x >> 8;
  asm volatile("" : "+v"(half));
  const int bid = blockIdx.x * 2 + half, nb = gridDim.x * 2;
  char* smem = smem_all + half * SMEM_HALF;
  LAS unsigned char* lds = (LAS unsigned char*)smem_all;
  const u16* HB = reinterpret_cast<const u16*>(reinterpret_cast<const char*>(p.out) + YB_H);
  switch (ph) {
    case 0: phase_prep(p, smem, bid, nb); break;
    case 1: { pg8::SchedStatic S; S.init(TT, 3072, (int)gridDim.x, (int)blockIdx.x, 0); gemm_phase8<EPI_Z1>(p, HB, reinterpret_cast<const u16*>(p.ws + W_MAIN), 1024, 1024, lds, S); } break;
    case 2:
      for (int it = bid; it < 1024 + 2048; it += nb) {
        if (it < 1024) m1_delta_item(p, it, smem); else m1_hgrn_item(p, it - 1024, smem);
      }
      break;
    case 3: {
      const int g = blockIdx.x;
      if (g < 128) {
        const int gg = g & 63, xcd = gg & 7, j = gg >> 3;
        const int q = xcd + 8 * (j >> 1), es = 2 * (j & 1) + half;
        if (g < 64) m2_delta_item(p, q * 4 + es, smem); else m2_hgrn_item(p, q * 4 + es, smem);
      } else {
        const int nrest = (gridDim.x - 128) * 2, v0 = (g - 128) * 2 + half;
        for (int it = v0; it < 1024; it += nrest) {
          if (it < 512) ms_delta_item(p, it, smem); else ms_hgrn_item(p, it - 512, smem);
        }
        __syncthreads();
        { pg8::SchedStatic S; S.init(TS, 3072, 24, g - 128, 64);
          gemm_phase8<EPI_Z2>(p, HB, reinterpret_cast<const u16*>(p.ws + W_G2), 1024, 1024, lds, S); }
      }
    } break;
    case 4: { pg8::SchedStatic S; S.init(TP, 3072, (int)gridDim.x, (int)blockIdx.x, 0); gemm_phase8<EPI_Z2>(p, HB, reinterpret_cast<const u16*>(p.ws + W_G2), 1024, 1024, lds, S); } break;
    case 5: phase_m3(p, smem, bid, nb); break;
    case 6: {
      const u16* OA = reinterpret_cast<const u16*>(reinterpret_cast<const char*>(p.out) + YB_OA);
      const u16* OB = reinterpret_cast<const u16*>(reinterpret_cast<const char*>(p.out) + YB_OB);
      { pg8::SchedStatic S; S.init(TT, 1024, (int)gridDim.x, (int)blockIdx.x, 0); gemm_phase8<EPI_MIXA>(p, OA, reinterpret_cast<const u16*>(p.ws + W_A), 512, 512, lds, S);
      gemm_phase8<EPI_MIXB>(p, OB, reinterpret_cast<const u16*>(p.ws + W_B), 512, 512, lds, S); }
    } break;
    case 7: { pg8::SchedStatic S; S.init(TT, 1024, (int)gridDim.x, (int)blockIdx.x, 0); gemm_phase8<EPI_WOUT>(p, reinterpret_cast<const u16*>(p.ws + MIX), reinterpret_cast<const u16*>(p.ws + W_OUT), 1024, 1024, lds, S); } break;
    case 8: { pg8::SchedStatic S; S.init(TT, 5632, (int)gridDim.x, (int)blockIdx.x, 0); gemm_phase8<EPI_FFN1>(p, reinterpret_cast<const u16*>(p.ws + X1B), reinterpret_cast<const u16*>(p.ws + W_GU), 1024, 1024, lds, S); } break;
    case 9: phase_fixup(p, bid, nb); break;
    case 10: {
      { pg8::SchedStatic S; S.init(TP, 1024, (int)gridDim.x, (int)blockIdx.x, 0);
        gemm_phase8<EPI_FFN2>(p, reinterpret_cast<const u16*>(p.ws + ACT), reinterpret_cast<const u16*>(p.ws + W_DOWN), DFF, DFF, lds, S); }
      { pg8::SchedSplit S; S.init(2, 4, 11, (int)gridDim.x, (int)blockIdx.x, 64);
        gemm_phase8<EPI_FFN2S>(p, reinterpret_cast<const u16*>(p.ws + ACT), reinterpret_cast<const u16*>(p.ws + W_DOWN), DFF, 256, lds, S); }
    } break;
    case 11: phase_final(p, bid, nb); break;
  }
}

__global__ void __launch_bounds__(512, 2) k_main(Params p, int ph0, int ph1) {
  extern __shared__ __attribute__((aligned(16))) char smem[];
  volatile LAS unsigned* xst = (volatile LAS unsigned*)(smem + 2 * SMEM_HALF);
  if (threadIdx.x == 0) { xst[0] = 0u; xst[1] = 0u; }
  __syncthreads();
  XcdBarrier xb = xcd_barrier_post(reinterpret_cast<unsigned*>(p.ws + BAR_OFF), xst);
  if (ph1 < 0) cg::this_grid().sync();
#define PHASE_STEP(N)                                        \
  if (ph0 <= N && N < ph1) run_phase(p, N, smem);            \
  if (ph0 <= N && N + 1 < ph1) xcd_barrier(xb);
  PHASE_STEP(0) PHASE_STEP(1) PHASE_STEP(2) PHASE_STEP(3) PHASE_STEP(4) PHASE_STEP(5)
  PHASE_STEP(6) PHASE_STEP(7) PHASE_STEP(8) PHASE_STEP(9) PHASE_STEP(10) PHASE_STEP(11)
#undef PHASE_STEP
}

extern "C" void kernel_launch(void* const* d_in, const int* in_sizes, int n_in, void* d_out, int out_size, void* d_ws,
                              size_t ws_size, hipStream_t stream) {
  static int grid_blocks = 0;
  if (!grid_blocks) {
    hipFuncSetAttribute((const void*)k_main, hipFuncAttributeMaxDynamicSharedMemorySize, SMEM_BYTES);
    int dev = 0, cus = 0, per_cu = 0;
    hipGetDevice(&dev);
    hipDeviceGetAttribute(&cus, hipDeviceAttributeMultiprocessorCount, dev);
    hipOccupancyMaxActiveBlocksPerMultiprocessor(&per_cu, k_main, 512, SMEM_BYTES);
    if (per_cu > 1) per_cu = 1;
    if (per_cu < 1) per_cu = 1;
    grid_blocks = cus * per_cu;
  }
  Params p{};
  const float** f = reinterpret_cast<const float**>(&p);
  for (int i = 0; i < 23; ++i) f[i] = reinterpret_cast<const float*>(d_in[i]);
  p.out = reinterpret_cast<float*>(d_out);
  p.ws = reinterpret_cast<char*>(d_ws);
  if (ws_size < WS_NEED) fprintf(stderr, "workspace too small: %zu < %zu\n", ws_size, (size_t)WS_NEED);
  hipMemsetAsync(p.ws + BAR_OFF, 0, 16384, stream);
#if MULTI_LAUNCH
  for (int ph = 0; ph < NPHASE; ++ph) {
    hipLaunchKernelGGL(k_main, dim3(grid_blocks), dim3(512), SMEM_BYTES, stream, p, ph, ph + 1);
  }
#else
  int ph0 = 0, ph1 = NPHASE;
  void* args[] = {&p, &ph0, &ph1};
  hipError_t e = hipLaunchCooperativeKernel((void*)k_main, dim3(grid_blocks), dim3(512), args, SMEM_BYTES, stream);
  if (e != hipSuccess) fprintf(stderr, "cooperative launch failed: %s (grid %d)\n", hipGetErrorString(e), grid_blocks);
#endif
}
```

```cpp
#include <hip/hip_runtime.h>
#include <hip/hip_cooperative_groups.h>
#include <cstdio>
#include <cstdint>
namespace cg = cooperative_groups;

#ifndef MULTI_LAUNCH
#define MULTI_LAUNCH 0
#endif

typedef unsigned short u16;
typedef __attribute__((ext_vector_type(8))) short bf16x8;
typedef __attribute__((ext_vector_type(4))) float f32x4;

constexpr int TP = 16384, TS = 512, TT = TP + TS;
constexpr int DM = 1024, NIN = 6152, DFF = 2816;
constexpr float EPS = 1e-6f;
constexpr int NTHR = 256;
#define VTID (threadIdx.x & 255)
constexpr int SMEM_HALF = 77824;
constexpr int SMEM_BYTES = 2 * SMEM_HALF + 16;

constexpr size_t O_YP = 0;
constexpr size_t O_YS = O_YP + (size_t)TP * DM;
constexpr size_t O_CONVP = O_YS + (size_t)TS * DM;
constexpr size_t O_DELTAP = O_CONVP + 8 * 3 * 1536;
constexpr size_t O_HGRNP = O_DELTAP + 8 * 4 * 128 * 128;
constexpr size_t O_FFNP = O_HGRNP + 8 * 4 * 128 * 128;
constexpr size_t O_CONVS = O_FFNP + 8 * 2 * DFF;
constexpr size_t O_DELTAS = O_CONVS + 128 * 3 * 1536;
constexpr size_t O_HGRNS = O_DELTAS + (size_t)128 * 4 * 128 * 128;
constexpr size_t O_FFNS = O_HGRNS + (size_t)128 * 4 * 128 * 128;

constexpr size_t al(size_t x) { return (x + 255) & ~(size_t)255; }
constexpr size_t W_MAIN = 0;
constexpr size_t W_G2 = W_MAIN + (size_t)3072 * 1024 * 2;
constexpr size_t W_A = W_G2 + (size_t)3072 * 1024 * 2;
constexpr size_t W_B = W_A + (size_t)1024 * 512 * 2;
constexpr size_t W_OUT = W_B + (size_t)1024 * 512 * 2;
constexpr size_t SM_GDEC = W_OUT + (size_t)1024 * 1024 * 2;
constexpr size_t SM_BETA = al(SM_GDEC + (size_t)TT * 16);
constexpr size_t SM_ROWSS = al(SM_BETA + (size_t)TT * 16);
constexpr size_t Z1 = al(SM_ROWSS + (size_t)TT * 4);
constexpr size_t Z1_SIZE = (size_t)TT * 3072 * 2;
constexpr size_t RB = al(Z1 + Z1_SIZE);
constexpr size_t D_QF = RB;
constexpr size_t D_KCD = D_QF + (size_t)1024 * 16384;
constexpr size_t D_KNT = D_KCD + (size_t)1024 * 16384;
constexpr size_t D_VALT = D_KNT + (size_t)1024 * 16384;
constexpr size_t D_ATT = D_VALT + (size_t)1024 * 16384;
constexpr size_t D_GC = D_ATT + (size_t)1024 * 8192;
constexpr size_t H_QG = D_GC + (size_t)1024 * 256;
constexpr size_t H_KGT = H_QG + (size_t)2048 * 8192;
constexpr size_t H_VT = H_KGT + (size_t)2048 * 8192;
constexpr size_t H_ATT = H_VT + (size_t)2048 * 8192;
constexpr size_t H_EBL = H_ATT + (size_t)2048 * 2048;
constexpr size_t RB_END1 = H_EBL + (size_t)2048 * 512;
constexpr size_t Z2 = RB;
constexpr size_t X1B = RB;
constexpr size_t ACT = RB + (size_t)TT * 1024 * 2;
constexpr size_t RB_END2 = ACT + (size_t)TT * DFF * 2;
constexpr size_t WS_NEED = (RB_END1 > RB_END2 ? RB_END1 : RB_END2);
constexpr size_t BAR_OFF = al(WS_NEED);
constexpr size_t Z2S = BAR_OFF + 16384;
static_assert(Z2S + (size_t)TS * 3072 * 2 <= (size_t)268435456, "workspace too large");
constexpr size_t W_GU = Z1;
constexpr size_t W_DOWN = W_GU + (size_t)5632 * 1024 * 2;
constexpr size_t MIX = W_DOWN + (size_t)1024 * DFF * 2;
constexpr size_t HALO_G = MIX + (size_t)TT * 1024 * 2;
constexpr size_t HEAD_G = HALO_G + (size_t)264 * 2 * DFF * 4;
constexpr size_t HEAD_U = HEAD_G + (size_t)264 * 2 * DFF * 4;
constexpr size_t PART = HEAD_U + (size_t)264 * 2 * DFF * 4;
static_assert(PART + (size_t)11 * TS * 1024 * 4 <= Z1 + Z1_SIZE, "z1 reuse overflow");
constexpr size_t YB_H = 0;
constexpr size_t YB_OA = (size_t)TT * 1024 * 2;
constexpr size_t YB_OB = YB_OA + (size_t)TT * 512 * 2;

struct Params {
  const float *x_prompt, *x_sample, *cache_conv, *state_delta, *state_hgrn, *cache_ffn;
  const float *g_attn, *w_in, *w_conv_a, *a_log, *dt_bias, *g_out_a, *w_branch_a, *lb_logits, *g_out_b,
      *w_branch_b, *w_out, *g_ffn, *w_ffn_gate, *w_ffn_up, *w_ffn_conv, *w_ffn_down, *g_final;
  float* out;
  char* ws;
};

__device__ __forceinline__ const unsigned short* z2row(const Params& p, int row) {
  return row < TP ? reinterpret_cast<const unsigned short*>(p.ws + Z2) + (size_t)row * 3072
                  : reinterpret_cast<const unsigned short*>(p.ws + Z2S) + (size_t)(row - TP) * 3072;
}
__device__ __forceinline__ u16 f2bf(float f) {
  unsigned u = __float_as_uint(f);
  u += 0x7fffu + ((u >> 16) & 1u);
  return (u16)(u >> 16);
}
__device__ __forceinline__ float bf2f(u16 h) { return __uint_as_float(((unsigned)h) << 16); }
__device__ __forceinline__ unsigned pack2(float a, float b) { return (unsigned)f2bf(a) | ((unsigned)f2bf(b) << 16); }
__device__ __forceinline__ float lo2f(unsigned u) { return __uint_as_float(u << 16); }
__device__ __forceinline__ float hi2f(unsigned u) { return __uint_as_float(u & 0xffff0000u); }
__device__ __forceinline__ float silu_f(float x) { return x / (1.f + __expf(-x)); }
__device__ __forceinline__ float sigmoid_f(float x) { return 1.f / (1.f + __expf(-x)); }
__device__ __forceinline__ float wave_sum(float v) {
#pragma unroll
  for (int o = 32; o >= 1; o >>= 1) v += __shfl_xor(v, o, 64);
  return v;
}
__device__ __forceinline__ void lds_barrier() {
  __builtin_amdgcn_fence(__ATOMIC_RELEASE, "workgroup", "local");
  __builtin_amdgcn_s_barrier();
  __builtin_amdgcn_fence(__ATOMIC_ACQUIRE, "workgroup", "local");
}
__device__ __forceinline__ f32x4 mfma16(bf16x8 a, bf16x8 b, f32x4 c) {
  return __builtin_amdgcn_mfma_f32_16x16x32_bf16(a, b, c, 0, 0, 0);
}
__device__ __forceinline__ bf16x8 lds_frag(const u16* base, int ld, int row0, int k0, int lane) {
  return *reinterpret_cast<const bf16x8*>(base + (row0 + (lane & 15)) * ld + k0 + 8 * (lane >> 4));
}
__device__ __forceinline__ void store_frags(const u16* lds, int ld, int R, int K, u16* dst, int t, int nt) {
  const int nkb = K >> 5, total = (R >> 4) * nkb * 64;
  for (int idx = t; idx < total; idx += nt) {
    int f = idx >> 6, pl = idx & 63, rb = f / nkb, kb = f - rb * nkb;
    uint4 v = *reinterpret_cast<const uint4*>(lds + (rb * 16 + (pl & 15)) * ld + kb * 32 + 8 * (pl >> 4));
    *reinterpret_cast<uint4*>(dst + (size_t)idx * 8) = v;
  }
}
__device__ __forceinline__ void store_frags_T(const u16* lds, int ld, int R2, int K2, u16* dst, int t, int nt) {
  const int nkb = K2 >> 5, total = (R2 >> 4) * nkb * 64;
  for (int idx = t; idx < total; idx += nt) {
    int f = idx >> 6, pl = idx & 63, rb = f / nkb, kb = f - rb * nkb;
    int d = rb * 16 + (pl & 15), c0 = kb * 32 + 8 * (pl >> 4);
    unsigned r[4];
#pragma unroll
    for (int j = 0; j < 4; ++j) {
      unsigned a = lds[(c0 + 2 * j) * ld + d], b = lds[(c0 + 2 * j + 1) * ld + d];
      r[j] = a | (b << 16);
    }
    *reinterpret_cast<uint4*>(dst + (size_t)idx * 8) = make_uint4(r[0], r[1], r[2], r[3]);
  }
}

#define XB_TMO 128
#define XB_XCNT(j) (256 + 64 * (j))
#define XB_XSUB(j) (1280 + 64 * (j))
#define XB_XGEN(j) (2304 + 64 * (j))
#define XB_TOP 3328
#define XB_TOPGEN 3392
#define XCD_BAR_WORDS 3456
#define XB_SPIN_CAP (1u << 18)
#define LAS __attribute__((address_space(3)))
__device__ __forceinline__ unsigned xb_ld(unsigned* p) { return __hip_atomic_load(p, __ATOMIC_RELAXED, __HIP_MEMORY_SCOPE_AGENT); }
__device__ __forceinline__ unsigned xb_add(unsigned* p, unsigned v) { return __hip_atomic_fetch_add(p, v, __ATOMIC_RELAXED, __HIP_MEMORY_SCOPE_AGENT); }
__device__ __forceinline__ unsigned xb_xcc_id() { return (unsigned)__builtin_amdgcn_s_getreg((3 << 11) | 20) & 0xFu; }
#define XB_SPIN(cond, bar) do { unsigned _sp = 0; while (cond) { __builtin_amdgcn_s_sleep(1); \
    if ((++_sp & 255u) == 0u) { if (xb_ld(&(bar)[XB_TMO])) break; if (_sp > XB_SPIN_CAP) { atomicAdd(&(bar)[XB_TMO], 1u); break; } } } } while (0)
struct XcdBarrier { unsigned* bar; unsigned x; volatile LAS unsigned* st; };
__device__ __forceinline__ XcdBarrier xcd_barrier_post(unsigned* bar, volatile LAS unsigned* st) {
  XcdBarrier b; b.bar = bar; b.x = xb_xcc_id(); b.st = st;
  if (threadIdx.x == 0) (void)xb_add(&bar[XB_XCNT(b.x)], 1u);
  return b;
}
__device__ __forceinline__ void xcd_barrier_complete(unsigned* bar, unsigned x, unsigned& nloc, unsigned& nx) {
  const unsigned G = gridDim.x * gridDim.y * gridDim.z;
  unsigned sum, cnt, mine, sp = 0u;
  for (;;) {
    sum = 0u; cnt = 0u; mine = 0u;
#pragma unroll
    for (unsigned j = 0; j < 16; ++j) { const unsigned c = xb_ld(&bar[XB_XCNT(j)]); sum += c; cnt += (c > 0u) ? 1u : 0u; mine = (j == x) ? c : mine; }
    if (sum == G) break;
    __builtin_amdgcn_s_sleep(1);
    if ((++sp & 255u) == 0u) { if (xb_ld(&bar[XB_TMO])) break; if (sp > XB_SPIN_CAP) { atomicAdd(&bar[XB_TMO], 1u); break; } }
  }
  nloc = mine > 0u ? mine : 1u; nx = cnt > 0u ? cnt : 1u;
}
__device__ __forceinline__ void xcd_barrier(const XcdBarrier& b) {
  asm volatile("s_waitcnt vmcnt(0)" ::: "memory");
  __syncthreads();
  if (threadIdx.x == 0) {
    unsigned* bar = b.bar;
    __builtin_amdgcn_s_waitcnt(0);
    unsigned nloc = b.st[0], nx = b.st[1];
    if (nloc == 0u) { xcd_barrier_complete(bar, b.x, nloc, nx); b.st[0] = nloc; b.st[1] = nx; }
    const unsigned old = xb_add(&bar[XB_XSUB(b.x)], 1u);
    const unsigned gen = old / nloc;
    if (old + 1u == (gen + 1u) * nloc) {
      __builtin_amdgcn_fence(__ATOMIC_RELEASE, "agent");
      asm volatile("s_waitcnt vmcnt(0)" ::: "memory");
      const unsigned og = xb_add(&bar[XB_TOP], 1u);
      const unsigned tg = og / nx;
      if (og + 1u == (tg + 1u) * nx) xb_add(&bar[XB_TOPGEN], 1u);
      else XB_SPIN(xb_ld(&bar[XB_TOPGEN]) == tg, bar);
      __builtin_amdgcn_fence(__ATOMIC_ACQUIRE, "agent");
      xb_add(&bar[XB_XGEN(b.x)], 1u);
      asm volatile("s_waitcnt vmcnt(0)" ::: "memory");
    } else {
      XB_SPIN(xb_ld(&bar[XB_XGEN(b.x)]) == gen, bar);
      __builtin_amdgcn_fence(__ATOMIC_ACQUIRE, "agent");
      asm volatile("s_waitcnt vmcnt(0)" ::: "memory");
    }
  }
  __syncthreads();
}

__device__ __forceinline__ void wt_block(const float* __restrict__ src, int ld, int K, u16* __restrict__ dst, const float* __restrict__ kscale,
                         float* lds) {
  const int t = VTID;
  for (int k0 = 0; k0 < K; k0 += 64) {
    {
      int n = t & 31, kk = t >> 5;
#pragma unroll
      for (int i = 0; i < 8; ++i) {
        int k = kk + 8 * i;
        float v = src[(size_t)(k0 + k) * ld + n];
        if (kscale) v *= kscale[k0 + k];
        lds[k * 33 + n] = v;
      }
    }
    __syncthreads();
    {
      int kp = t & 31, nn = t >> 5;
#pragma unroll
      for (int i = 0; i < 4; ++i) {
        int n = nn + 8 * i;
        unsigned v = pack2(lds[(2 * kp) * 33 + n], lds[(2 * kp + 1) * 33 + n]);
        *reinterpret_cast<unsigned*>(dst + (size_t)n * K + k0 + 2 * kp) = v;
      }
    }
    __syncthreads();
  }
}

__device__ __forceinline__ void wt_chunk(const float* __restrict__ src, int ld, int K, u16* __restrict__ dst, const float* __restrict__ kscale, float* lds, int k0) {
  const int t = VTID;
  {
    const int n = t & 31, kk = t >> 5;
    float v[32];
#pragma unroll
    for (int i = 0; i < 32; ++i) v[i] = src[(size_t)(k0 + kk + 8 * i) * ld + n];
    if (kscale) {
#pragma unroll
      for (int i = 0; i < 32; ++i) v[i] *= kscale[k0 + kk + 8 * i];
    }
#pragma unroll
    for (int i = 0; i < 32; ++i) lds[(kk + 8 * i) * 33 + n] = v[i];
  }
  __syncthreads();
  {
    const int kp = t & 127, nn = t >> 7;
#pragma unroll
    for (int i = 0; i < 16; ++i) {
      const int n = nn + 2 * i;
      *reinterpret_cast<unsigned*>(dst + (size_t)n * K + k0 + 2 * kp) = pack2(lds[(2 * kp) * 33 + n], lds[(2 * kp + 1) * 33 + n]);
    }
  }
  __syncthreads();
}

__device__ __forceinline__ void phase_prep(const Params& p, char* smem, int bid, int nb) {
  float* wab = reinterpret_cast<float*>(smem);
  float* tl = reinterpret_cast<float*>(smem + 32768);
  const int t = VTID, lane = t & 63, w = t >> 6;
  for (int i = t; i < 8192; i += NTHR) wab[i] = p.w_in[(size_t)(i >> 3) * NIN + 1536 + (i & 7)];
  for (int i = bid * NTHR + t; i < TT; i += nb * NTHR) reinterpret_cast<float*>(p.ws + SM_ROWSS)[i] = 0.f;
  __syncthreads();
  const int NWT = 384 + 384 + 64 + 64 + 128;
  const int NROW = TT / 4;
  for (int item = bid; item < NWT + NROW; item += nb) {
    if (item < NWT) {
      if (item < 384) {
        int n = (item >> 2) * 32, k0 = (item & 3) * 256;
        int col = n < 1536 ? n : 2056 + (n - 1536);
        wt_chunk(p.w_in + col, NIN, 1024, reinterpret_cast<u16*>(p.ws + W_MAIN) + (size_t)n * 1024, nullptr, tl, k0);
      } else if (item < 768) {
        int n = ((item - 384) >> 2) * 32, k0 = (item & 3) * 256;
        int col = n < 2048 ? 4104 + n : (n < 2560 ? 1544 + (n - 2048) : 3592 + (n - 2560));
        wt_chunk(p.w_in + col, NIN, 1024, reinterpret_cast<u16*>(p.ws + W_G2) + (size_t)n * 1024, nullptr, tl, k0);
      } else if (item < 832) {
        int n = ((item - 768) >> 1) * 32, k0 = (item & 1) * 256;
        wt_chunk(p.w_branch_a + n, 1024, 512, reinterpret_cast<u16*>(p.ws + W_A) + (size_t)n * 512, nullptr, tl, k0);
      } else if (item < 896) {
        int n = ((item - 832) >> 1) * 32, k0 = (item & 1) * 256;
        wt_chunk(p.w_branch_b + n, 1024, 512, reinterpret_cast<u16*>(p.ws + W_B) + (size_t)n * 512, nullptr, tl, k0);
      } else {
        int n = ((item - 896) >> 2) * 32, k0 = (item & 3) * 256;
        wt_chunk(p.w_out + n, 1024, 1024, reinterpret_cast<u16*>(p.ws + W_OUT) + (size_t)n * 1024, nullptr, tl, k0);
      }
    } else {
      int row = (item - NWT) * 4 + w;
      const float* x = row < TP ? p.x_prompt + (size_t)row * DM : p.x_sample + (size_t)(row - TP) * DM;
      float4 xv[4];
      float ss = 0.f;
#pragma unroll
      for (int i = 0; i < 4; ++i) {
        xv[i] = *reinterpret_cast<const float4*>(x + i * 256 + lane * 4);
        ss += xv[i].x * xv[i].x + xv[i].y * xv[i].y + xv[i].z * xv[i].z + xv[i].w * xv[i].w;
      }
      ss = wave_sum(ss);
      float rstd = rsqrtf(ss * (1.f / DM) + EPS);
      float dot[8];
#pragma unroll
      for (int c = 0; c < 8; ++c) dot[c] = 0.f;
      u16* hrow = reinterpret_cast<u16*>(reinterpret_cast<char*>(p.out) + YB_H) + (size_t)row * DM;
#pragma unroll
      for (int i = 0; i < 4; ++i) {
        int k = i * 256 + lane * 4;
        float4 g = *reinterpret_cast<const float4*>(p.g_attn + k);
        float h0 = xv[i].x * rstd * g.x, h1 = xv[i].y * rstd * g.y, h2 = xv[i].z * rstd * g.z, h3 = xv[i].w * rstd * g.w;
        *reinterpret_cast<uint2*>(hrow + k) = make_uint2(pack2(h0, h1), pack2(h2, h3));
        float hh[4] = {h0, h1, h2, h3};
#pragma unroll
        for (int j = 0; j < 4; ++j) {
          float4 wa = *reinterpret_cast<const float4*>(wab + (k + j) * 8);
          float4 wb = *reinterpret_cast<const float4*>(wab + (k + j) * 8 + 4);
          dot[0] += hh[j] * wa.x; dot[1] += hh[j] * wa.y; dot[2] += hh[j] * wa.z; dot[3] += hh[j] * wa.w;
          dot[4] += hh[j] * wb.x; dot[5] += hh[j] * wb.y; dot[6] += hh[j] * wb.z; dot[7] += hh[j] * wb.w;
        }
      }
#pragma unroll
      for (int c = 0; c < 8; ++c) dot[c] = wave_sum(dot[c]);
      if (lane < 4) {
        float aa = lane == 0 ? dot[0] : lane == 1 ? dot[1] : lane == 2 ? dot[2] : dot[3];
        float xx = aa + p.dt_bias[lane];
        float sp = xx > 20.f ? xx : log1pf(__expf(xx));
        reinterpret_cast<float*>(p.ws + SM_GDEC)[(size_t)row * 4 + lane] = -__expf(p.a_log[lane]) * sp;
      } else if (lane < 8) {
        float ba = lane == 4 ? dot[4] : lane == 5 ? dot[5] : lane == 6 ? dot[6] : dot[7];
        reinterpret_cast<float*>(p.ws + SM_BETA)[(size_t)row * 4 + lane - 4] = sigmoid_f(ba);
      }
    }
  }
}

enum { EPI_Z1 = 0, EPI_Z2 = 1, EPI_MIXA = 2, EPI_MIXB = 3, EPI_WOUT = 4, EPI_FFN1 = 5, EPI_FFN2 = 6, EPI_FFN2S = 7, EPI_FFN1S = 8 };
namespace pg8 {
constexpr int BM = 256, BK = 64, HALF = 128, HTB = HALF * BK * 2, STAGE_BYTES = 8 * HTB, NXCD = 8, WGM = 8;
__device__ __forceinline__ int lds_byte(int r, int c) { const int st = (r >> 4) * 2 + (c >> 5), rr = r & 15, cc = c & 31, ob = rr * 64 + cc * 2; return st * 1024 + (ob ^ (((ob >> 9) & 1) << 5)); }
__device__ __forceinline__ void stage_rc(int b, int& R, int& C) { const int st = b / 1024, sb = b % 1024, swz = sb ^ (((sb >> 9) & 1) << 5); R = (st >> 1) * 16 + swz / 64; C = (st & 1) * 32 + (swz % 64) / 2; }
__device__ __forceinline__ int perm32(int rho) { const int n = rho >> 4, i = rho & 15; return 8 * (i >> 2) + 4 * n + (i & 3); }
struct Unit { int pm, pn, ks; };
struct StaticOrder {
  int nM, nN, nwg, G, c;
  __device__ void init(int M, int N, int G_, int c_) { nM = M / BM; nN = N / BM; nwg = nM * nN; G = G_; c = c_; }
  __device__ bool next(int i, Unit& u) const {
    const long L = (long)i * G + c; if (L >= nwg) return false;
    int wgid = (int)L; { const int q = nwg / NXCD, r = nwg % NXCD, xcd = wgid % NXCD, off = wgid / NXCD; wgid = (xcd < r ? xcd * (q + 1) : r * (q + 1) + (xcd - r) * q) + off; }
    const int nig = WGM * nN, gid = wgid / nig, fm = gid * WGM, gsz = (nM - fm) < WGM ? (nM - fm) : WGM;
    u.pm = fm + ((wgid % nig) % gsz); u.pn = (wgid % nig) / gsz; return true;
  }
};
struct SchedStatic {
  StaticOrder S; int pm0;
  __device__ void init(int M, int N, int G, int c, int pm0_) { S.init(M, N, G, c); pm0 = pm0_; }
  __device__ bool next(int i, Unit& u) const { if (S.c >= S.G || !S.next(i, u)) return false; u.pm += pm0; u.ks = 0; return true; }
};
struct SchedSplit {
  int nN, nS, pm0, G, c, total;
  __device__ void init(int nM, int nN_, int nS_, int G_, int c_, int pm0_) { nN = nN_; nS = nS_; pm0 = pm0_; G = G_; c = c_; total = nM * nN_ * nS_; }
  __device__ bool next(int i, Unit& u) const {
    const int L = i * G + c; if (c >= G || L >= total) return false;
    u.ks = L % nS; const int t = L / nS; u.pn = t % nN; u.pm = pm0 + t / nN; return true;
  }
};
}

__device__ __forceinline__ float dpp_ror1(float v) { return __int_as_float(__builtin_amdgcn_update_dpp(0, __float_as_int(v), 0x121, 0xf, 0xf, false)); }
__device__ __forceinline__ float dpp_ror2(float v) { return __int_as_float(__builtin_amdgcn_update_dpp(0, __float_as_int(v), 0x122, 0xf, 0xf, false)); }

template <int MODE>
__device__ __forceinline__ void gemm_epilogue(const Params& p, f32x4 (&acc)[2][2][4][2], const pg8::Unit& u, int wr, int wc, int fr, int fq) {
  const int row0 = u.pm * 256 + wr * 64 + fr, col0 = u.pn * 256 + wc * 32 + 8 * fq;
  if constexpr (MODE == EPI_Z1 || MODE == EPI_Z2) {
#pragma unroll
    for (int ai = 0; ai < 2; ++ai)
#pragma unroll
      for (int m = 0; m < 4; ++m) {
        const int row = row0 + ai * 128 + m * 16;
        u16* rowp = (MODE == EPI_Z1 ? reinterpret_cast<u16*>(p.ws + Z1) + (size_t)row * 3072 : const_cast<u16*>(z2row(p, row))) + col0;
#pragma unroll
        for (int bj = 0; bj < 2; ++bj) {
          const f32x4 v0 = acc[ai][bj][m][0], v1 = acc[ai][bj][m][1];
          *reinterpret_cast<uint4*>(rowp + bj * 128) = make_uint4(pack2(v0[0], v0[1]), pack2(v0[2], v0[3]), pack2(v1[0], v1[1]), pack2(v1[2], v1[3]));
        }
        if (MODE == EPI_Z1 && u.pn < 6) {
          float* dst = nullptr;
          if (row < TP) {
            int pos = row & 2047;
            if (pos >= 2045) dst = p.out + O_CONVP + (size_t)((row >> 11) * 3 + pos - 2045) * 1536 + col0;
          } else {
            int pos = (row - TP) & 3;
            if (pos >= 1) dst = p.out + O_CONVS + (size_t)(((row - TP) >> 2) * 3 + pos - 1) * 1536 + col0;
          }
          if (dst) {
#pragma unroll
            for (int bj = 0; bj < 2; ++bj) {
              const f32x4 v0 = acc[ai][bj][m][0], v1 = acc[ai][bj][m][1];
              *reinterpret_cast<float4*>(dst + bj * 128) = make_float4(v0[0], v0[1], v0[2], v0[3]);
              *reinterpret_cast<float4*>(dst + bj * 128 + 4) = make_float4(v1[0], v1[1], v1[2], v1[3]);
            }
          }
        }
      }
  } else if constexpr (MODE == EPI_MIXA || MODE == EPI_MIXB) {
    u16* Mx = reinterpret_cast<u16*>(p.ws + MIX);
#pragma unroll
    for (int ai = 0; ai < 2; ++ai)
#pragma unroll
      for (int m = 0; m < 4; ++m) {
        const int row = row0 + ai * 128 + m * 16;
#pragma unroll
        for (int bj = 0; bj < 2; ++bj) {
          const int col = col0 + bj * 128;
          const uint4 gv = *reinterpret_cast<const uint4*>(z2row(p, row) + (MODE == EPI_MIXB ? 1024 : 0) + col);
          u16* mp = Mx + (size_t)row * 1024 + col;
          const f32x4 v0 = acc[ai][bj][m][0], v1 = acc[ai][bj][m][1];
          float r0 = v0[0] * sigmoid_f(lo2f(gv.x)), r1 = v0[1] * sigmoid_f(hi2f(gv.x));
          float r2 = v0[2] * sigmoid_f(lo2f(gv.y)), r3 = v0[3] * sigmoid_f(hi2f(gv.y));
          float r4 = v1[0] * sigmoid_f(lo2f(gv.z)), r5 = v1[1] * sigmoid_f(hi2f(gv.z));
          float r6 = v1[2] * sigmoid_f(lo2f(gv.w)), r7 = v1[3] * sigmoid_f(hi2f(gv.w));
          if (MODE == EPI_MIXB) {
            const uint4 mv = *reinterpret_cast<const uint4*>(mp);
            r0 += lo2f(mv.x); r1 += hi2f(mv.x); r2 += lo2f(mv.y); r3 += hi2f(mv.y);
            r4 += lo2f(mv.z); r5 += hi2f(mv.z); r6 += lo2f(mv.w); r7 += hi2f(mv.w);
          }
          *reinterpret_cast<uint4*>(mp) = make_uint4(pack2(r0, r1), pack2(r2, r3), pack2(r4, r5), pack2(r6, r7));
        }
        asm volatile("" ::: "memory");
      }
  } else if constexpr (MODE == EPI_WOUT) {
    float* rowss = reinterpret_cast<float*>(p.ws + SM_ROWSS);
    u16* XB = reinterpret_cast<u16*>(p.ws + X1B);
#pragma unroll
    for (int ai = 0; ai < 2; ++ai)
#pragma unroll
      for (int m = 0; m < 4; ++m) {
        const int row = row0 + ai * 128 + m * 16;
        const float* x = (row < TP ? p.x_prompt + (size_t)row * DM : p.x_sample + (size_t)(row - TP) * DM) + col0;
        float* y = p.out + O_YP + (size_t)row * DM + col0;
        float ss = 0.f;
#pragma unroll
        for (int bj = 0; bj < 2; ++bj) {
          const float4 x0 = *reinterpret_cast<const float4*>(x + bj * 128), x1 = *reinterpret_cast<const float4*>(x + bj * 128 + 4);
          const f32x4 a0 = acc[ai][bj][m][0], a1 = acc[ai][bj][m][1];
          const float4 v0 = make_float4(a0[0] + x0.x, a0[1] + x0.y, a0[2] + x0.z, a0[3] + x0.w);
          const float4 v1 = make_float4(a1[0] + x1.x, a1[1] + x1.y, a1[2] + x1.z, a1[3] + x1.w);
          *reinterpret_cast<float4*>(y + bj * 128) = v0;
          *reinterpret_cast<float4*>(y + bj * 128 + 4) = v1;
          *reinterpret_cast<uint4*>(XB + (size_t)row * DM + col0 + bj * 128) =
              make_uint4(pack2(v0.x, v0.y), pack2(v0.z, v0.w), pack2(v1.x, v1.y), pack2(v1.z, v1.w));
          ss += v0.x * v0.x + v0.y * v0.y + v0.z * v0.z + v0.w * v0.w + v1.x * v1.x + v1.y * v1.y + v1.z * v1.z + v1.w * v1.w;
        }
        ss += __shfl_xor(ss, 16, 64);
        ss += __shfl_xor(ss, 32, 64);
        if (fq == 0) atomicAdd(rowss + row, ss);
        asm volatile("" ::: "memory");
      }
  } else if constexpr (MODE == EPI_FFN2) {
#pragma unroll
    for (int ai = 0; ai < 2; ++ai)
#pragma unroll
      for (int m = 0; m < 4; ++m) {
        float* y = p.out + O_YP + (size_t)(row0 + ai * 128 + m * 16) * DM + col0;
#pragma unroll
        for (int bj = 0; bj < 2; ++bj) {
          float4 y0 = *reinterpret_cast<const float4*>(y + bj * 128), y1 = *reinterpret_cast<const float4*>(y + bj * 128 + 4);
          const f32x4 a0 = acc[ai][bj][m][0], a1 = acc[ai][bj][m][1];
          y0.x += a0[0]; y0.y += a0[1]; y0.z += a0[2]; y0.w += a0[3];
          y1.x += a1[0]; y1.y += a1[1]; y1.z += a1[2]; y1.w += a1[3];
          *reinterpret_cast<float4*>(y + bj * 128) = y0;
          *reinterpret_cast<float4*>(y + bj * 128 + 4) = y1;
        }
        asm volatile("" ::: "memory");
      }
  } else if constexpr (MODE == EPI_FFN2S) {
    float* part = reinterpret_cast<float*>(p.ws + PART) + (size_t)u.ks * TS * 1024;
#pragma unroll
    for (int ai = 0; ai < 2; ++ai)
#pragma unroll
      for (int m = 0; m < 4; ++m) {
        float* y = part + (size_t)(row0 + ai * 128 + m * 16 - TP) * 1024 + col0;
#pragma unroll
        for (int bj = 0; bj < 2; ++bj) {
          const f32x4 a0 = acc[ai][bj][m][0], a1 = acc[ai][bj][m][1];
          *reinterpret_cast<float4*>(y + bj * 128) = make_float4(a0[0], a0[1], a0[2], a0[3]);
          *reinterpret_cast<float4*>(y + bj * 128 + 4) = make_float4(a1[0], a1[1], a1[2], a1[3]);
        }
      }
  } else if constexpr (MODE == EPI_FFN1 || MODE == EPI_FFN1S) {
    const float* rowss = reinterpret_cast<const float*>(p.ws + SM_ROWSS);
    u16* ACTp = reinterpret_cast<u16*>(p.ws + ACT);
    float* haloG = reinterpret_cast<float*>(p.ws + HALO_G);
    float* headG = reinterpret_cast<float*>(p.ws + HEAD_G);
    float* headU = reinterpret_cast<float*>(p.ws + HEAD_U);
    const int ch = u.pn * 128 + wc * 32 + 8 * fq;
    float w0[8], w1[8], w2[8];
#pragma unroll
    for (int c = 0; c < 8; ++c) { w0[c] = p.w_ffn_conv[ch + c]; w1[c] = p.w_ffn_conv[DFF + ch + c]; w2[c] = p.w_ffn_conv[2 * DFF + ch + c]; }
    if constexpr (MODE == EPI_FFN1) {
#pragma unroll
      for (int ai = 0; ai < 2; ++ai) {
        const int blk = u.pm * 4 + ai * 2 + wr;
        const bool seqstart = (blk & 31) == 0, seqend = (blk & 31) == 31;
        float gprev[8];
#pragma unroll
        for (int c = 0; c < 8; ++c) gprev[c] = 0.f;
#pragma unroll
        for (int m = 0; m < 4; ++m) {
          const int row = row0 + ai * 128 + m * 16;
          const float rs = rsqrtf(rowss[row] * (1.f / DM) + EPS);
          float g0[8], uu[8];
#pragma unroll
          for (int c = 0; c < 4; ++c) {
            g0[c] = acc[ai][0][m][0][c] * rs; g0[4 + c] = acc[ai][0][m][1][c] * rs;
            uu[c] = acc[ai][1][m][0][c] * rs; uu[4 + c] = acc[ai][1][m][1][c] * rs;
          }
          float r[8];
#pragma unroll
          for (int c = 0; c < 8; ++c) {
            float gm1 = __int_as_float(__builtin_amdgcn_update_dpp(__float_as_int(dpp_ror1(gprev[c])), __float_as_int(g0[c]), 0x111, 0xf, 0xf, false));
            float gm2 = __int_as_float(__builtin_amdgcn_update_dpp(__float_as_int(dpp_ror2(gprev[c])), __float_as_int(g0[c]), 0x112, 0xf, 0xf, false));
            r[c] = silu_f(w0[c] * gm2 + w1[c] * gm1 + w2[c] * g0[c]) * uu[c];
          }
          bool defer = false;
          if (m == 0) {
            defer = !seqstart && fr < 2;
            if (defer) {
              float* dg = headG + (size_t)(blk * 2 + fr) * DFF + ch;
              float* du = headU + (size_t)(blk * 2 + fr) * DFF + ch;
              *reinterpret_cast<float4*>(dg) = make_float4(g0[0], g0[1], g0[2], g0[3]);
              *reinterpret_cast<float4*>(dg + 4) = make_float4(g0[4], g0[5], g0[6], g0[7]);
              *reinterpret_cast<float4*>(du) = make_float4(uu[0], uu[1], uu[2], uu[3]);
              *reinterpret_cast<float4*>(du + 4) = make_float4(uu[4], uu[5], uu[6], uu[7]);
            }
          }
          if (m == 3) {
            if (fr >= 14) {
              float* d = haloG + (size_t)(blk * 2 + fr - 14) * DFF + ch;
              *reinterpret_cast<float4*>(d) = make_float4(g0[0], g0[1], g0[2], g0[3]);
              *reinterpret_cast<float4*>(d + 4) = make_float4(g0[4], g0[5], g0[6], g0[7]);
              if (seqend) {
                float* o = p.out + O_FFNP + (size_t)((row >> 11) * 2 + fr - 14) * DFF + ch;
                *reinterpret_cast<float4*>(o) = make_float4(g0[0], g0[1], g0[2], g0[3]);
                *reinterpret_cast<float4*>(o + 4) = make_float4(g0[4], g0[5], g0[6], g0[7]);
              }
            }
          }
          if (!defer)
            *reinterpret_cast<uint4*>(ACTp + (size_t)row * DFF + ch) = make_uint4(pack2(r[0], r[1]), pack2(r[2], r[3]), pack2(r[4], r[5]), pack2(r[6], r[7]));
#pragma unroll
          for (int c = 0; c < 8; ++c) gprev[c] = g0[c];
          asm volatile("" ::: "memory");
        }
      }
    } else {
#pragma unroll
    for (int ai = 0; ai < 2; ++ai) {
      const int blk = u.pm * 4 + ai * 2 + wr;
      float gprev[8];
#pragma unroll
      for (int c = 0; c < 8; ++c) gprev[c] = 0.f;
#pragma unroll
      for (int m = 0; m < 4; ++m) {
        const int row = row0 + ai * 128 + m * 16;
        const int r64 = m * 16 + fr;
        const float rs = rsqrtf(rowss[row] * (1.f / DM) + EPS);
        float g0[8], uu[8];
#pragma unroll
        for (int c = 0; c < 4; ++c) {
          g0[c] = acc[ai][0][m][0][c] * rs; g0[4 + c] = acc[ai][0][m][1][c] * rs;
          uu[c] = acc[ai][1][m][0][c] * rs; uu[4 + c] = acc[ai][1][m][1][c] * rs;
        }
        const bool prompt = row < TP;
        int pos, b;
        if (prompt) { pos = row & 2047; b = row >> 11; } else { pos = (row - TP) & 3; b = (row - TP) >> 2; }
        const bool defer = (pos >= 1 && r64 < 1) || (pos >= 2 && r64 < 2);
        float gm1[8], gm2[8];
#pragma unroll
        for (int c = 0; c < 8; ++c) {
          float a1 = dpp_ror1(g0[c]), b1 = dpp_ror1(gprev[c]);
          float a2 = dpp_ror2(g0[c]), b2 = dpp_ror2(gprev[c]);
          gm1[c] = fr >= 1 ? a1 : b1;
          gm2[c] = fr >= 2 ? a2 : b2;
        }
        if (pos < 1) {
#pragma unroll
          for (int c = 0; c < 8; ++c) gm1[c] = prompt ? 0.f : p.cache_ffn[(size_t)(b * 2 + 1) * DFF + ch + c];
        }
        if (pos < 2) {
#pragma unroll
          for (int c = 0; c < 8; ++c) gm2[c] = prompt ? 0.f : p.cache_ffn[(size_t)(b * 2 + pos) * DFF + ch + c];
        }
        if (r64 >= 62) {
          float* d = haloG + (size_t)(blk * 2 + r64 - 62) * DFF + ch;
          *reinterpret_cast<float4*>(d) = make_float4(g0[0], g0[1], g0[2], g0[3]);
          *reinterpret_cast<float4*>(d + 4) = make_float4(g0[4], g0[5], g0[6], g0[7]);
        }
        {
          float* d = nullptr;
          if (prompt) { if (pos >= 2046) d = p.out + O_FFNP + (size_t)(b * 2 + pos - 2046) * DFF + ch; }
          else { if (pos >= 2) d = p.out + O_FFNS + (size_t)(b * 2 + pos - 2) * DFF + ch; }
          if (d) {
            *reinterpret_cast<float4*>(d) = make_float4(g0[0], g0[1], g0[2], g0[3]);
            *reinterpret_cast<float4*>(d + 4) = make_float4(g0[4], g0[5], g0[6], g0[7]);
          }
        }
        if (defer) {
          float* dg = headG + (size_t)(blk * 2 + r64) * DFF + ch;
          float* du = headU + (size_t)(blk * 2 + r64) * DFF + ch;
          *reinterpret_cast<float4*>(dg) = make_float4(g0[0], g0[1], g0[2], g0[3]);
          *reinterpret_cast<float4*>(dg + 4) = make_float4(g0[4], g0[5], g0[6], g0[7]);
          *reinterpret_cast<float4*>(du) = make_float4(uu[0], uu[1], uu[2], uu[3]);
          *reinterpret_cast<float4*>(du + 4) = make_float4(uu[4], uu[5], uu[6], uu[7]);
        } else {
          float r[8];
#pragma unroll
          for (int c = 0; c < 8; ++c) r[c] = silu_f(w0[c] * gm2[c] + w1[c] * gm1[c] + w2[c] * g0[c]) * uu[c];
          *reinterpret_cast<uint4*>(ACTp + (size_t)row * DFF + ch) = make_uint4(pack2(r[0], r[1]), pack2(r[2], r[3]), pack2(r[4], r[5]), pack2(r[6], r[7]));
        }
#pragma unroll
        for (int c = 0; c < 8; ++c) gprev[c] = g0[c];
        asm volatile("" ::: "memory");
      }
    }
    }
  }
}

template <int MODE, class Sched>
__device__ __forceinline__ void gemm_phase8(const Params& p, const u16* Ag, const u16* Btg, int ld, int Kunit, LAS unsigned char* lds, const Sched& S) {
  using namespace pg8;
  const int tid = threadIdx.x, wid = __builtin_amdgcn_readfirstlane(tid >> 6), lane = tid & 63, wr = wid >> 2, wc = wid & 3, fr = lane & 15, fq = lane >> 4;
  const int nt = Kunit / BK;
  unsigned voffA[2], voffB[2];
#pragma unroll
  for (int i = 0; i < 2; ++i) { int R, C; stage_rc(tid * 16 + i * 8192, R, C); const int Rb = (R & ~31) + perm32(R & 31);
    voffA[i] = (unsigned)(R * ld + C) * 2u; voffB[i] = (unsigned)(Rb * ld + C) * 2u; }
  const size_t kstep = (size_t)(BK * 2);
  const size_t hstep = (size_t)HALF * ld * 2;
  const size_t tstep = 2 * hstep;
  const size_t kub = (size_t)Kunit * 2;
  const unsigned ldsw = (unsigned)wid * 1024u;
  const int aoff = lds_byte(wr * 64 + fr, fq * 8), boff = lds_byte(wc * 32 + fr, fq * 8);
#define PG8_SA(b, h) (((b) * 2 + (h)) * HTB)
#define PG8_SB(b, h) ((4 + (b) * 2 + (h)) * HTB)
#define PG8_STAGE(bufoff, gbase, voff) do { _Pragma("unroll") for (int _i = 0; _i < 2; ++_i) \
    __builtin_amdgcn_global_load_lds((const unsigned*)((const char*)(gbase) + (voff)[_i]), (LAS unsigned*)(lds + (bufoff) + ldsw + _i * 8192), 16, 0, 0); } while (0)
#define PG8_LDA(dst, b, h) do { _Pragma("unroll") for (int m = 0; m < 4; ++m) _Pragma("unroll") for (int k = 0; k < 2; ++k) dst[m][k] = *(const LAS bf16x8*)(lds + PG8_SA(b, h) + aoff + m * 2048 + k * 1024); } while (0)
#define PG8_LDB(dst, b, h) do { _Pragma("unroll") for (int n = 0; n < 2; ++n) _Pragma("unroll") for (int k = 0; k < 2; ++k) dst[n][k] = *(const LAS bf16x8*)(lds + PG8_SB(b, h) + boff + n * 2048 + k * 1024); } while (0)
#define PG8_MMA(ai, bj, At, Bt) do { __builtin_amdgcn_s_setprio(1); _Pragma("unroll") for (int m = 0; m < 4; ++m) _Pragma("unroll") for (int n = 0; n < 2; ++n) _Pragma("unroll") for (int k = 0; k < 2; ++k) \
    acc[ai][bj][m][n] = __builtin_amdgcn_mfma_f32_16x16x32_bf16(Bt[n][k], At[m][k], acc[ai][bj][m][n], 0, 0, 0); __builtin_amdgcn_s_setprio(0); } while (0)
#define PG8_WAIT_V(n) asm volatile("s_waitcnt vmcnt(" #n ")" ::: "memory")
#define PG8_WAIT_L(n) asm volatile("s_waitcnt lgkmcnt(" #n ")" ::: "memory")
#define PG8_BAR __builtin_amdgcn_s_barrier()
#define PG8_SCHED __builtin_amdgcn_sched_barrier(0)
  Unit cur, nxt; int ui = 0;
  if (!S.next(0, cur)) return;
  f32x4 acc[2][2][4][2];
#pragma unroll
  for (int a = 0; a < 2; ++a)
#pragma unroll
    for (int b = 0; b < 2; ++b)
#pragma unroll
      for (int m = 0; m < 4; ++m)
#pragma unroll
        for (int n = 0; n < 2; ++n) acc[a][b][m][n] = (f32x4){0.f, 0.f, 0.f, 0.f};
  bf16x8 At[4][2], B0[2][2], B1[2][2];
  const char* cA = (const char*)Ag + (size_t)cur.pm * tstep + cur.ks * kub; const char* cB = (const char*)Btg + (size_t)cur.pn * tstep + cur.ks * kub;
  PG8_STAGE(PG8_SB(0, 0), cB, voffB); PG8_STAGE(PG8_SA(0, 0), cA, voffA); PG8_STAGE(PG8_SB(0, 1), cB + hstep, voffB); PG8_STAGE(PG8_SA(0, 1), cA + hstep, voffA);
  if (wr == 1) PG8_BAR;
  PG8_WAIT_V(4); PG8_BAR;
  PG8_STAGE(PG8_SB(1, 0), cB + kstep, voffB); PG8_STAGE(PG8_SA(1, 0), cA + kstep, voffA); PG8_STAGE(PG8_SB(1, 1), cB + hstep + kstep, voffB);
  PG8_WAIT_V(6); PG8_BAR;
  for (;;) {
    const bool has_next = S.next(ui + 1, nxt);
    const char* nA = has_next ? (const char*)Ag + (size_t)nxt.pm * tstep + nxt.ks * kub : cA; const char* nB = has_next ? (const char*)Btg + (size_t)nxt.pn * tstep + nxt.ks * kub : cB;
    for (int t = 0; t < nt; t += 2) {
      const bool last = (t == nt - 2);
      const char* a1 = cA + (size_t)(t + 1) * kstep;
      const char* a2 = last ? nA : cA + (size_t)(t + 2) * kstep; const char* b2 = last ? nB : cB + (size_t)(t + 2) * kstep;
      const char* a3 = a2 + kstep; const char* b3 = b2 + kstep;
      PG8_LDB(B0, 0, 0); PG8_SCHED; PG8_LDA(At, 0, 0); PG8_STAGE(PG8_SA(1, 1), a1 + hstep, voffA);
      PG8_WAIT_L(8); PG8_BAR; PG8_WAIT_L(0); PG8_MMA(0, 0, At, B0); PG8_BAR; PG8_SCHED;
      PG8_LDB(B1, 0, 1); PG8_STAGE(PG8_SB(0, 0), b2, voffB);
      PG8_BAR; PG8_WAIT_L(0); PG8_MMA(0, 1, At, B1); PG8_BAR;
      PG8_LDA(At, 0, 1); PG8_STAGE(PG8_SA(0, 0), a2, voffA);
      PG8_BAR; PG8_WAIT_L(0); PG8_MMA(1, 0, At, B0); PG8_BAR; PG8_SCHED;
      PG8_STAGE(PG8_SB(0, 1), b2 + hstep, voffB);
      PG8_WAIT_V(6); PG8_BAR; PG8_MMA(1, 1, At, B1); PG8_BAR;
      PG8_LDB(B0, 1, 0); PG8_SCHED; PG8_LDA(At, 1, 0); PG8_STAGE(PG8_SA(0, 1), a2 + hstep, voffA);
      PG8_WAIT_L(8); PG8_BAR; PG8_WAIT_L(0); PG8_MMA(0, 0, At, B0); PG8_BAR; PG8_SCHED;
      PG8_LDB(B1, 1, 1); PG8_STAGE(PG8_SB(1, 0), b3, voffB);
      PG8_BAR; PG8_WAIT_L(0); PG8_MMA(0, 1, At, B1); PG8_BAR;
      PG8_LDA(At, 1, 1); PG8_STAGE(PG8_SA(1, 0), a3, voffA);
      PG8_BAR; PG8_WAIT_L(0); PG8_MMA(1, 0, At, B0); PG8_BAR; PG8_SCHED;
      PG8_STAGE(PG8_SB(1, 1), b3 + hstep, voffB);
      PG8_WAIT_V(6); PG8_BAR; PG8_MMA(1, 1, At, B1); PG8_BAR;
    }
    gemm_epilogue<MODE>(p, acc, cur, wr, wc, fr, fq);
    if (!has_next) break;
#pragma unroll
    for (int a = 0; a < 2; ++a)
#pragma unroll
      for (int b = 0; b < 2; ++b)
#pragma unroll
        for (int m = 0; m < 4; ++m)
#pragma unroll
          for (int n = 0; n < 2; ++n) acc[a][b][m][n] = (f32x4){0.f, 0.f, 0.f, 0.f};
    cur = nxt; cA = nA; cB = nB; ++ui;
  }
  PG8_WAIT_V(0);
  if (wr == 0) PG8_BAR;
  PG8_BAR;
#undef PG8_SA
#undef PG8_SB
#undef PG8_STAGE
#undef PG8_LDA
#undef PG8_LDB
#undef PG8_MMA
#undef PG8_WAIT_V
#undef PG8_WAIT_L
#undef PG8_BAR
#undef PG8_SCHED
}


template <int PASS>
__device__ __forceinline__ void delta_rowpass(const Params& p, int t0, int n, int h, int w, int lane, float Gv, u16* RA, u16* RBk,
                                              u16* RC) {
  const u16* Zp = reinterpret_cast<const u16*>(p.ws + Z1);
  const float* betap = reinterpret_cast<const float*>(p.ws + SM_BETA);
  const int c1 = (PASS == 0 ? 0 : 512) + h * 128 + 2 * lane;
  const int c2 = (PASS == 0 ? 512 : 1024) + h * 128 + 2 * lane;
  float w1[4][2], w2[4][2];
#pragma unroll
  for (int j = 0; j < 4; ++j) {
    w1[j][0] = p.w_conv_a[j * 1536 + c1]; w1[j][1] = p.w_conv_a[j * 1536 + c1 + 1];
    w2[j][0] = p.w_conv_a[j * 1536 + c2]; w2[j][1] = p.w_conv_a[j * 1536 + c2 + 1];
  }
  const int r0 = 16 * w;
  const u16* zbase = Zp + (size_t)(t0 + r0) * 3072;
  float h1[3][2], h2[3][2];
#pragma unroll
  for (int j = 0; j < 3; ++j) {
    unsigned ua = 0u, ub = 0u;
    if (n * 64 + r0 + j - 3 >= 0) {
      ua = *reinterpret_cast<const unsigned*>(zbase + (ptrdiff_t)(j - 3) * 3072 + c1);
      ub = *reinterpret_cast<const unsigned*>(zbase + (ptrdiff_t)(j - 3) * 3072 + c2);
    }
    h1[j][0] = lo2f(ua); h1[j][1] = hi2f(ua); h2[j][0] = lo2f(ub); h2[j][1] = hi2f(ub);
  }
  unsigned qa0, qa1, qa2, qa3, qa4, qa5, qb0, qb1, qb2, qb3, qb4, qb5;
#define RLOAD(i, A_, B_) A_ = *reinterpret_cast<const unsigned*>(zbase + (size_t)(i) * 3072 + c1); B_ = *reinterpret_cast<const unsigned*>(zbase + (size_t)(i) * 3072 + c2);
  RLOAD(0, qa0, qb0) RLOAD(1, qa1, qb1) RLOAD(2, qa2, qb2) RLOAD(3, qa3, qb3) RLOAD(4, qa4, qb4) RLOAD(5, qa5, qb5)
#pragma unroll 1
  for (int rr = 0; rr < 16; ++rr) {
    const int r = r0 + rr;
    const unsigned ua = qa0, ub = qb0;
    qa0 = qa1; qa1 = qa2; qa2 = qa3; qa3 = qa4; qa4 = qa5;
    qb0 = qb1; qb1 = qb2; qb2 = qb3; qb3 = qb4; qb4 = qb5;
    if (rr + 6 < 16) { RLOAD(rr + 6, qa5, qb5) }
    const float a0 = lo2f(ua), a1 = hi2f(ua), b0 = lo2f(ub), b1 = hi2f(ub);
    float y10 = silu_f(w1[0][0] * h1[0][0] + w1[1][0] * h1[1][0] + w1[2][0] * h1[2][0] + w1[3][0] * a0);
    float y11 = silu_f(w1[0][1] * h1[0][1] + w1[1][1] * h1[1][1] + w1[2][1] * h1[2][1] + w1[3][1] * a1);
    float y20 = silu_f(w2[0][0] * h2[0][0] + w2[1][0] * h2[1][0] + w2[2][0] * h2[2][0] + w2[3][0] * b0);
    float y21 = silu_f(w2[0][1] * h2[0][1] + w2[1][1] * h2[1][1] + w2[2][1] * h2[2][1] + w2[3][1] * b1);
    const float bt = betap[(size_t)(t0 + r) * 4 + h];
    if (PASS == 0) {
      float qs = wave_sum(y10 * y10 + y11 * y11), ks = wave_sum(y20 * y20 + y21 * y21);
      float qn = rsqrtf(qs + EPS) * 0.08838834764831845f, kn = rsqrtf(ks + EPS);
      float k0 = y20 * kn, k1 = y21 * kn;
      *reinterpret_cast<unsigned*>(RA + r * 136 + 2 * lane) = pack2(k0, k1);
      *reinterpret_cast<unsigned*>(RBk + r * 136 + 2 * lane) = pack2(k0 * bt, k1 * bt);
      *reinterpret_cast<unsigned*>(RC + r * 136 + 2 * lane) = pack2(y10 * qn, y11 * qn);
    } else {
      float ks = wave_sum(y10 * y10 + y11 * y11);
      float sc = rsqrtf(ks + EPS) * bt * __expf(__shfl(Gv, r, 64));
      RA[(2 * lane) * 72 + r] = f2bf(y10 * sc);
      RA[(2 * lane + 1) * 72 + r] = f2bf(y11 * sc);
      RC[(2 * lane) * 72 + r] = f2bf(y20 * bt);
      RC[(2 * lane + 1) * 72 + r] = f2bf(y21 * bt);
    }
#pragma unroll
    for (int c = 0; c < 2; ++c) {
      h1[0][c] = h1[1][c]; h1[1][c] = h1[2][c];
      h2[0][c] = h2[1][c]; h2[1][c] = h2[2][c];
    }
    h1[2][0] = a0; h1[2][1] = a1; h2[2][0] = b0; h2[2][1] = b1;
  }
#undef RLOAD
}

__device__ __forceinline__ void m1_delta_item(const Params& p, int item, char* smem) {
  const int tid = VTID, lane = tid & 63, w = tid >> 6, lr = lane & 15, lq = lane >> 4;
  const int h = item & 3, n = (item >> 2) & 31, b = item >> 7;
  const int t0 = b * 2048 + n * 64;
  u16* RA = reinterpret_cast<u16*>(smem);
  u16* RBk = reinterpret_cast<u16*>(smem + 18432);
  u16* RC = reinterpret_cast<u16*>(smem + 36864);
  u16* RD = reinterpret_cast<u16*>(smem + 55296);
  float* Gs = reinterpret_cast<float*>(smem + 73728);
  const float* gdec = reinterpret_cast<const float*>(p.ws + SM_GDEC);

  float Gv = gdec[(size_t)(t0 + lane) * 4 + h];
#pragma unroll
  for (int o = 1; o < 64; o <<= 1) {
    float tv = __shfl_up(Gv, o, 64);
    if (lane >= o) Gv += tv;
  }
  if (w == 0) {
    Gs[lane] = Gv;
    reinterpret_cast<float*>(p.ws + D_GC)[(size_t)item * 64 + lane] = Gv;
  }
  delta_rowpass<0>(p, t0, n, h, w, lane, Gv, RA, RBk, RC);
  __syncthreads();
  {
    f32x4 accL[4], accA[4];
#pragma unroll
    for (int jb = 0; jb < 4; ++jb) { accL[jb] = (f32x4){0.f, 0.f, 0.f, 0.f}; accA[jb] = (f32x4){0.f, 0.f, 0.f, 0.f}; }
#pragma unroll
    for (int ks = 0; ks < 4; ++ks) {
      bf16x8 a1 = lds_frag(RBk, 136, 16 * w, ks * 32, lane);
      bf16x8 a2 = lds_frag(RC, 136, 16 * w, ks * 32, lane);
#pragma unroll
      for (int jb = 0; jb < 4; ++jb) {
        if (jb <= w) {
          bf16x8 bb = lds_frag(RA, 136, 16 * jb, ks * 32, lane);
          accL[jb] = mfma16(a1, bb, accL[jb]);
          accA[jb] = mfma16(a2, bb, accA[jb]);
        }
      }
    }
    __syncthreads();
    float* Lm = reinterpret_cast<float*>(RBk);
#pragma unroll
    for (int jb = 0; jb < 4; ++jb)
#pragma unroll
      for (int j = 0; j < 4; ++j) {
        int i = 16 * w + 4 * lq + j, jj = jb * 16 + lr;
        float dec = __expf(fminf(Gs[i] - Gs[jj], 0.f));
        float lv = (i > jj) ? accL[jb][j] * dec : 0.f;
        float av = (i >= jj) ? accA[jb][j] * dec : 0.f;
        Lm[i * 64 + jj] = lv;
        RD[i * 72 + jj] = f2bf(av);
      }
  }
  __syncthreads();
  store_frags(RC, 136, 64, 128, reinterpret_cast<u16*>(p.ws + D_QF) + (size_t)item * 8192, tid, NTHR);
  store_frags(RD, 72, 64, 64, reinterpret_cast<u16*>(p.ws + D_ATT) + (size_t)item * 4096, tid, NTHR);
  store_frags_T(RA, 136, 128, 64, reinterpret_cast<u16*>(p.ws + D_KNT) + (size_t)item * 8192, tid, NTHR);
  __syncthreads();
  {
    const float* Lm = reinterpret_cast<const float*>(RBk);
    float* Tm = reinterpret_cast<float*>(RA);
    float* Ms = reinterpret_cast<float*>(RC) + w * 256;
    {
      const int c = lane & 15, i0 = 16 * w;
      float tc[16];
#pragma unroll
      for (int r = 0; r < 16; ++r) {
        float a = (r == c) ? 1.f : 0.f;
#pragma unroll
        for (int k = 0; k < r; ++k) a -= Lm[(i0 + r) * 64 + i0 + k] * tc[k];
        tc[r] = a;
      }
      if (lane < 16) {
#pragma unroll
        for (int r = 0; r < 16; ++r) Tm[(i0 + r) * 64 + i0 + c] = tc[r];
      }
    }
    __syncthreads();
    {
      const int j = w;
      for (int i = j + 1; i < 4; ++i) {
        f32x4 macc = (f32x4){0.f, 0.f, 0.f, 0.f};
        for (int k = j; k < i; ++k) {
#pragma unroll
          for (int ks = 0; ks < 4; ++ks) {
            float av = Lm[(16 * i + lr) * 64 + 16 * k + 4 * ks + lq];
            float bv = Tm[(16 * k + 4 * ks + lq) * 64 + 16 * j + lr];
            macc = __builtin_amdgcn_mfma_f32_16x16x4f32(av, bv, macc, 0, 0, 0);
          }
        }
#pragma unroll
        for (int r = 0; r < 4; ++r) Ms[(4 * lq + r) * 16 + lr] = macc[r];
        __builtin_amdgcn_wave_barrier();
        f32x4 tacc = (f32x4){0.f, 0.f, 0.f, 0.f};
#pragma unroll
        for (int ks = 0; ks < 4; ++ks) {
          float av = Tm[(16 * i + lr) * 64 + 16 * i + 4 * ks + lq];
          float bv = Ms[(4 * ks + lq) * 16 + lr];
          tacc = __builtin_amdgcn_mfma_f32_16x16x4f32(av, bv, tacc, 0, 0, 0);
        }
#pragma unroll
        for (int r = 0; r < 4; ++r) Tm[(16 * i + 4 * lq + r) * 64 + 16 * j + lr] = -tacc[r];
        __builtin_amdgcn_wave_barrier();
      }
    }
    __syncthreads();
    {
      u16* Tb = RD + 64 * 72;
      for (int idx = tid; idx < 4096; idx += NTHR) {
        int r = idx >> 6, c = idx & 63;
        float v = ((c >> 4) <= (r >> 4)) ? Tm[idx] : 0.f;
        Tb[r * 72 + c] = f2bf(v);
      }
    }
    __syncthreads();
  }
  delta_rowpass<1>(p, t0, n, h, w, lane, Gv, RA, RBk, RC);
  __syncthreads();
  {
    const u16* Tm = RD + 64 * 72;
    bf16x8 tf[4][2];
#pragma unroll
    for (int cb = 0; cb < 4; ++cb)
#pragma unroll
      for (int ks = 0; ks < 2; ++ks) tf[cb][ks] = lds_frag(Tm, 72, cb * 16, ks * 32, lane);
    u16* valt = reinterpret_cast<u16*>(p.ws + D_VALT) + (size_t)item * 8192;
#pragma unroll
    for (int ee = 0; ee < 2; ++ee) {
      int eb = 2 * w + ee;
      bf16x8 a0 = lds_frag(RC, 72, eb * 16, 0, lane), a1 = lds_frag(RC, 72, eb * 16, 32, lane);
#pragma unroll
      for (int cb = 0; cb < 4; ++cb) {
        f32x4 c = (f32x4){0.f, 0.f, 0.f, 0.f};
        c = mfma16(a0, tf[cb][0], c);
        c = mfma16(a1, tf[cb][1], c);
        *reinterpret_cast<uint2*>(valt + ((size_t)(eb * 4 + cb) * 64 + lane) * 4) = make_uint2(pack2(c[0], c[1]), pack2(c[2], c[3]));
      }
    }
#pragma unroll
    for (int dd = 0; dd < 2; ++dd) {
      int db = 2 * w + dd;
      bf16x8 b0 = lds_frag(RA, 72, db * 16, 0, lane), b1 = lds_frag(RA, 72, db * 16, 32, lane);
#pragma unroll
      for (int cb = 0; cb < 4; ++cb) {
        f32x4 c = (f32x4){0.f, 0.f, 0.f, 0.f};
        c = mfma16(tf[cb][0], b0, c);
        c = mfma16(tf[cb][1], b1, c);
#pragma unroll
        for (int j = 0; j < 4; ++j) RBk[(cb * 16 + 4 * lq + j) * 136 + db * 16 + lr] = f2bf(c[j]);
      }
    }
  }
  __syncthreads();
  store_frags(RBk, 136, 64, 128, reinterpret_cast<u16*>(p.ws + D_KCD) + (size_t)item * 8192, tid, NTHR);
  __syncthreads();
}

__device__ __forceinline__ void m1_hgrn_item(const Params& p, int item, char* smem) {
  const int tid = VTID, lane = tid & 63, w = tid >> 6, lr = lane & 15, lq = lane >> 4;
  const int h = item & 3, n = (item >> 2) & 63, b = item >> 8;
  const int t0 = b * 2048 + n * 32;
  u16* QG = reinterpret_cast<u16*>(smem);
  u16* QR = reinterpret_cast<u16*>(smem + 8704);
  u16* KR = reinterpret_cast<u16*>(smem + 17408);
  u16* KGT = reinterpret_cast<u16*>(smem + 26112);
  u16* VT = reinterpret_cast<u16*>(smem + 36352);
  float* tot = reinterpret_cast<float*>(smem + 46592);
  float* bls = tot + 128;
  const u16* Zp = reinterpret_cast<const u16*>(p.ws + Z1);
  const int e = tid & 127, half = tid >> 7;
  const int he = h * 128 + e;
  const float lb = sigmoid_f(p.lb_logits[he] - p.lb_logits[512 + he]);
  float q[16], k[16], bc[16];
  float run = 0.f;
#pragma unroll
  for (int i = 0; i < 16; ++i) {
    const u16* zr = Zp + (size_t)(t0 + half * 16 + i) * 3072;
    float qb = bf2f(zr[1536 + he]), fb = bf2f(zr[2048 + he]);
    float f = lb + (1.f - lb) * sigmoid_f(fb);
    run += __logf(f);
    q[i] = silu_f(qb); k[i] = 1.f - f; bc[i] = run;
    VT[e * 40 + half * 16 + i] = zr[2560 + he];
  }
  if (half == 0) tot[e] = run;
  __syncthreads();
  const float bref = tot[e];
  if (half == 1) {
#pragma unroll
    for (int i = 0; i < 16; ++i) bc[i] += bref;
    bls[e] = bc[15];
  }
  __syncthreads();
  const float bl = bls[e];
  if (half == 0) reinterpret_cast<float*>(p.ws + H_EBL)[(size_t)item * 128 + e] = __expf(bl);
#pragma unroll
  for (int i = 0; i < 16; ++i) {
    int r = half * 16 + i;
    QG[r * 136 + e] = f2bf(q[i] * __expf(bc[i]));
    QR[r * 136 + e] = f2bf(q[i] * __expf(bc[i] - bref));
    KR[r * 136 + e] = f2bf(k[i] * __expf(bref - bc[i]));
    KGT[e * 40 + r] = f2bf(k[i] * __expf(bl - bc[i]));
  }
  __syncthreads();
  {
    const int ib = w >> 1, jb = w & 1;
    f32x4 c = (f32x4){0.f, 0.f, 0.f, 0.f};
    if (jb <= ib) {
#pragma unroll
      for (int ks = 0; ks < 4; ++ks) c = mfma16(lds_frag(QR, 136, ib * 16, ks * 32, lane), lds_frag(KR, 136, jb * 16, ks * 32, lane), c);
    }
    u16* att = reinterpret_cast<u16*>(p.ws + H_ATT) + (size_t)item * 1024;
#pragma unroll
    for (int j = 0; j < 4; ++j) {
      int i = ib * 16 + 4 * lq + j, jj = jb * 16 + lr;
      float v = (i >= jj) ? c[j] : 0.f;
      att[(ib * 64 + (i & 15) + 16 * (jj >> 3)) * 8 + (jj & 7)] = f2bf(v);
    }
  }
  store_frags(QG, 136, 32, 128, reinterpret_cast<u16*>(p.ws + H_QG) + (size_t)item * 4096, tid, NTHR);
  store_frags(KGT, 40, 128, 32, reinterpret_cast<u16*>(p.ws + H_KGT) + (size_t)item * 4096, tid, NTHR);
  store_frags(VT, 40, 128, 32, reinterpret_cast<u16*>(p.ws + H_VT) + (size_t)item * 4096, tid, NTHR);
  __syncthreads();
}

struct DPre {
  bf16x8 kcd[4], q[4], att[2], knt[2][2];
  uint2 val[2];
  float gc, gl;
  float4 gi;
};
__device__ __forceinline__ void m2d_loadA(const Params& p, int base, int es, int w, int lane, DPre& d) {
  const int lr = lane & 15, lq = lane >> 4;
  const bf16x8* kcd = reinterpret_cast<const bf16x8*>(p.ws + D_KCD + (size_t)base * 16384);
  const uint2* val = reinterpret_cast<const uint2*>(p.ws + D_VALT + (size_t)base * 16384);
  const float* gc = reinterpret_cast<const float*>(p.ws + D_GC) + (size_t)base * 64;
#pragma unroll
  for (int ks = 0; ks < 4; ++ks) d.kcd[ks] = kcd[(w * 4 + ks) * 64 + lane];
#pragma unroll
  for (int eb = 0; eb < 2; ++eb) d.val[eb] = val[((es * 2 + eb) * 4 + w) * 64 + lane];
  d.gc = gc[w * 16 + lr];
  d.gl = gc[63];
  d.gi = *reinterpret_cast<const float4*>(gc + 16 * w + 4 * lq);
}
__device__ __forceinline__ void m2d_loadB(const Params& p, int base, int w, int lane, DPre& d) {
  const bf16x8* qf = reinterpret_cast<const bf16x8*>(p.ws + D_QF + (size_t)base * 16384);
  const bf16x8* att = reinterpret_cast<const bf16x8*>(p.ws + D_ATT + (size_t)base * 8192);
#pragma unroll
  for (int ks = 0; ks < 4; ++ks) d.q[ks] = qf[(w * 4 + ks) * 64 + lane];
#pragma unroll
  for (int ks = 0; ks < 2; ++ks) d.att[ks] = att[(w * 2 + ks) * 64 + lane];
}
__device__ __forceinline__ void m2d_loadC(const Params& p, int base, int w, int lane, DPre& d) {
  const bf16x8* knt = reinterpret_cast<const bf16x8*>(p.ws + D_KNT + (size_t)base * 16384);
#pragma unroll
  for (int ks = 0; ks < 2; ++ks) {
    d.knt[0][ks] = knt[((2 * w) * 2 + ks) * 64 + lane];
    d.knt[1][ks] = knt[((2 * w + 1) * 2 + ks) * 64 + lane];
  }
}

__device__ __forceinline__ void m2_delta_item(const Params& p, int item, char* smem) {
  const int tid = VTID, lane = tid & 63, w = tid >> 6, lr = lane & 15, lq = lane >> 4;
  const int es = item & 3, h = (item >> 2) & 3, b = item >> 4;
  u16* Sb = reinterpret_cast<u16*>(smem);
  u16* Ub = reinterpret_cast<u16*>(smem + 17408);
  u16* Usb = reinterpret_cast<u16*>(smem + 22016);
  for (int i = tid; i < 32 * 136; i += NTHR) Sb[i] = 0;
  f32x4 accS[2][2];
#pragma unroll
  for (int i = 0; i < 2; ++i)
#pragma unroll
    for (int j = 0; j < 2; ++j) accS[i][j] = (f32x4){0.f, 0.f, 0.f, 0.f};
  u16* OA = reinterpret_cast<u16*>(reinterpret_cast<char*>(p.out) + YB_OA);
  DPre cur;
  m2d_loadA(p, (b * 32 + 0) * 4 + h, es, w, lane, cur);
  m2d_loadB(p, (b * 32 + 0) * 4 + h, w, lane, cur);
  m2d_loadC(p, (b * 32 + 0) * 4 + h, w, lane, cur);
  __syncthreads();
  for (int n = 0; n < 32; ++n) {
    const int nbase = (b * 32 + (n + 1 < 32 ? n + 1 : n)) * 4 + h;
    const u16* Sc = Sb + (n & 1) * (32 * 136);
    u16* Sn = Sb + ((n + 1) & 1) * (32 * 136);
    f32x4 accP[2];
    accP[0] = (f32x4){0.f, 0.f, 0.f, 0.f}; accP[1] = accP[0];
#pragma unroll
    for (int ks = 0; ks < 4; ++ks) {
      accP[0] = mfma16(lds_frag(Sc, 136, 0, ks * 32, lane), cur.kcd[ks], accP[0]);
      accP[1] = mfma16(lds_frag(Sc, 136, 16, ks * 32, lane), cur.kcd[ks], accP[1]);
    }
    const float egc = __expf(cur.gl - cur.gc);
    const float egl = __expf(cur.gl);
    const float egi[4] = {__expf(cur.gi.x), __expf(cur.gi.y), __expf(cur.gi.z), __expf(cur.gi.w)};
    float vv[2][4];
#pragma unroll
    for (int eb = 0; eb < 2; ++eb) { vv[eb][0] = lo2f(cur.val[eb].x); vv[eb][1] = hi2f(cur.val[eb].x); vv[eb][2] = lo2f(cur.val[eb].y); vv[eb][3] = hi2f(cur.val[eb].y); }
    m2d_loadA(p, nbase, es, w, lane, cur);
#pragma unroll
    for (int eb = 0; eb < 2; ++eb) {
#pragma unroll
      for (int j = 0; j < 4; ++j) {
        float u = vv[eb][j] - accP[eb][j];
        int e = eb * 16 + 4 * lq + j, c = 16 * w + lr;
        Ub[e * 72 + c] = f2bf(u);
        Usb[e * 72 + c] = f2bf(u * egc);
      }
    }
    lds_barrier();
    {
      f32x4 accO[2];
      accO[0] = (f32x4){0.f, 0.f, 0.f, 0.f}; accO[1] = accO[0];
#pragma unroll
      for (int ks = 0; ks < 4; ++ks) {
        accO[0] = mfma16(cur.q[ks], lds_frag(Sc, 136, 0, ks * 32, lane), accO[0]);
        accO[1] = mfma16(cur.q[ks], lds_frag(Sc, 136, 16, ks * 32, lane), accO[1]);
      }
#pragma unroll
      for (int eb = 0; eb < 2; ++eb)
#pragma unroll
        for (int j = 0; j < 4; ++j) accO[eb][j] *= egi[j];
#pragma unroll
      for (int ks = 0; ks < 2; ++ks) {
        accO[0] = mfma16(cur.att[ks], lds_frag(Ub, 72, 0, ks * 32, lane), accO[0]);
        accO[1] = mfma16(cur.att[ks], lds_frag(Ub, 72, 16, ks * 32, lane), accO[1]);
      }
      m2d_loadB(p, nbase, w, lane, cur);
#pragma unroll
      for (int eb = 0; eb < 2; ++eb)
#pragma unroll
        for (int j = 0; j < 4; ++j) {
          int tok = b * 2048 + n * 64 + 16 * w + 4 * lq + j;
          OA[(size_t)tok * 512 + h * 128 + es * 32 + eb * 16 + lr] = f2bf(accO[eb][j]);
        }
    }
    {
#pragma unroll
      for (int eb = 0; eb < 2; ++eb) {
        bf16x8 a0 = lds_frag(Usb, 72, eb * 16, 0, lane), a1 = lds_frag(Usb, 72, eb * 16, 32, lane);
#pragma unroll
        for (int dd = 0; dd < 2; ++dd) {
#pragma unroll
          for (int j = 0; j < 4; ++j) accS[eb][dd][j] *= egl;
          accS[eb][dd] = mfma16(a0, cur.knt[dd][0], accS[eb][dd]);
          accS[eb][dd] = mfma16(a1, cur.knt[dd][1], accS[eb][dd]);
#pragma unroll
          for (int j = 0; j < 4; ++j) Sn[(eb * 16 + 4 * lq + j) * 136 + (2 * w + dd) * 16 + lr] = f2bf(accS[eb][dd][j]);
        }
      }
    }
    m2d_loadC(p, nbase, w, lane, cur);
    lds_barrier();
  }
  float* outp = p.out + O_DELTAP + (size_t)(b * 4 + h) * 16384;
#pragma unroll
  for (int eb = 0; eb < 2; ++eb)
#pragma unroll
    for (int dd = 0; dd < 2; ++dd) {
      int d = (2 * w + dd) * 16 + lr, e0 = es * 32 + eb * 16 + 4 * lq;
      *reinterpret_cast<float4*>(outp + (size_t)d * 128 + e0) =
          make_float4(accS[eb][dd][0], accS[eb][dd][1], accS[eb][dd][2], accS[eb][dd][3]);
    }
  __syncthreads();
}

struct HPre {
  bf16x8 qg[4], att, vt[2], kgt[2];
  float ebl[2];
};
__device__ __forceinline__ HPre m2h_load(const Params& p, int base, int vs, int w, int lane) {
  HPre d;
  const int lr = lane & 15;
  const bf16x8* qg = reinterpret_cast<const bf16x8*>(p.ws + H_QG + (size_t)base * 8192);
  const bf16x8* att = reinterpret_cast<const bf16x8*>(p.ws + H_ATT + (size_t)base * 2048);
  const bf16x8* vt = reinterpret_cast<const bf16x8*>(p.ws + H_VT + (size_t)base * 8192);
  const bf16x8* kgt = reinterpret_cast<const bf16x8*>(p.ws + H_KGT + (size_t)base * 8192);
  const float* ebl = reinterpret_cast<const float*>(p.ws + H_EBL) + (size_t)base * 128;
  const int ib = w >> 1;
#pragma unroll
  for (int ks = 0; ks < 4; ++ks) d.qg[ks] = qg[(ib * 4 + ks) * 64 + lane];
  d.att = att[ib * 64 + lane];
  d.vt[0] = vt[(vs * 2 + 0) * 64 + lane];
  d.vt[1] = vt[(vs * 2 + 1) * 64 + lane];
  d.kgt[0] = kgt[(2 * w) * 64 + lane];
  d.kgt[1] = kgt[(2 * w + 1) * 64 + lane];
  d.ebl[0] = ebl[(2 * w) * 16 + lr];
  d.ebl[1] = ebl[(2 * w + 1) * 16 + lr];
  return d;
}

__device__ __forceinline__ void m2_hgrn_item(const Params& p, int item, char* smem) {
  const int tid = VTID, lane = tid & 63, w = tid >> 6, lr = lane & 15, lq = lane >> 4;
  const int vs = item & 3, h = (item >> 2) & 3, b = item >> 4;
  u16* Sb = reinterpret_cast<u16*>(smem);
  for (int i = tid; i < 32 * 136; i += NTHR) Sb[i] = 0;
  f32x4 accS[2][2];
#pragma unroll
  for (int i = 0; i < 2; ++i)
#pragma unroll
    for (int j = 0; j < 2; ++j) accS[i][j] = (f32x4){0.f, 0.f, 0.f, 0.f};
  u16* OB = reinterpret_cast<u16*>(reinterpret_cast<char*>(p.out) + YB_OB);
  const int ib = w >> 1, vb = w & 1;
  HPre cur = m2h_load(p, (b * 64 + 0) * 4 + h, vs, w, lane), nxt = cur;
  __syncthreads();
  for (int n = 0; n < 64; ++n) {
    if (n + 1 < 64) nxt = m2h_load(p, (b * 64 + n + 1) * 4 + h, vs, w, lane);
    const u16* Sc = Sb + (n & 1) * (32 * 136);
    u16* Sn = Sb + ((n + 1) & 1) * (32 * 136);
    {
      f32x4 o = (f32x4){0.f, 0.f, 0.f, 0.f};
#pragma unroll
      for (int ks = 0; ks < 4; ++ks) o = mfma16(cur.qg[ks], lds_frag(Sc, 136, vb * 16, ks * 32, lane), o);
      o = mfma16(cur.att, vb ? cur.vt[1] : cur.vt[0], o);
#pragma unroll
      for (int j = 0; j < 4; ++j) {
        int tok = b * 2048 + n * 32 + ib * 16 + 4 * lq + j;
        OB[(size_t)tok * 512 + h * 128 + vs * 32 + vb * 16 + lr] = f2bf(o[j]);
      }
    }
#pragma unroll
    for (int v2 = 0; v2 < 2; ++v2)
#pragma unroll
      for (int dd = 0; dd < 2; ++dd) {
#pragma unroll
        for (int j = 0; j < 4; ++j) accS[v2][dd][j] *= cur.ebl[dd];
        accS[v2][dd] = mfma16(cur.vt[v2], cur.kgt[dd], accS[v2][dd]);
#pragma unroll
        for (int j = 0; j < 4; ++j) Sn[(v2 * 16 + 4 * lq + j) * 136 + (2 * w + dd) * 16 + lr] = f2bf(accS[v2][dd][j]);
      }
    lds_barrier();
    cur = nxt;
  }
  float* outp = p.out + O_HGRNP + (size_t)(b * 4 + h) * 16384;
#pragma unroll
  for (int v2 = 0; v2 < 2; ++v2)
#pragma unroll
    for (int dd = 0; dd < 2; ++dd) {
      int e = (2 * w + dd) * 16 + lr, v0 = vs * 32 + v2 * 16 + 4 * lq;
      *reinterpret_cast<float4*>(outp + (size_t)e * 128 + v0) =
          make_float4(accS[v2][dd][0], accS[v2][dd][1], accS[v2][dd][2], accS[v2][dd][3]);
    }
  __syncthreads();
}

__device__ __forceinline__ void ms_delta_item(const Params& p, int item, char* smem) {
  const int tid = VTID, lane = tid & 63, w = tid >> 6;
  const int h = item & 3, b = item >> 2;
  const int R0 = TP + b * 4;
  float* qkv = reinterpret_cast<float*>(smem);
  float* red = reinterpret_cast<float*>(smem + 6144);
  const u16* Zp = reinterpret_cast<const u16*>(p.ws + Z1);
  for (int c = tid; c < 384; c += NTHR) {
    int col = c < 128 ? h * 128 + c : (c < 256 ? 512 + h * 128 + c - 128 : 1024 + h * 128 + c - 256);
    float xs[7];
#pragma unroll
    for (int j = 0; j < 3; ++j) xs[j] = p.cache_conv[(size_t)(b * 3 + j) * 1536 + col];
#pragma unroll
    for (int t = 0; t < 4; ++t) xs[3 + t] = bf2f(Zp[(size_t)(R0 + t) * 3072 + col]);
    float wc[4];
#pragma unroll
    for (int j = 0; j < 4; ++j) wc[j] = p.w_conv_a[j * 1536 + col];
#pragma unroll
    for (int t = 0; t < 4; ++t) {
      float y = xs[t] * wc[0] + xs[t + 1] * wc[1] + xs[t + 2] * wc[2] + xs[t + 3] * wc[3];
      qkv[t * 384 + c] = silu_f(y);
    }
  }
  __syncthreads();
  {
    const int t = w;
    float q0 = qkv[t * 384 + lane], q1 = qkv[t * 384 + 64 + lane];
    float k0 = qkv[t * 384 + 128 + lane], k1 = qkv[t * 384 + 192 + lane];
    float qs = wave_sum(q0 * q0 + q1 * q1), ks = wave_sum(k0 * k0 + k1 * k1);
    float qn = rsqrtf(qs + EPS) * 0.08838834764831845f, kn = rsqrtf(ks + EPS);
    qkv[t * 384 + lane] = q0 * qn; qkv[t * 384 + 64 + lane] = q1 * qn;
    qkv[t * 384 + 128 + lane] = k0 * kn; qkv[t * 384 + 192 + lane] = k1 * kn;
  }
  __syncthreads();
  const int e = tid & 127, dh = tid >> 7;
  float S[64];
  const float* s0 = p.state_delta + (size_t)(b * 4 + h) * 16384 + (size_t)(dh * 64) * 128 + e;
#pragma unroll
  for (int dd = 0; dd < 64; ++dd) S[dd] = s0[(size_t)dd * 128];
  const float* gdec = reinterpret_cast<const float*>(p.ws + SM_GDEC);
  const float* betap = reinterpret_cast<const float*>(p.ws + SM_BETA);
  u16* OA = reinterpret_cast<u16*>(reinterpret_cast<char*>(p.out) + YB_OA);
  for (int t = 0; t < 4; ++t) {
    const float a = __expf(gdec[(size_t)(R0 + t) * 4 + h]), bt = betap[(size_t)(R0 + t) * 4 + h];
    const float* qv = qkv + t * 384 + dh * 64;
    const float* kv = qkv + t * 384 + 128 + dh * 64;
    float rp = 0.f;
#pragma unroll
    for (int dd = 0; dd < 64; ++dd) rp += S[dd] * kv[dd];
    red[((t * 2 + 0) * 2 + dh) * 128 + e] = rp;
    __syncthreads();
    float r = a * (red[((t * 2 + 0) * 2 + 0) * 128 + e] + red[((t * 2 + 0) * 2 + 1) * 128 + e]);
    float u = bt * (qkv[t * 384 + 256 + e] - r);
    float op = 0.f;
#pragma unroll
    for (int dd = 0; dd < 64; ++dd) {
      S[dd] = a * S[dd] + kv[dd] * u;
      op += S[dd] * qv[dd];
    }
    red[((t * 2 + 1) * 2 + dh) * 128 + e] = op;
    __syncthreads();
    if (dh == 0) {
      float o = red[((t * 2 + 1) * 2 + 0) * 128 + e] + red[((t * 2 + 1) * 2 + 1) * 128 + e];
      OA[(size_t)(R0 + t) * 512 + h * 128 + e] = f2bf(o);
    }
  }
  float* so = p.out + O_DELTAS + (size_t)(b * 4 + h) * 16384 + (size_t)(dh * 64) * 128 + e;
#pragma unroll
  for (int dd = 0; dd < 64; ++dd) so[(size_t)dd * 128] = S[dd];
  __syncthreads();
}

__device__ __forceinline__ void ms_hgrn_item(const Params& p, int item, char* smem) {
  const int tid = VTID;
  const int h = item & 3, b = item >> 2;
  const int R0 = TP + b * 4;
  float* qs = reinterpret_cast<float*>(smem);
  float* fs = qs + 512;
  float* vsm = fs + 512;
  float* red = vsm + 512;
  const u16* Zp = reinterpret_cast<const u16*>(p.ws + Z1);
  for (int i = tid; i < 512; i += NTHR) {
    int t = i >> 7, e = i & 127, he = h * 128 + e;
    const u16* zr = Zp + (size_t)(R0 + t) * 3072;
    float lb = sigmoid_f(p.lb_logits[he] - p.lb_logits[512 + he]);
    qs[i] = silu_f(bf2f(zr[1536 + he]));
    fs[i] = lb + (1.f - lb) * sigmoid_f(bf2f(zr[2048 + he]));
    vsm[i] = bf2f(zr[2560 + he]);
  }
  __syncthreads();
  const int v = tid & 127, eh = tid >> 7;
  float S[64];
  const float* s0 = p.state_hgrn + (size_t)(b * 4 + h) * 16384 + (size_t)(eh * 64) * 128 + v;
#pragma unroll
  for (int ee = 0; ee < 64; ++ee) S[ee] = s0[(size_t)ee * 128];
  u16* OB = reinterpret_cast<u16*>(reinterpret_cast<char*>(p.out) + YB_OB);
  for (int t = 0; t < 4; ++t) {
    const float vv = vsm[t * 128 + v];
    const float* ft = fs + t * 128 + eh * 64;
    const float* qt = qs + t * 128 + eh * 64;
    float op = 0.f;
#pragma unroll
    for (int ee = 0; ee < 64; ++ee) {
      float f = ft[ee];
      S[ee] = f * S[ee] + (1.f - f) * vv;
      op += S[ee] * qt[ee];
    }
    red[(t * 2 + eh) * 128 + v] = op;
    __syncthreads();
    if (eh == 0) OB[(size_t)(R0 + t) * 512 + h * 128 + v] = f2bf(red[(t * 2) * 128 + v] + red[(t * 2 + 1) * 128 + v]);
  }
  float* so = p.out + O_HGRNS + (size_t)(b * 4 + h) * 16384 + (size_t)(eh * 64) * 128 + v;
#pragma unroll
  for (int ee = 0; ee < 64; ++ee) so[(size_t)ee * 128] = S[ee];
  __syncthreads();
}

__device__ __forceinline__ void phase_m3(const Params& p, char* smem, int bid, int nb) {
  const int tid = VTID, lane = tid & 63, w = tid >> 6;
  float* tl = reinterpret_cast<float*>(smem);
  const int NWT = 704 + 352;
  const int NTASK = (2 * TT) / 4;
  for (int item = bid; item < NWT + NTASK; item += nb) {
    if (item < NWT) {
      if (item < 704) {
        int blk = item >> 2, k0 = (item & 3) * 256;
        int grp = blk >> 3, sub = blk & 7, up = sub >> 2;
        wt_chunk((up ? p.w_ffn_up : p.w_ffn_gate) + grp * 128 + (sub & 3) * 32, DFF, 1024,
                 reinterpret_cast<u16*>(p.ws + W_GU) + (size_t)blk * 32 * 1024, p.g_ffn, tl, k0);
      } else {
        int q = item - 704;
        int n = (q / 11) * 32, k0 = (q % 11) * 256;
        wt_chunk(p.w_ffn_down + n, 1024, DFF, reinterpret_cast<u16*>(p.ws + W_DOWN) + (size_t)n * DFF, nullptr, tl, k0);
      }
    } else {
      int task = (item - NWT) * 4 + w;
      int tok = task >> 1, br = task & 1;
      u16* o = reinterpret_cast<u16*>(reinterpret_cast<char*>(p.out) + (br ? YB_OB : YB_OA)) + (size_t)tok * 512 + lane * 8;
      const u16* og = z2row(p, tok) + 2048 + br * 512 + lane * 8;
      const float* g = (br ? p.g_out_b : p.g_out_a) + (lane & 15) * 8;
      uint4 ov = *reinterpret_cast<const uint4*>(o), gv = *reinterpret_cast<const uint4*>(og);
      unsigned oo[4] = {ov.x, ov.y, ov.z, ov.w}, gg[4] = {gv.x, gv.y, gv.z, gv.w};
      float x[8], y[8];
#pragma unroll
      for (int j = 0; j < 4; ++j) { x[2 * j] = lo2f(oo[j]); x[2 * j + 1] = hi2f(oo[j]); y[2 * j] = lo2f(gg[j]); y[2 * j + 1] = hi2f(gg[j]); }
      float ss = 0.f;
#pragma unroll
      for (int j = 0; j < 8; ++j) ss += x[j] * x[j];
      ss += __shfl_xor(ss, 1, 64); ss += __shfl_xor(ss, 2, 64); ss += __shfl_xor(ss, 4, 64); ss += __shfl_xor(ss, 8, 64);
      float rstd = rsqrtf(ss * (1.f / 128.f) + EPS);
      unsigned r[4];
#pragma unroll
      for (int j = 0; j < 4; ++j)
        r[j] = pack2(x[2 * j] * rstd * g[2 * j] * silu_f(y[2 * j]), x[2 * j + 1] * rstd * g[2 * j + 1] * silu_f(y[2 * j + 1]));
      *reinterpret_cast<uint4*>(o) = make_uint4(r[0], r[1], r[2], r[3]);
    }
  }
}

__device__ __forceinline__ void phase_fixup(const Params& p, int bid, int nb) {
  const float* haloG = reinterpret_cast<const float*>(p.ws + HALO_G);
  const float* headG = reinterpret_cast<const float*>(p.ws + HEAD_G);
  const float* headU = reinterpret_cast<const float*>(p.ws + HEAD_U);
  u16* ACTp = reinterpret_cast<u16*>(p.ws + ACT);
  const int total = 256 * 2 * DFF;
  for (int i = bid * NTHR + VTID; i < total; i += nb * NTHR) {
    int ch = i % DFF, rr = (i / DFF) & 1, blk = i / (2 * DFF);
    if ((blk & 31) == 0) continue;
    float g0 = headG[(size_t)(blk * 2 + rr) * DFF + ch], u = headU[(size_t)(blk * 2 + rr) * DFF + ch];
    float gm1, gm2;
    if (rr == 0) { gm1 = haloG[(size_t)((blk - 1) * 2 + 1) * DFF + ch]; gm2 = haloG[(size_t)((blk - 1) * 2 + 0) * DFF + ch]; }
    else { gm1 = headG[(size_t)(blk * 2 + 0) * DFF + ch]; gm2 = haloG[(size_t)((blk - 1) * 2 + 1) * DFF + ch]; }
    float gc = p.w_ffn_conv[ch] * gm2 + p.w_ffn_conv[DFF + ch] * gm1 + p.w_ffn_conv[2 * DFF + ch] * g0;
    ACTp[(size_t)(blk * 64 + rr) * DFF + ch] = f2bf(silu_f(gc) * u);
  }
}

__device__ __forceinline__ void phase_final(const Params& p, int bid, int nb) {
  const int tid = VTID, lane = tid & 63, w = tid >> 6;
  for (int row = bid * 4 + w; row < TP; row += nb * 8) {
    const int rowB = row + nb * 4;
    const bool hasB = rowB < TP;
    float* ya = p.out + O_YP + (size_t)row * DM;
    float* yb = p.out + O_YP + (size_t)(hasB ? rowB : row) * DM;
    float4 xa[4], xb[4];
#pragma unroll
    for (int i = 0; i < 4; ++i) xa[i] = *reinterpret_cast<const float4*>(ya + i * 256 + lane * 4);
#pragma unroll
    for (int i = 0; i < 4; ++i) xb[i] = *reinterpret_cast<const float4*>(yb + i * 256 + lane * 4);
    float sa = 0.f, sb = 0.f;
#pragma unroll
    for (int i = 0; i < 4; ++i) {
      sa += xa[i].x * xa[i].x + xa[i].y * xa[i].y + xa[i].z * xa[i].z + xa[i].w * xa[i].w;
      sb += xb[i].x * xb[i].x + xb[i].y * xb[i].y + xb[i].z * xb[i].z + xb[i].w * xb[i].w;
    }
    sa = wave_sum(sa); sb = wave_sum(sb);
    const float ra = rsqrtf(sa * (1.f / DM) + EPS), rb = rsqrtf(sb * (1.f / DM) + EPS);
#pragma unroll
    for (int i = 0; i < 4; ++i) {
      float4 g = *reinterpret_cast<const float4*>(p.g_final + i * 256 + lane * 4);
      *reinterpret_cast<float4*>(ya + i * 256 + lane * 4) = make_float4(xa[i].x * ra * g.x, xa[i].y * ra * g.y, xa[i].z * ra * g.z, xa[i].w * ra * g.w);
      if (hasB) *reinterpret_cast<float4*>(yb + i * 256 + lane * 4) = make_float4(xb[i].x * rb * g.x, xb[i].y * rb * g.y, xb[i].z * rb * g.z, xb[i].w * rb * g.w);
    }
  }
  for (int row = TP + bid * 4 + w; row < TT; row += nb * 4) {
    float* y = p.out + O_YP + (size_t)row * DM;
    float4 xv[4];
    float ss = 0.f;
    const float* part = reinterpret_cast<const float*>(p.ws + PART) + (size_t)(row - TP) * 1024;
#pragma unroll
    for (int i = 0; i < 4; ++i) {
      xv[i] = *reinterpret_cast<const float4*>(y + i * 256 + lane * 4);
      for (int ks = 0; ks < 11; ++ks) {
        float4 pv = *reinterpret_cast<const float4*>(part + (size_t)ks * TS * 1024 + i * 256 + lane * 4);
        xv[i].x += pv.x; xv[i].y += pv.y; xv[i].z += pv.z; xv[i].w += pv.w;
      }
      ss += xv[i].x * xv[i].x + xv[i].y * xv[i].y + xv[i].z * xv[i].z + xv[i].w * xv[i].w;
    }
    ss = wave_sum(ss);
    float rstd = rsqrtf(ss * (1.f / DM) + EPS);
#pragma unroll
    for (int i = 0; i < 4; ++i) {
      float4 g = *reinterpret_cast<const float4*>(p.g_final + i * 256 + lane * 4);
      *reinterpret_cast<float4*>(y + i * 256 + lane * 4) =
          make_float4(xv[i].x * rstd * g.x, xv[i].y * rstd * g.y, xv[i].z * rstd * g.z, xv[i].w * rstd * g.w);
    }
  }
}

constexpr int NPHASE = 12;
__device__ __forceinline__ void run_phase(const Params& p, int ph, char* smem_all) {
  int half = threadIdx.x >> 8;
  asm volatile("" : "+v"(half));
  const int bid = blockIdx.x * 2 + half, nb = gridDim.x * 2;
  char* smem = smem_all + half * SMEM_HALF;
  LAS unsigned char* lds = (LAS unsigned char*)smem_all;
  const u16* HB = reinterpret_cast<const u16*>(reinterpret_cast<const char*>(p.out) + YB_H);
  switch (ph) {
    case 0: phase_prep(p, smem, bid, nb); break;
    case 1: { pg8::SchedStatic S; S.init(TT, 3072, (int)gridDim.x, (int)blockIdx.x, 0); gemm_phase8<EPI_Z1>(p, HB, reinterpret_cast<const u16*>(p.ws + W_MAIN), 1024, 1024, lds, S); } break;
    case 2:
      for (int it = bid; it < 1024 + 2048; it += nb) {
        if (it < 1024) m1_delta_item(p, it, smem); else m1_hgrn_item(p, it - 1024, smem);
      }
      break;
    case 3: {
      const int g = blockIdx.x;
      if (g < 128) {
        const int gg = g & 63, xcd = gg & 7, j = gg >> 3;
        const int q = xcd + 8 * (j >> 1), es = 2 * (j & 1) + half;
        if (g < 64) m2_delta_item(p, q * 4 + es, smem); else m2_hgrn_item(p, q * 4 + es, smem);
      } else {
        const int nrest = (gridDim.x - 128) * 2, v0 = (g - 128) * 2 + half;
        for (int it = v0; it < 1024; it += nrest) {
          if (it < 512) ms_delta_item(p, it, smem); else ms_hgrn_item(p, it - 512, smem);
        }
        __syncthreads();
        { pg8::SchedStatic S; S.init(TS, 3072, 24, g - 128, 64);
          gemm_phase8<EPI_Z2>(p, HB, reinterpret_cast<const u16*>(p.ws + W_G2), 1024, 1024, lds, S); }
      }
    } break;
    case 4: { pg8::SchedStatic S; S.init(TP, 3072, (int)gridDim.x, (int)blockIdx.x, 0); gemm_phase8<EPI_Z2>(p, HB, reinterpret_cast<const u16*>(p.ws + W_G2), 1024, 1024, lds, S); } break;
    case 5: phase_m3(p, smem, bid, nb); break;
    case 6: {
      const u16* OA = reinterpret_cast<const u16*>(reinterpret_cast<const char*>(p.out) + YB_OA);
      const u16* OB = reinterpret_cast<const u16*>(reinterpret_cast<const char*>(p.out) + YB_OB);
      { pg8::SchedStatic S; S.init(TT, 1024, (int)gridDim.x, (int)blockIdx.x, 0); gemm_phase8<EPI_MIXA>(p, OA, reinterpret_cast<const u16*>(p.ws + W_A), 512, 512, lds, S);
      gemm_phase8<EPI_MIXB>(p, OB, reinterpret_cast<const u16*>(p.ws + W_B), 512, 512, lds, S); }
    } break;
    case 7: { pg8::SchedStatic S; S.init(TT, 1024, (int)gridDim.x, (int)blockIdx.x, 0); gemm_phase8<EPI_WOUT>(p, reinterpret_cast<const u16*>(p.ws + MIX), reinterpret_cast<const u16*>(p.ws + W_OUT), 1024, 1024, lds, S); } break;
    case 8: {
      { pg8::SchedStatic S; S.init(TP, 5632, (int)gridDim.x, (int)blockIdx.x, 0);
        gemm_phase8<EPI_FFN1>(p, reinterpret_cast<const u16*>(p.ws + X1B), reinterpret_cast<const u16*>(p.ws + W_GU), 1024, 1024, lds, S); }
      { pg8::SchedStatic S; S.init(TS, 5632, (int)gridDim.x, (int)gridDim.x - 1 - (int)blockIdx.x, 64);
        gemm_phase8<EPI_FFN1S>(p, reinterpret_cast<const u16*>(p.ws + X1B), reinterpret_cast<const u16*>(p.ws + W_GU), 1024, 1024, lds, S); }
    } break;
    case 9: phase_fixup(p, bid, nb); break;
    case 10: {
      { pg8::SchedStatic S; S.init(TP, 1024, (int)gridDim.x, (int)blockIdx.x, 0);
        gemm_phase8<EPI_FFN2>(p, reinterpret_cast<const u16*>(p.ws + ACT), reinterpret_cast<const u16*>(p.ws + W_DOWN), DFF, DFF, lds, S); }
      { pg8::SchedSplit S; S.init(2, 4, 11, (int)gridDim.x, (int)blockIdx.x, 64);
        gemm_phase8<EPI_FFN2S>(p, reinterpret_cast<const u16*>(p.ws + ACT), reinterpret_cast<const u16*>(p.ws + W_DOWN), DFF, 256, lds, S); }
    } break;
    case 11: phase_final(p, bid, nb); break;
  }
}

__global__ void __launch_bounds__(512, 2) k_main(Params p, int ph0, int ph1) {
  extern __shared__ __attribute__((aligned(16))) char smem[];
  volatile LAS unsigned* xst = (volatile LAS unsigned*)(smem + 2 * SMEM_HALF);
  if (threadIdx.x == 0) { xst[0] = 0u; xst[1] = 0u; }
  __syncthreads();
  XcdBarrier xb = xcd_barrier_post(reinterpret_cast<unsigned*>(p.ws + BAR_OFF), xst);
  if (ph1 < 0) cg::this_grid().sync();
#define PHASE_STEP(N)                                        \
  if (ph0 <= N && N < ph1) run_phase(p, N, smem);            \
  if (ph0 <= N && N + 1 < ph1) xcd_barrier(xb);
  PHASE_STEP(0) PHASE_STEP(1) PHASE_STEP(2) PHASE_STEP(3) PHASE_STEP(4) PHASE_STEP(5)
  PHASE_STEP(6) PHASE_STEP(7) PHASE_STEP(8) PHASE_STEP(9) PHASE_STEP(10) PHASE_STEP(11)
#undef PHASE_STEP
}

extern "C" void kernel_launch(void* const* d_in, const int* in_sizes, int n_in, void* d_out, int out_size, void* d_ws,
                              size_t ws_size, hipStream_t stream) {
  static int grid_blocks = 0;
  if (!grid_blocks) {
    hipFuncSetAttribute((const void*)k_main, hipFuncAttributeMaxDynamicSharedMemorySize, SMEM_BYTES);
    int dev = 0, cus = 0, per_cu = 0;
    hipGetDevice(&dev);
    hipDeviceGetAttribute(&cus, hipDeviceAttributeMultiprocessorCount, dev);
    hipOccupancyMaxActiveBlocksPerMultiprocessor(&per_cu, k_main, 512, SMEM_BYTES);
    if (per_cu > 1) per_cu = 1;
    if (per_cu < 1) per_cu = 1;
    grid_blocks = cus * per_cu;
  }
  Params p{};
  const float** f = reinterpret_cast<const float**>(&p);
  for (int i = 0; i < 23; ++i) f[i] = reinterpret_cast<const float*>(d_in[i]);
  p.out = reinterpret_cast<float*>(d_out);
  p.ws = reinterpret_cast<char*>(d_ws);
  if (ws_size < WS_NEED) fprintf(stderr, "workspace too small: %zu < %zu\n", ws_size, (size_t)WS_NEED);
  hipMemsetAsync(p.ws + BAR_OFF, 0, 16384, stream);
#if MULTI_LAUNCH
  for (int ph = 0; ph < NPHASE; ++ph) {
    hipLaunchKernelGGL(k_main, dim3(grid_blocks), dim3(512), SMEM_BYTES, stream, p, ph, ph + 1);
  }
#else
  int ph0 = 0, ph1 = NPHASE;
  void* args[] = {&p, &ph0, &ph1};
  hipError_t e = hipLaunchCooperativeKernel((void*)k_main, dim3(grid_blocks), dim3(512), args, SMEM_BYTES, stream);
  if (e != hipSuccess) fprintf(stderr, "cooperative launch failed: %s (grid %d)\n", hipGetErrorString(e), grid_blocks);
#endif
}
```

```cpp
#include <hip/hip_runtime.h>
#include <hip/hip_cooperative_groups.h>
#include <cstdio>
#include <cstdint>
namespace cg = cooperative_groups;

#ifndef MULTI_LAUNCH
#define MULTI_LAUNCH 0
#endif

typedef unsigned short u16;
typedef __attribute__((ext_vector_type(8))) short bf16x8;
typedef __attribute__((ext_vector_type(4))) float f32x4;

constexpr int TP = 16384, TS = 512, TT = TP + TS;
constexpr int DM = 1024, NIN = 6152, DFF = 2816;
constexpr float EPS = 1e-6f;
constexpr int NTHR = 256;
#define VTID (threadIdx.x & 255)
constexpr int SMEM_HALF = 77824;
constexpr int SMEM_BYTES = 2 * SMEM_HALF + 16;

constexpr size_t O_YP = 0;
constexpr size_t O_YS = O_YP + (size_t)TP * DM;
constexpr size_t O_CONVP = O_YS + (size_t)TS * DM;
constexpr size_t O_DELTAP = O_CONVP + 8 * 3 * 1536;
constexpr size_t O_HGRNP = O_DELTAP + 8 * 4 * 128 * 128;
constexpr size_t O_FFNP = O_HGRNP + 8 * 4 * 128 * 128;
constexpr size_t O_CONVS = O_FFNP + 8 * 2 * DFF;
constexpr size_t O_DELTAS = O_CONVS + 128 * 3 * 1536;
constexpr size_t O_HGRNS = O_DELTAS + (size_t)128 * 4 * 128 * 128;
constexpr size_t O_FFNS = O_HGRNS + (size_t)128 * 4 * 128 * 128;

constexpr size_t al(size_t x) { return (x + 255) & ~(size_t)255; }
constexpr size_t W_MAIN = 0;
constexpr size_t W_G2 = W_MAIN + (size_t)3072 * 1024 * 2;
constexpr size_t W_A = W_G2 + (size_t)3072 * 1024 * 2;
constexpr size_t W_B = W_A + (size_t)1024 * 512 * 2;
constexpr size_t W_OUT = W_B + (size_t)1024 * 512 * 2;
constexpr size_t SM_GDEC = W_OUT + (size_t)1024 * 1024 * 2;
constexpr size_t SM_BETA = al(SM_GDEC + (size_t)TT * 16);
constexpr size_t SM_ROWSS = al(SM_BETA + (size_t)TT * 16);
constexpr size_t Z1 = al(SM_ROWSS + (size_t)TT * 4);
constexpr size_t Z1_SIZE = (size_t)TT * 3072 * 2;
constexpr size_t RB = al(Z1 + Z1_SIZE);
constexpr size_t D_QF = RB;
constexpr size_t D_KCD = D_QF + (size_t)1024 * 16384;
constexpr size_t D_KNT = D_KCD + (size_t)1024 * 16384;
constexpr size_t D_VALT = D_KNT + (size_t)1024 * 16384;
constexpr size_t D_ATT = D_VALT + (size_t)1024 * 16384;
constexpr size_t D_GC = D_ATT + (size_t)1024 * 8192;
constexpr size_t H_QG = D_GC + (size_t)1024 * 256;
constexpr size_t H_KGT = H_QG + (size_t)2048 * 8192;
constexpr size_t H_VT = H_KGT + (size_t)2048 * 8192;
constexpr size_t H_ATT = H_VT + (size_t)2048 * 8192;
constexpr size_t H_EBL = H_ATT + (size_t)2048 * 2048;
constexpr size_t RB_END1 = H_EBL + (size_t)2048 * 512;
constexpr size_t Z2 = RB;
constexpr size_t X1B = RB;
constexpr size_t ACT = RB + (size_t)TT * 1024 * 2;
constexpr size_t RB_END2 = ACT + (size_t)TT * DFF * 2;
constexpr size_t WS_NEED = (RB_END1 > RB_END2 ? RB_END1 : RB_END2);
constexpr size_t BAR_OFF = al(WS_NEED);
constexpr size_t Z2S = BAR_OFF + 16384;
static_assert(Z2S + (size_t)TS * 3072 * 2 <= (size_t)268435456, "workspace too large");
constexpr size_t W_GU = Z1;
constexpr size_t W_DOWN = W_GU + (size_t)5632 * 1024 * 2;
constexpr size_t MIX = W_DOWN + (size_t)1024 * DFF * 2;
constexpr size_t HALO_G = MIX + (size_t)TT * 1024 * 2;
constexpr size_t HEAD_G = HALO_G + (size_t)264 * 2 * DFF * 4;
constexpr size_t HEAD_U = HEAD_G + (size_t)264 * 2 * DFF * 4;
constexpr size_t PART = HEAD_U + (size_t)264 * 2 * DFF * 4;
static_assert(PART + (size_t)11 * TS * 1024 * 4 <= Z1 + Z1_SIZE, "z1 reuse overflow");
constexpr size_t YB_H = 0;
constexpr size_t YB_OA = (size_t)TT * 1024 * 2;
constexpr size_t YB_OB = YB_OA + (size_t)TT * 512 * 2;

struct Params {
  const float *x_prompt, *x_sample, *cache_conv, *state_delta, *state_hgrn, *cache_ffn;
  const float *g_attn, *w_in, *w_conv_a, *a_log, *dt_bias, *g_out_a, *w_branch_a, *lb_logits, *g_out_b,
      *w_branch_b, *w_out, *g_ffn, *w_ffn_gate, *w_ffn_up, *w_ffn_conv, *w_ffn_down, *g_final;
  float* out;
  char* ws;
};

__device__ __forceinline__ const unsigned short* z2row(const Params& p, int row) {
  return row < TP ? reinterpret_cast<const unsigned short*>(p.ws + Z2) + (size_t)row * 3072
                  : reinterpret_cast<const unsigned short*>(p.ws + Z2S) + (size_t)(row - TP) * 3072;
}
__device__ __forceinline__ u16 f2bf(float f) {
  unsigned u = __float_as_uint(f);
  u += 0x7fffu + ((u >> 16) & 1u);
  return (u16)(u >> 16);
}
__device__ __forceinline__ float bf2f(u16 h) { return __uint_as_float(((unsigned)h) << 16); }
__device__ __forceinline__ unsigned pack2(float a, float b) { return (unsigned)f2bf(a) | ((unsigned)f2bf(b) << 16); }
__device__ __forceinline__ float lo2f(unsigned u) { return __uint_as_float(u << 16); }
__device__ __forceinline__ float hi2f(unsigned u) { return __uint_as_float(u & 0xffff0000u); }
__device__ __forceinline__ float silu_f(float x) { return x * __builtin_amdgcn_rcpf(1.f + __expf(-x)); }
__device__ __forceinline__ float sigmoid_f(float x) { return __builtin_amdgcn_rcpf(1.f + __expf(-x)); }
__device__ __forceinline__ float wave_sum(float v) {
#pragma unroll
  for (int o = 32; o >= 1; o >>= 1) v += __shfl_xor(v, o, 64);
  return v;
}
__device__ __forceinline__ void lds_barrier() {
  __builtin_amdgcn_fence(__ATOMIC_RELEASE, "workgroup", "local");
  __builtin_amdgcn_s_barrier();
  __builtin_amdgcn_fence(__ATOMIC_ACQUIRE, "workgroup", "local");
}
__device__ __forceinline__ f32x4 mfma16(bf16x8 a, bf16x8 b, f32x4 c) {
  return __builtin_amdgcn_mfma_f32_16x16x32_bf16(a, b, c, 0, 0, 0);
}
__device__ __forceinline__ bf16x8 lds_frag(const u16* base, int ld, int row0, int k0, int lane) {
  return *reinterpret_cast<const bf16x8*>(base + (row0 + (lane & 15)) * ld + k0 + 8 * (lane >> 4));
}
__device__ __forceinline__ void store_frags(const u16* lds, int ld, int R, int K, u16* dst, int t, int nt) {
  const int nkb = K >> 5, total = (R >> 4) * nkb * 64;
  for (int idx = t; idx < total; idx += nt) {
    int f = idx >> 6, pl = idx & 63, rb = f / nkb, kb = f - rb * nkb;
    uint4 v = *reinterpret_cast<const uint4*>(lds + (rb * 16 + (pl & 15)) * ld + kb * 32 + 8 * (pl >> 4));
    *reinterpret_cast<uint4*>(dst + (size_t)idx * 8) = v;
  }
}
__device__ __forceinline__ void store_frags_T(const u16* lds, int ld, int R2, int K2, u16* dst, int t, int nt) {
  const int nkb = K2 >> 5, total = (R2 >> 4) * nkb * 64;
  for (int idx = t; idx < total; idx += nt) {
    int f = idx >> 6, pl = idx & 63, rb = f / nkb, kb = f - rb * nkb;
    int d = rb * 16 + (pl & 15), c0 = kb * 32 + 8 * (pl >> 4);
    unsigned r[4];
#pragma unroll
    for (int j = 0; j < 4; ++j) {
      unsigned a = lds[(c0 + 2 * j) * ld + d], b = lds[(c0 + 2 * j + 1) * ld + d];
      r[j] = a | (b << 16);
    }
    *reinterpret_cast<uint4*>(dst + (size_t)idx * 8) = make_uint4(r[0], r[1], r[2], r[3]);
  }
}

#define XB_TMO 128
#define XB_XCNT(j) (256 + 64 * (j))
#define XB_XSUB(j) (1280 + 64 * (j))
#define XB_XGEN(j) (2304 + 64 * (j))
#define XB_TOP 3328
#define XB_TOPGEN 3392
#define XCD_BAR_WORDS 3456
#define XB_SPIN_CAP (1u << 18)
#define LAS __attribute__((address_space(3)))
__device__ __forceinline__ unsigned xb_ld(unsigned* p) { return __hip_atomic_load(p, __ATOMIC_RELAXED, __HIP_MEMORY_SCOPE_AGENT); }
__device__ __forceinline__ unsigned xb_add(unsigned* p, unsigned v) { return __hip_atomic_fetch_add(p, v, __ATOMIC_RELAXED, __HIP_MEMORY_SCOPE_AGENT); }
__device__ __forceinline__ unsigned xb_xcc_id() { return (unsigned)__builtin_amdgcn_s_getreg((3 << 11) | 20) & 0xFu; }
#define XB_SPIN(cond, bar) do { unsigned _sp = 0; while (cond) { __builtin_amdgcn_s_sleep(1); \
    if ((++_sp & 255u) == 0u) { if (xb_ld(&(bar)[XB_TMO])) break; if (_sp > XB_SPIN_CAP) { atomicAdd(&(bar)[XB_TMO], 1u); break; } } } } while (0)
struct XcdBarrier { unsigned* bar; unsigned x; volatile LAS unsigned* st; };
__device__ __forceinline__ XcdBarrier xcd_barrier_post(unsigned* bar, volatile LAS unsigned* st) {
  XcdBarrier b; b.bar = bar; b.x = xb_xcc_id(); b.st = st;
  if (threadIdx.x == 0) (void)xb_add(&bar[XB_XCNT(b.x)], 1u);
  return b;
}
__device__ __forceinline__ void xcd_barrier_complete(unsigned* bar, unsigned x, unsigned& nloc, unsigned& nx) {
  const unsigned G = gridDim.x * gridDim.y * gridDim.z;
  unsigned sum, cnt, mine, sp = 0u;
  for (;;) {
    sum = 0u; cnt = 0u; mine = 0u;
#pragma unroll
    for (unsigned j = 0; j < 16; ++j) { const unsigned c = xb_ld(&bar[XB_XCNT(j)]); sum += c; cnt += (c > 0u) ? 1u : 0u; mine = (j == x) ? c : mine; }
    if (sum == G) break;
    __builtin_amdgcn_s_sleep(1);
    if ((++sp & 255u) == 0u) { if (xb_ld(&bar[XB_TMO])) break; if (sp > XB_SPIN_CAP) { atomicAdd(&bar[XB_TMO], 1u); break; } }
  }
  nloc = mine > 0u ? mine : 1u; nx = cnt > 0u ? cnt : 1u;
}
__device__ __forceinline__ void xcd_barrier(const XcdBarrier& b) {
  asm volatile("s_waitcnt vmcnt(0)" ::: "memory");
  __syncthreads();
  if (threadIdx.x == 0) {
    unsigned* bar = b.bar;
    __builtin_amdgcn_s_waitcnt(0);
    unsigned nloc = b.st[0], nx = b.st[1];
    if (nloc == 0u) { xcd_barrier_complete(bar, b.x, nloc, nx); b.st[0] = nloc; b.st[1] = nx; }
    const unsigned old = xb_add(&bar[XB_XSUB(b.x)], 1u);
    const unsigned gen = old / nloc;
    if (old + 1u == (gen + 1u) * nloc) {
      __builtin_amdgcn_fence(__ATOMIC_RELEASE, "agent");
      asm volatile("s_waitcnt vmcnt(0)" ::: "memory");
      const unsigned og = xb_add(&bar[XB_TOP], 1u);
      const unsigned tg = og / nx;
      if (og + 1u == (tg + 1u) * nx) xb_add(&bar[XB_TOPGEN], 1u);
      else XB_SPIN(xb_ld(&bar[XB_TOPGEN]) == tg, bar);
      __builtin_amdgcn_fence(__ATOMIC_ACQUIRE, "agent");
      xb_add(&bar[XB_XGEN(b.x)], 1u);
      asm volatile("s_waitcnt vmcnt(0)" ::: "memory");
    } else {
      XB_SPIN(xb_ld(&bar[XB_XGEN(b.x)]) == gen, bar);
      __builtin_amdgcn_fence(__ATOMIC_ACQUIRE, "agent");
      asm volatile("s_waitcnt vmcnt(0)" ::: "memory");
    }
  }
  __syncthreads();
}

__device__ __forceinline__ void wt_block(const float* __restrict__ src, int ld, int K, u16* __restrict__ dst, const float* __restrict__ kscale,
                         float* lds) {
  const int t = VTID;
  for (int k0 = 0; k0 < K; k0 += 64) {
    {
      int n = t & 31, kk = t >> 5;
#pragma unroll
      for (int i = 0; i < 8; ++i) {
        int k = kk + 8 * i;
        float v = src[(size_t)(k0 + k) * ld + n];
        if (kscale) v *= kscale[k0 + k];
        lds[k * 33 + n] = v;
      }
    }
    __syncthreads();
    {
      int kp = t & 31, nn = t >> 5;
#pragma unroll
      for (int i = 0; i < 4; ++i) {
        int n = nn + 8 * i;
        unsigned v = pack2(lds[(2 * kp) * 33 + n], lds[(2 * kp + 1) * 33 + n]);
        *reinterpret_cast<unsigned*>(dst + (size_t)n * K + k0 + 2 * kp) = v;
      }
    }
    __syncthreads();
  }
}

__device__ __forceinline__ void wt_chunk(const float* __restrict__ src, int ld, int K, u16* __restrict__ dst, const float* __restrict__ kscale, float* lds, int k0) {
  const int t = VTID;
  {
    const int n = t & 31, kk = t >> 5;
    float v[32];
#pragma unroll
    for (int i = 0; i < 32; ++i) v[i] = src[(size_t)(k0 + kk + 8 * i) * ld + n];
    if (kscale) {
#pragma unroll
      for (int i = 0; i < 32; ++i) v[i] *= kscale[k0 + kk + 8 * i];
    }
#pragma unroll
    for (int i = 0; i < 32; ++i) lds[(kk + 8 * i) * 33 + n] = v[i];
  }
  __syncthreads();
  {
    const int kp = t & 127, nn = t >> 7;
#pragma unroll
    for (int i = 0; i < 16; ++i) {
      const int n = nn + 2 * i;
      *reinterpret_cast<unsigned*>(dst + (size_t)n * K + k0 + 2 * kp) = pack2(lds[(2 * kp) * 33 + n], lds[(2 * kp + 1) * 33 + n]);
    }
  }
  __syncthreads();
}

__device__ __forceinline__ void phase_prep(const Params& p, char* smem, int bid, int nb) {
  float* wab = reinterpret_cast<float*>(smem);
  float* tl = reinterpret_cast<float*>(smem + 32768);
  const int t = VTID, lane = t & 63, w = t >> 6;
  for (int i = t; i < 8192; i += NTHR) wab[i] = p.w_in[(size_t)(i >> 3) * NIN + 1536 + (i & 7)];
  for (int i = bid * NTHR + t; i < TT; i += nb * NTHR) reinterpret_cast<float*>(p.ws + SM_ROWSS)[i] = 0.f;
  __syncthreads();
  const int NWT = 384 + 384 + 64 + 64 + 128;
  const int NROW = TT / 4;
  for (int item = bid; item < NWT + NROW; item += nb) {
    if (item < NWT) {
      if (item < 384) {
        int n = (item >> 2) * 32, k0 = (item & 3) * 256;
        int col = n < 1536 ? n : 2056 + (n - 1536);
        wt_chunk(p.w_in + col, NIN, 1024, reinterpret_cast<u16*>(p.ws + W_MAIN) + (size_t)n * 1024, nullptr, tl, k0);
      } else if (item < 768) {
        int n = ((item - 384) >> 2) * 32, k0 = (item & 3) * 256;
        int col = n < 2048 ? 4104 + n : (n < 2560 ? 1544 + (n - 2048) : 3592 + (n - 2560));
        wt_chunk(p.w_in + col, NIN, 1024, reinterpret_cast<u16*>(p.ws + W_G2) + (size_t)n * 1024, nullptr, tl, k0);
      } else if (item < 832) {
        int n = ((item - 768) >> 1) * 32, k0 = (item & 1) * 256;
        wt_chunk(p.w_branch_a + n, 1024, 512, reinterpret_cast<u16*>(p.ws + W_A) + (size_t)n * 512, nullptr, tl, k0);
      } else if (item < 896) {
        int n = ((item - 832) >> 1) * 32, k0 = (item & 1) * 256;
        wt_chunk(p.w_branch_b + n, 1024, 512, reinterpret_cast<u16*>(p.ws + W_B) + (size_t)n * 512, nullptr, tl, k0);
      } else {
        int n = ((item - 896) >> 2) * 32, k0 = (item & 3) * 256;
        wt_chunk(p.w_out + n, 1024, 1024, reinterpret_cast<u16*>(p.ws + W_OUT) + (size_t)n * 1024, nullptr, tl, k0);
      }
    } else {
      int row = (item - NWT) * 4 + w;
      const float* x = row < TP ? p.x_prompt + (size_t)row * DM : p.x_sample + (size_t)(row - TP) * DM;
      float4 xv[4];
      float ss = 0.f;
#pragma unroll
      for (int i = 0; i < 4; ++i) {
        xv[i] = *reinterpret_cast<const float4*>(x + i * 256 + lane * 4);
        ss += xv[i].x * xv[i].x + xv[i].y * xv[i].y + xv[i].z * xv[i].z + xv[i].w * xv[i].w;
      }
      ss = wave_sum(ss);
      float rstd = rsqrtf(ss * (1.f / DM) + EPS);
      float dot[8];
#pragma unroll
      for (int c = 0; c < 8; ++c) dot[c] = 0.f;
      u16* hrow = reinterpret_cast<u16*>(reinterpret_cast<char*>(p.out) + YB_H) + (size_t)row * DM;
#pragma unroll
      for (int i = 0; i < 4; ++i) {
        int k = i * 256 + lane * 4;
        float4 g = *reinterpret_cast<const float4*>(p.g_attn + k);
        float h0 = xv[i].x * rstd * g.x, h1 = xv[i].y * rstd * g.y, h2 = xv[i].z * rstd * g.z, h3 = xv[i].w * rstd * g.w;
        *reinterpret_cast<uint2*>(hrow + k) = make_uint2(pack2(h0, h1), pack2(h2, h3));
        float hh[4] = {h0, h1, h2, h3};
#pragma unroll
        for (int j = 0; j < 4; ++j) {
          float4 wa = *reinterpret_cast<const float4*>(wab + (k + j) * 8);
          float4 wb = *reinterpret_cast<const float4*>(wab + (k + j) * 8 + 4);
          dot[0] += hh[j] * wa.x; dot[1] += hh[j] * wa.y; dot[2] += hh[j] * wa.z; dot[3] += hh[j] * wa.w;
          dot[4] += hh[j] * wb.x; dot[5] += hh[j] * wb.y; dot[6] += hh[j] * wb.z; dot[7] += hh[j] * wb.w;
        }
      }
#pragma unroll
      for (int c = 0; c < 8; ++c) dot[c] = wave_sum(dot[c]);
      if (lane < 4) {
        float aa = lane == 0 ? dot[0] : lane == 1 ? dot[1] : lane == 2 ? dot[2] : dot[3];
        float xx = aa + p.dt_bias[lane];
        float sp = xx > 20.f ? xx : log1pf(__expf(xx));
        reinterpret_cast<float*>(p.ws + SM_GDEC)[(size_t)row * 4 + lane] = -__expf(p.a_log[lane]) * sp;
      } else if (lane < 8) {
        float ba = lane == 4 ? dot[4] : lane == 5 ? dot[5] : lane == 6 ? dot[6] : dot[7];
        reinterpret_cast<float*>(p.ws + SM_BETA)[(size_t)row * 4 + lane - 4] = sigmoid_f(ba);
      }
    }
  }
}

enum { EPI_Z1 = 0, EPI_Z2 = 1, EPI_MIXA = 2, EPI_MIXB = 3, EPI_WOUT = 4, EPI_FFN1 = 5, EPI_FFN2 = 6, EPI_FFN2S = 7, EPI_FFN1S = 8 };
namespace pg8 {
constexpr int BM = 256, BK = 64, HALF = 128, HTB = HALF * BK * 2, STAGE_BYTES = 8 * HTB, NXCD = 8, WGM = 8;
__device__ __forceinline__ int lds_byte(int r, int c) { const int st = (r >> 4) * 2 + (c >> 5), rr = r & 15, cc = c & 31, ob = rr * 64 + cc * 2; return st * 1024 + (ob ^ (((ob >> 9) & 1) << 5)); }
__device__ __forceinline__ void stage_rc(int b, int& R, int& C) { const int st = b / 1024, sb = b % 1024, swz = sb ^ (((sb >> 9) & 1) << 5); R = (st >> 1) * 16 + swz / 64; C = (st & 1) * 32 + (swz % 64) / 2; }
__device__ __forceinline__ int perm32(int rho) { const int n = rho >> 4, i = rho & 15; return 8 * (i >> 2) + 4 * n + (i & 3); }
struct Unit { int pm, pn, ks; };
struct StaticOrder {
  int nM, nN, nwg, G, c;
  __device__ void init(int M, int N, int G_, int c_) { nM = M / BM; nN = N / BM; nwg = nM * nN; G = G_; c = c_; }
  __device__ bool next(int i, Unit& u) const {
    const long L = (long)i * G + c; if (L >= nwg) return false;
    int wgid = (int)L; { const int q = nwg / NXCD, r = nwg % NXCD, xcd = wgid % NXCD, off = wgid / NXCD; wgid = (xcd < r ? xcd * (q + 1) : r * (q + 1) + (xcd - r) * q) + off; }
    const int nig = WGM * nN, gid = wgid / nig, fm = gid * WGM, gsz = (nM - fm) < WGM ? (nM - fm) : WGM;
    u.pm = fm + ((wgid % nig) % gsz); u.pn = (wgid % nig) / gsz; return true;
  }
};
struct SchedStatic {
  StaticOrder S; int pm0;
  __device__ void init(int M, int N, int G, int c, int pm0_) { S.init(M, N, G, c); pm0 = pm0_; }
  __device__ bool next(int i, Unit& u) const { if (S.c >= S.G || !S.next(i, u)) return false; u.pm += pm0; u.ks = 0; return true; }
};
struct SchedSplit {
  int nN, nS, pm0, G, c, total;
  __device__ void init(int nM, int nN_, int nS_, int G_, int c_, int pm0_) { nN = nN_; nS = nS_; pm0 = pm0_; G = G_; c = c_; total = nM * nN_ * nS_; }
  __device__ bool next(int i, Unit& u) const {
    const int L = i * G + c; if (c >= G || L >= total) return false;
    u.ks = L % nS; const int t = L / nS; u.pn = t % nN; u.pm = pm0 + t / nN; return true;
  }
};
}

__device__ __forceinline__ float dpp_ror1(float v) { return __int_as_float(__builtin_amdgcn_update_dpp(0, __float_as_int(v), 0x121, 0xf, 0xf, false)); }
__device__ __forceinline__ float dpp_ror2(float v) { return __int_as_float(__builtin_amdgcn_update_dpp(0, __float_as_int(v), 0x122, 0xf, 0xf, false)); }

template <int MODE>
__device__ __forceinline__ void gemm_epilogue(const Params& p, f32x4 (&acc)[2][2][4][2], const pg8::Unit& u, int wr, int wc, int fr, int fq) {
  const int row0 = u.pm * 256 + wr * 64 + fr, col0 = u.pn * 256 + wc * 32 + 8 * fq;
  if constexpr (MODE == EPI_Z1 || MODE == EPI_Z2) {
#pragma unroll
    for (int ai = 0; ai < 2; ++ai)
#pragma unroll
      for (int m = 0; m < 4; ++m) {
        const int row = row0 + ai * 128 + m * 16;
        u16* rowp = (MODE == EPI_Z1 ? reinterpret_cast<u16*>(p.ws + Z1) + (size_t)row * 3072 : const_cast<u16*>(z2row(p, row))) + col0;
#pragma unroll
        for (int bj = 0; bj < 2; ++bj) {
          const f32x4 v0 = acc[ai][bj][m][0], v1 = acc[ai][bj][m][1];
          *reinterpret_cast<uint4*>(rowp + bj * 128) = make_uint4(pack2(v0[0], v0[1]), pack2(v0[2], v0[3]), pack2(v1[0], v1[1]), pack2(v1[2], v1[3]));
        }
        if (MODE == EPI_Z1 && u.pn < 6) {
          float* dst = nullptr;
          if (row < TP) {
            int pos = row & 2047;
            if (pos >= 2045) dst = p.out + O_CONVP + (size_t)((row >> 11) * 3 + pos - 2045) * 1536 + col0;
          } else {
            int pos = (row - TP) & 3;
            if (pos >= 1) dst = p.out + O_CONVS + (size_t)(((row - TP) >> 2) * 3 + pos - 1) * 1536 + col0;
          }
          if (dst) {
#pragma unroll
            for (int bj = 0; bj < 2; ++bj) {
              const f32x4 v0 = acc[ai][bj][m][0], v1 = acc[ai][bj][m][1];
              *reinterpret_cast<float4*>(dst + bj * 128) = make_float4(v0[0], v0[1], v0[2], v0[3]);
              *reinterpret_cast<float4*>(dst + bj * 128 + 4) = make_float4(v1[0], v1[1], v1[2], v1[3]);
            }
          }
        }
      }
  } else if constexpr (MODE == EPI_MIXA || MODE == EPI_MIXB) {
    u16* Mx = reinterpret_cast<u16*>(p.ws + MIX);
#pragma unroll
    for (int ai = 0; ai < 2; ++ai)
#pragma unroll
      for (int m = 0; m < 4; ++m) {
        const int row = row0 + ai * 128 + m * 16;
#pragma unroll
        for (int bj = 0; bj < 2; ++bj) {
          const int col = col0 + bj * 128;
          const uint4 gv = *reinterpret_cast<const uint4*>(z2row(p, row) + (MODE == EPI_MIXB ? 1024 : 0) + col);
          u16* mp = Mx + (size_t)row * 1024 + col;
          const f32x4 v0 = acc[ai][bj][m][0], v1 = acc[ai][bj][m][1];
          float r0 = v0[0] * sigmoid_f(lo2f(gv.x)), r1 = v0[1] * sigmoid_f(hi2f(gv.x));
          float r2 = v0[2] * sigmoid_f(lo2f(gv.y)), r3 = v0[3] * sigmoid_f(hi2f(gv.y));
          float r4 = v1[0] * sigmoid_f(lo2f(gv.z)), r5 = v1[1] * sigmoid_f(hi2f(gv.z));
          float r6 = v1[2] * sigmoid_f(lo2f(gv.w)), r7 = v1[3] * sigmoid_f(hi2f(gv.w));
          if (MODE == EPI_MIXB) {
            const uint4 mv = *reinterpret_cast<const uint4*>(mp);
            r0 += lo2f(mv.x); r1 += hi2f(mv.x); r2 += lo2f(mv.y); r3 += hi2f(mv.y);
            r4 += lo2f(mv.z); r5 += hi2f(mv.z); r6 += lo2f(mv.w); r7 += hi2f(mv.w);
          }
          *reinterpret_cast<uint4*>(mp) = make_uint4(pack2(r0, r1), pack2(r2, r3), pack2(r4, r5), pack2(r6, r7));
        }
        asm volatile("" ::: "memory");
      }
  } else if constexpr (MODE == EPI_WOUT) {
    float* rowss = reinterpret_cast<float*>(p.ws + SM_ROWSS);
    u16* XB = reinterpret_cast<u16*>(p.ws + X1B);
#pragma unroll
    for (int ai = 0; ai < 2; ++ai)
#pragma unroll
      for (int m = 0; m < 4; ++m) {
        const int row = row0 + ai * 128 + m * 16;
        const float* x = (row < TP ? p.x_prompt + (size_t)row * DM : p.x_sample + (size_t)(row - TP) * DM) + col0;
        float* y = p.out + O_YP + (size_t)row * DM + col0;
        float ss = 0.f;
#pragma unroll
        for (int bj = 0; bj < 2; ++bj) {
          const float4 x0 = *reinterpret_cast<const float4*>(x + bj * 128), x1 = *reinterpret_cast<const float4*>(x + bj * 128 + 4);
          const f32x4 a0 = acc[ai][bj][m][0], a1 = acc[ai][bj][m][1];
          const float4 v0 = make_float4(a0[0] + x0.x, a0[1] + x0.y, a0[2] + x0.z, a0[3] + x0.w);
          const float4 v1 = make_float4(a1[0] + x1.x, a1[1] + x1.y, a1[2] + x1.z, a1[3] + x1.w);
          *reinterpret_cast<float4*>(y + bj * 128) = v0;
          *reinterpret_cast<float4*>(y + bj * 128 + 4) = v1;
          *reinterpret_cast<uint4*>(XB + (size_t)row * DM + col0 + bj * 128) =
              make_uint4(pack2(v0.x, v0.y), pack2(v0.z, v0.w), pack2(v1.x, v1.y), pack2(v1.z, v1.w));
          ss += v0.x * v0.x + v0.y * v0.y + v0.z * v0.z + v0.w * v0.w + v1.x * v1.x + v1.y * v1.y + v1.z * v1.z + v1.w * v1.w;
        }
        ss += __shfl_xor(ss, 16, 64);
        ss += __shfl_xor(ss, 32, 64);
        if (fq == 0) atomicAdd(rowss + row, ss);
        asm volatile("" ::: "memory");
      }
  } else if constexpr (MODE == EPI_FFN2) {
#pragma unroll
    for (int ai = 0; ai < 2; ++ai)
#pragma unroll
      for (int m = 0; m < 4; ++m) {
        float* y = p.out + O_YP + (size_t)(row0 + ai * 128 + m * 16) * DM + col0;
#pragma unroll
        for (int bj = 0; bj < 2; ++bj) {
          float4 y0 = *reinterpret_cast<const float4*>(y + bj * 128), y1 = *reinterpret_cast<const float4*>(y + bj * 128 + 4);
          const f32x4 a0 = acc[ai][bj][m][0], a1 = acc[ai][bj][m][1];
          y0.x += a0[0]; y0.y += a0[1]; y0.z += a0[2]; y0.w += a0[3];
          y1.x += a1[0]; y1.y += a1[1]; y1.z += a1[2]; y1.w += a1[3];
          *reinterpret_cast<float4*>(y + bj * 128) = y0;
          *reinterpret_cast<float4*>(y + bj * 128 + 4) = y1;
        }
        asm volatile("" ::: "memory");
      }
  } else if constexpr (MODE == EPI_FFN2S) {
    float* part = reinterpret_cast<float*>(p.ws + PART) + (size_t)u.ks * TS * 1024;
#pragma unroll
    for (int ai = 0; ai < 2; ++ai)
#pragma unroll
      for (int m = 0; m < 4; ++m) {
        float* y = part + (size_t)(row0 + ai * 128 + m * 16 - TP) * 1024 + col0;
#pragma unroll
        for (int bj = 0; bj < 2; ++bj) {
          const f32x4 a0 = acc[ai][bj][m][0], a1 = acc[ai][bj][m][1];
          *reinterpret_cast<float4*>(y + bj * 128) = make_float4(a0[0], a0[1], a0[2], a0[3]);
          *reinterpret_cast<float4*>(y + bj * 128 + 4) = make_float4(a1[0], a1[1], a1[2], a1[3]);
        }
      }
  } else if constexpr (MODE == EPI_FFN1 || MODE == EPI_FFN1S) {
    const float* rowss = reinterpret_cast<const float*>(p.ws + SM_ROWSS);
    u16* ACTp = reinterpret_cast<u16*>(p.ws + ACT);
    float* haloG = reinterpret_cast<float*>(p.ws + HALO_G);
    float* headG = reinterpret_cast<float*>(p.ws + HEAD_G);
    float* headU = reinterpret_cast<float*>(p.ws + HEAD_U);
    const int ch = u.pn * 128 + wc * 32 + 8 * fq;
    float w0[8], w1[8], w2[8];
#pragma unroll
    for (int c = 0; c < 8; ++c) { w0[c] = p.w_ffn_conv[ch + c]; w1[c] = p.w_ffn_conv[DFF + ch + c]; w2[c] = p.w_ffn_conv[2 * DFF + ch + c]; }
    if constexpr (MODE == EPI_FFN1) {
#pragma unroll
      for (int ai = 0; ai < 2; ++ai) {
        const int blk = u.pm * 4 + ai * 2 + wr;
        const bool seqstart = (blk & 31) == 0, seqend = (blk & 31) == 31;
        float gprev[8];
#pragma unroll
        for (int c = 0; c < 8; ++c) gprev[c] = 0.f;
#pragma unroll
        for (int m = 0; m < 4; ++m) {
          const int row = row0 + ai * 128 + m * 16;
          const float rs = rsqrtf(rowss[row] * (1.f / DM) + EPS);
          float g0[8], uu[8];
#pragma unroll
          for (int c = 0; c < 4; ++c) {
            g0[c] = acc[ai][0][m][0][c] * rs; g0[4 + c] = acc[ai][0][m][1][c] * rs;
            uu[c] = acc[ai][1][m][0][c] * rs; uu[4 + c] = acc[ai][1][m][1][c] * rs;
          }
          float r[8];
#pragma unroll
          for (int c = 0; c < 8; ++c) {
            float gm1 = __int_as_float(__builtin_amdgcn_update_dpp(__float_as_int(dpp_ror1(gprev[c])), __float_as_int(g0[c]), 0x111, 0xf, 0xf, false));
            float gm2 = __int_as_float(__builtin_amdgcn_update_dpp(__float_as_int(dpp_ror2(gprev[c])), __float_as_int(g0[c]), 0x112, 0xf, 0xf, false));
            r[c] = silu_f(w0[c] * gm2 + w1[c] * gm1 + w2[c] * g0[c]) * uu[c];
          }
          bool defer = false;
          if (m == 0) {
            defer = !seqstart && fr < 2;
            if (defer) {
              float* dg = headG + (size_t)(blk * 2 + fr) * DFF + ch;
              float* du = headU + (size_t)(blk * 2 + fr) * DFF + ch;
              *reinterpret_cast<float4*>(dg) = make_float4(g0[0], g0[1], g0[2], g0[3]);
              *reinterpret_cast<float4*>(dg + 4) = make_float4(g0[4], g0[5], g0[6], g0[7]);
              *reinterpret_cast<float4*>(du) = make_float4(uu[0], uu[1], uu[2], uu[3]);
              *reinterpret_cast<float4*>(du + 4) = make_float4(uu[4], uu[5], uu[6], uu[7]);
            }
          }
          if (m == 3) {
            if (fr >= 14) {
              float* d = haloG + (size_t)(blk * 2 + fr - 14) * DFF + ch;
              *reinterpret_cast<float4*>(d) = make_float4(g0[0], g0[1], g0[2], g0[3]);
              *reinterpret_cast<float4*>(d + 4) = make_float4(g0[4], g0[5], g0[6], g0[7]);
              if (seqend) {
                float* o = p.out + O_FFNP + (size_t)((row >> 11) * 2 + fr - 14) * DFF + ch;
                *reinterpret_cast<float4*>(o) = make_float4(g0[0], g0[1], g0[2], g0[3]);
                *reinterpret_cast<float4*>(o + 4) = make_float4(g0[4], g0[5], g0[6], g0[7]);
              }
            }
          }
          if (!defer)
            *reinterpret_cast<uint4*>(ACTp + (size_t)row * DFF + ch) = make_uint4(pack2(r[0], r[1]), pack2(r[2], r[3]), pack2(r[4], r[5]), pack2(r[6], r[7]));
#pragma unroll
          for (int c = 0; c < 8; ++c) gprev[c] = g0[c];
          asm volatile("" ::: "memory");
        }
      }
    } else {
#pragma unroll
    for (int ai = 0; ai < 2; ++ai) {
      const int blk = u.pm * 4 + ai * 2 + wr;
      float gprev[8];
#pragma unroll
      for (int c = 0; c < 8; ++c) gprev[c] = 0.f;
#pragma unroll
      for (int m = 0; m < 4; ++m) {
        const int row = row0 + ai * 128 + m * 16;
        const int r64 = m * 16 + fr;
        const float rs = rsqrtf(rowss[row] * (1.f / DM) + EPS);
        float g0[8], uu[8];
#pragma unroll
        for (int c = 0; c < 4; ++c) {
          g0[c] = acc[ai][0][m][0][c] * rs; g0[4 + c] = acc[ai][0][m][1][c] * rs;
          uu[c] = acc[ai][1][m][0][c] * rs; uu[4 + c] = acc[ai][1][m][1][c] * rs;
        }
        const bool prompt = row < TP;
        int pos, b;
        if (prompt) { pos = row & 2047; b = row >> 11; } else { pos = (row - TP) & 3; b = (row - TP) >> 2; }
        const bool defer = (pos >= 1 && r64 < 1) || (pos >= 2 && r64 < 2);
        float gm1[8], gm2[8];
#pragma unroll
        for (int c = 0; c < 8; ++c) {
          gm1[c] = __int_as_float(__builtin_amdgcn_update_dpp(__float_as_int(dpp_ror1(gprev[c])), __float_as_int(g0[c]), 0x111, 0xf, 0xf, false));
          gm2[c] = __int_as_float(__builtin_amdgcn_update_dpp(__float_as_int(dpp_ror2(gprev[c])), __float_as_int(g0[c]), 0x112, 0xf, 0xf, false));
        }
        if (pos < 1) {
#pragma unroll
          for (int c = 0; c < 8; ++c) gm1[c] = prompt ? 0.f : p.cache_ffn[(size_t)(b * 2 + 1) * DFF + ch + c];
        }
        if (pos < 2) {
#pragma unroll
          for (int c = 0; c < 8; ++c) gm2[c] = prompt ? 0.f : p.cache_ffn[(size_t)(b * 2 + pos) * DFF + ch + c];
        }
        if (r64 >= 62) {
          float* d = haloG + (size_t)(blk * 2 + r64 - 62) * DFF + ch;
          *reinterpret_cast<float4*>(d) = make_float4(g0[0], g0[1], g0[2], g0[3]);
          *reinterpret_cast<float4*>(d + 4) = make_float4(g0[4], g0[5], g0[6], g0[7]);
        }
        {
          float* d = nullptr;
          if (prompt) { if (pos >= 2046) d = p.out + O_FFNP + (size_t)(b * 2 + pos - 2046) * DFF + ch; }
          else { if (pos >= 2) d = p.out + O_FFNS + (size_t)(b * 2 + pos - 2) * DFF + ch; }
          if (d) {
            *reinterpret_cast<float4*>(d) = make_float4(g0[0], g0[1], g0[2], g0[3]);
            *reinterpret_cast<float4*>(d + 4) = make_float4(g0[4], g0[5], g0[6], g0[7]);
          }
        }
        if (defer) {
          float* dg = headG + (size_t)(blk * 2 + r64) * DFF + ch;
          float* du = headU + (size_t)(blk * 2 + r64) * DFF + ch;
          *reinterpret_cast<float4*>(dg) = make_float4(g0[0], g0[1], g0[2], g0[3]);
          *reinterpret_cast<float4*>(dg + 4) = make_float4(g0[4], g0[5], g0[6], g0[7]);
          *reinterpret_cast<float4*>(du) = make_float4(uu[0], uu[1], uu[2], uu[3]);
          *reinterpret_cast<float4*>(du + 4) = make_float4(uu[4], uu[5], uu[6], uu[7]);
        } else {
          float r[8];
#pragma unroll
          for (int c = 0; c < 8; ++c) r[c] = silu_f(w0[c] * gm2[c] + w1[c] * gm1[c] + w2[c] * g0[c]) * uu[c];
          *reinterpret_cast<uint4*>(ACTp + (size_t)row * DFF + ch) = make_uint4(pack2(r[0], r[1]), pack2(r[2], r[3]), pack2(r[4], r[5]), pack2(r[6], r[7]));
        }
#pragma unroll
        for (int c = 0; c < 8; ++c) gprev[c] = g0[c];
        asm volatile("" ::: "memory");
      }
    }
    }
  }
}

template <int MODE, class Sched>
__device__ __forceinline__ void gemm_phase8(const Params& p, const u16* Ag, const u16* Btg, int ld, int Kunit, LAS unsigned char* lds, const Sched& S) {
  using namespace pg8;
  const int tid = threadIdx.x, wid = __builtin_amdgcn_readfirstlane(tid >> 6), lane = tid & 63, wr = wid >> 2, wc = wid & 3, fr = lane & 15, fq = lane >> 4;
  const int nt = Kunit / BK;
  unsigned voffA[2], voffB[2];
#pragma unroll
  for (int i = 0; i < 2; ++i) { int R, C; stage_rc(tid * 16 + i * 8192, R, C); const int Rb = (R & ~31) + perm32(R & 31);
    voffA[i] = (unsigned)(R * ld + C) * 2u; voffB[i] = (unsigned)(Rb * ld + C) * 2u; }
  const size_t kstep = (size_t)(BK * 2);
  const size_t hstep = (size_t)HALF * ld * 2;
  const size_t tstep = 2 * hstep;
  const size_t kub = (size_t)Kunit * 2;
  const unsigned ldsw = (unsigned)wid * 1024u;
  const int aoff = lds_byte(wr * 64 + fr, fq * 8), boff = lds_byte(wc * 32 + fr, fq * 8);
#define PG8_SA(b, h) (((b) * 2 + (h)) * HTB)
#define PG8_SB(b, h) ((4 + (b) * 2 + (h)) * HTB)
#define PG8_STAGE(bufoff, gbase, voff) do { _Pragma("unroll") for (int _i = 0; _i < 2; ++_i) \
    __builtin_amdgcn_global_load_lds((const unsigned*)((const char*)(gbase) + (voff)[_i]), (LAS unsigned*)(lds + (bufoff) + ldsw + _i * 8192), 16, 0, 0); } while (0)
#define PG8_LDA(dst, b, h) do { _Pragma("unroll") for (int m = 0; m < 4; ++m) _Pragma("unroll") for (int k = 0; k < 2; ++k) dst[m][k] = *(const LAS bf16x8*)(lds + PG8_SA(b, h) + aoff + m * 2048 + k * 1024); } while (0)
#define PG8_LDB(dst, b, h) do { _Pragma("unroll") for (int n = 0; n < 2; ++n) _Pragma("unroll") for (int k = 0; k < 2; ++k) dst[n][k] = *(const LAS bf16x8*)(lds + PG8_SB(b, h) + boff + n * 2048 + k * 1024); } while (0)
#define PG8_MMA(ai, bj, At, Bt) do { __builtin_amdgcn_s_setprio(1); _Pragma("unroll") for (int m = 0; m < 4; ++m) _Pragma("unroll") for (int n = 0; n < 2; ++n) _Pragma("unroll") for (int k = 0; k < 2; ++k) \
    acc[ai][bj][m][n] = __builtin_amdgcn_mfma_f32_16x16x32_bf16(Bt[n][k], At[m][k], acc[ai][bj][m][n], 0, 0, 0); __builtin_amdgcn_s_setprio(0); } while (0)
#define PG8_WAIT_V(n) asm volatile("s_waitcnt vmcnt(" #n ")" ::: "memory")
#define PG8_WAIT_L(n) asm volatile("s_waitcnt lgkmcnt(" #n ")" ::: "memory")
#define PG8_BAR __builtin_amdgcn_s_barrier()
#define PG8_SCHED __builtin_amdgcn_sched_barrier(0)
  Unit cur, nxt; int ui = 0;
  if (!S.next(0, cur)) return;
  f32x4 acc[2][2][4][2];
#pragma unroll
  for (int a = 0; a < 2; ++a)
#pragma unroll
    for (int b = 0; b < 2; ++b)
#pragma unroll
      for (int m = 0; m < 4; ++m)
#pragma unroll
        for (int n = 0; n < 2; ++n) acc[a][b][m][n] = (f32x4){0.f, 0.f, 0.f, 0.f};
  bf16x8 At[4][2], B0[2][2], B1[2][2];
  const char* cA = (const char*)Ag + (size_t)cur.pm * tstep + cur.ks * kub; const char* cB = (const char*)Btg + (size_t)cur.pn * tstep + cur.ks * kub;
  PG8_STAGE(PG8_SB(0, 0), cB, voffB); PG8_STAGE(PG8_SA(0, 0), cA, voffA); PG8_STAGE(PG8_SB(0, 1), cB + hstep, voffB); PG8_STAGE(PG8_SA(0, 1), cA + hstep, voffA);
  if (wr == 1) PG8_BAR;
  PG8_WAIT_V(4); PG8_BAR;
  PG8_STAGE(PG8_SB(1, 0), cB + kstep, voffB); PG8_STAGE(PG8_SA(1, 0), cA + kstep, voffA); PG8_STAGE(PG8_SB(1, 1), cB + hstep + kstep, voffB);
  PG8_WAIT_V(6); PG8_BAR;
  for (;;) {
    const bool has_next = S.next(ui + 1, nxt);
    const char* nA = has_next ? (const char*)Ag + (size_t)nxt.pm * tstep + nxt.ks * kub : cA; const char* nB = has_next ? (const char*)Btg + (size_t)nxt.pn * tstep + nxt.ks * kub : cB;
    for (int t = 0; t < nt; t += 2) {
      const bool last = (t == nt - 2);
      const char* a1 = cA + (size_t)(t + 1) * kstep;
      const char* a2 = last ? nA : cA + (size_t)(t + 2) * kstep; const char* b2 = last ? nB : cB + (size_t)(t + 2) * kstep;
      const char* a3 = a2 + kstep; const char* b3 = b2 + kstep;
      PG8_LDB(B0, 0, 0); PG8_SCHED; PG8_LDA(At, 0, 0); PG8_STAGE(PG8_SA(1, 1), a1 + hstep, voffA);
      PG8_WAIT_L(8); PG8_BAR; PG8_WAIT_L(0); PG8_MMA(0, 0, At, B0); PG8_BAR; PG8_SCHED;
      PG8_LDB(B1, 0, 1); PG8_STAGE(PG8_SB(0, 0), b2, voffB);
      PG8_BAR; PG8_WAIT_L(0); PG8_MMA(0, 1, At, B1); PG8_BAR;
      PG8_LDA(At, 0, 1); PG8_STAGE(PG8_SA(0, 0), a2, voffA);
      PG8_BAR; PG8_WAIT_L(0); PG8_MMA(1, 0, At, B0); PG8_BAR; PG8_SCHED;
      PG8_STAGE(PG8_SB(0, 1), b2 + hstep, voffB);
      PG8_WAIT_V(6); PG8_BAR; PG8_MMA(1, 1, At, B1); PG8_BAR;
      PG8_LDB(B0, 1, 0); PG8_SCHED; PG8_LDA(At, 1, 0); PG8_STAGE(PG8_SA(0, 1), a2 + hstep, voffA);
      PG8_WAIT_L(8); PG8_BAR; PG8_WAIT_L(0); PG8_MMA(0, 0, At, B0); PG8_BAR; PG8_SCHED;
      PG8_LDB(B1, 1, 1); PG8_STAGE(PG8_SB(1, 0), b3, voffB);
      PG8_BAR; PG8_WAIT_L(0); PG8_MMA(0, 1, At, B1); PG8_BAR;
      PG8_LDA(At, 1, 1); PG8_STAGE(PG8_SA(1, 0), a3, voffA);
      PG8_BAR; PG8_WAIT_L(0); PG8_MMA(1, 0, At, B0); PG8_BAR; PG8_SCHED;
      PG8_STAGE(PG8_SB(1, 1), b3 + hstep, voffB);
      PG8_WAIT_V(6); PG8_BAR; PG8_MMA(1, 1, At, B1); PG8_BAR;
    }
    gemm_epilogue<MODE>(p, acc, cur, wr, wc, fr, fq);
    if (!has_next) break;
#pragma unroll
    for (int a = 0; a < 2; ++a)
#pragma unroll
      for (int b = 0; b < 2; ++b)
#pragma unroll
        for (int m = 0; m < 4; ++m)
#pragma unroll
          for (int n = 0; n < 2; ++n) acc[a][b][m][n] = (f32x4){0.f, 0.f, 0.f, 0.f};
    cur = nxt; cA = nA; cB = nB; ++ui;
  }
  PG8_WAIT_V(0);
  if (wr == 0) PG8_BAR;
  PG8_BAR;
#undef PG8_SA
#undef PG8_SB
#undef PG8_STAGE
#undef PG8_LDA
#undef PG8_LDB
#undef PG8_MMA
#undef PG8_WAIT_V
#undef PG8_WAIT_L
#undef PG8_BAR
#undef PG8_SCHED
}


template <int PASS>
__device__ __forceinline__ void delta_rowpass(const Params& p, int t0, int n, int h, int w, int lane, float Gv, u16* RA, u16* RBk,
                                              u16* RC) {
  const u16* Zp = reinterpret_cast<const u16*>(p.ws + Z1);
  const float* betap = reinterpret_cast<const float*>(p.ws + SM_BETA);
  const int c1 = (PASS == 0 ? 0 : 512) + h * 128 + 2 * lane;
  const int c2 = (PASS == 0 ? 512 : 1024) + h * 128 + 2 * lane;
  float w1[4][2], w2[4][2];
#pragma unroll
  for (int j = 0; j < 4; ++j) {
    w1[j][0] = p.w_conv_a[j * 1536 + c1]; w1[j][1] = p.w_conv_a[j * 1536 + c1 + 1];
    w2[j][0] = p.w_conv_a[j * 1536 + c2]; w2[j][1] = p.w_conv_a[j * 1536 + c2 + 1];
  }
  const int r0 = 16 * w;
  const u16* zbase = Zp + (size_t)(t0 + r0) * 3072;
  float h1[3][2], h2[3][2];
#pragma unroll
  for (int j = 0; j < 3; ++j) {
    unsigned ua = 0u, ub = 0u;
    if (n * 64 + r0 + j - 3 >= 0) {
      ua = *reinterpret_cast<const unsigned*>(zbase + (ptrdiff_t)(j - 3) * 3072 + c1);
      ub = *reinterpret_cast<const unsigned*>(zbase + (ptrdiff_t)(j - 3) * 3072 + c2);
    }
    h1[j][0] = lo2f(ua); h1[j][1] = hi2f(ua); h2[j][0] = lo2f(ub); h2[j][1] = hi2f(ub);
  }
  unsigned qa0, qa1, qa2, qa3, qa4, qa5, qb0, qb1, qb2, qb3, qb4, qb5;
#define RLOAD(i, A_, B_) A_ = *reinterpret_cast<const unsigned*>(zbase + (size_t)(i) * 3072 + c1); B_ = *reinterpret_cast<const unsigned*>(zbase + (size_t)(i) * 3072 + c2);
  RLOAD(0, qa0, qb0) RLOAD(1, qa1, qb1) RLOAD(2, qa2, qb2) RLOAD(3, qa3, qb3) RLOAD(4, qa4, qb4) RLOAD(5, qa5, qb5)
#pragma unroll 1
  for (int rr = 0; rr < 16; ++rr) {
    const int r = r0 + rr;
    const unsigned ua = qa0, ub = qb0;
    qa0 = qa1; qa1 = qa2; qa2 = qa3; qa3 = qa4; qa4 = qa5;
    qb0 = qb1; qb1 = qb2; qb2 = qb3; qb3 = qb4; qb4 = qb5;
    if (rr + 6 < 16) { RLOAD(rr + 6, qa5, qb5) }
    const float a0 = lo2f(ua), a1 = hi2f(ua), b0 = lo2f(ub), b1 = hi2f(ub);
    float y10 = silu_f(w1[0][0] * h1[0][0] + w1[1][0] * h1[1][0] + w1[2][0] * h1[2][0] + w1[3][0] * a0);
    float y11 = silu_f(w1[0][1] * h1[0][1] + w1[1][1] * h1[1][1] + w1[2][1] * h1[2][1] + w1[3][1] * a1);
    float y20 = silu_f(w2[0][0] * h2[0][0] + w2[1][0] * h2[1][0] + w2[2][0] * h2[2][0] + w2[3][0] * b0);
    float y21 = silu_f(w2[0][1] * h2[0][1] + w2[1][1] * h2[1][1] + w2[2][1] * h2[2][1] + w2[3][1] * b1);
    const float bt = betap[(size_t)(t0 + r) * 4 + h];
    if (PASS == 0) {
      float qs = wave_sum(y10 * y10 + y11 * y11), ks = wave_sum(y20 * y20 + y21 * y21);
      float qn = rsqrtf(qs + EPS) * 0.08838834764831845f, kn = rsqrtf(ks + EPS);
      float k0 = y20 * kn, k1 = y21 * kn;
      *reinterpret_cast<unsigned*>(RA + r * 136 + 2 * lane) = pack2(k0, k1);
      *reinterpret_cast<unsigned*>(RBk + r * 136 + 2 * lane) = pack2(k0 * bt, k1 * bt);
      *reinterpret_cast<unsigned*>(RC + r * 136 + 2 * lane) = pack2(y10 * qn, y11 * qn);
    } else {
      float ks = wave_sum(y10 * y10 + y11 * y11);
      float sc = rsqrtf(ks + EPS) * bt * __expf(__shfl(Gv, r, 64));
      RA[(2 * lane) * 72 + r] = f2bf(y10 * sc);
      RA[(2 * lane + 1) * 72 + r] = f2bf(y11 * sc);
      RC[(2 * lane) * 72 + r] = f2bf(y20 * bt);
      RC[(2 * lane + 1) * 72 + r] = f2bf(y21 * bt);
    }
#pragma unroll
    for (int c = 0; c < 2; ++c) {
      h1[0][c] = h1[1][c]; h1[1][c] = h1[2][c];
      h2[0][c] = h2[1][c]; h2[1][c] = h2[2][c];
    }
    h1[2][0] = a0; h1[2][1] = a1; h2[2][0] = b0; h2[2][1] = b1;
  }
#undef RLOAD
}

__device__ __forceinline__ void m1_delta_item(const Params& p, int item, char* smem) {
  const int tid = VTID, lane = tid & 63, w = tid >> 6, lr = lane & 15, lq = lane >> 4;
  const int h = item & 3, n = (item >> 2) & 31, b = item >> 7;
  const int t0 = b * 2048 + n * 64;
  u16* RA = reinterpret_cast<u16*>(smem);
  u16* RBk = reinterpret_cast<u16*>(smem + 18432);
  u16* RC = reinterpret_cast<u16*>(smem + 36864);
  u16* RD = reinterpret_cast<u16*>(smem + 55296);
  float* Gs = reinterpret_cast<float*>(smem + 73728);
  const float* gdec = reinterpret_cast<const float*>(p.ws + SM_GDEC);

  float Gv = gdec[(size_t)(t0 + lane) * 4 + h];
#pragma unroll
  for (int o = 1; o < 64; o <<= 1) {
    float tv = __shfl_up(Gv, o, 64);
    if (lane >= o) Gv += tv;
  }
  if (w == 0) {
    Gs[lane] = Gv;
    reinterpret_cast<float*>(p.ws + D_GC)[(size_t)item * 64 + lane] = Gv;
  }
  delta_rowpass<0>(p, t0, n, h, w, lane, Gv, RA, RBk, RC);
  __syncthreads();
  {
    f32x4 accL[4], accA[4];
#pragma unroll
    for (int jb = 0; jb < 4; ++jb) { accL[jb] = (f32x4){0.f, 0.f, 0.f, 0.f}; accA[jb] = (f32x4){0.f, 0.f, 0.f, 0.f}; }
#pragma unroll
    for (int ks = 0; ks < 4; ++ks) {
      bf16x8 a1 = lds_frag(RBk, 136, 16 * w, ks * 32, lane);
      bf16x8 a2 = lds_frag(RC, 136, 16 * w, ks * 32, lane);
#pragma unroll
      for (int jb = 0; jb < 4; ++jb) {
        if (jb <= w) {
          bf16x8 bb = lds_frag(RA, 136, 16 * jb, ks * 32, lane);
          accL[jb] = mfma16(a1, bb, accL[jb]);
          accA[jb] = mfma16(a2, bb, accA[jb]);
        }
      }
    }
    __syncthreads();
    float* Lm = reinterpret_cast<float*>(RBk);
#pragma unroll
    for (int jb = 0; jb < 4; ++jb)
#pragma unroll
      for (int j = 0; j < 4; ++j) {
        int i = 16 * w + 4 * lq + j, jj = jb * 16 + lr;
        float dec = __expf(fminf(Gs[i] - Gs[jj], 0.f));
        float lv = (i > jj) ? accL[jb][j] * dec : 0.f;
        float av = (i >= jj) ? accA[jb][j] * dec : 0.f;
        Lm[i * 64 + jj] = lv;
        RD[i * 72 + jj] = f2bf(av);
      }
  }
  __syncthreads();
  store_frags(RC, 136, 64, 128, reinterpret_cast<u16*>(p.ws + D_QF) + (size_t)item * 8192, tid, NTHR);
  store_frags(RD, 72, 64, 64, reinterpret_cast<u16*>(p.ws + D_ATT) + (size_t)item * 4096, tid, NTHR);
  store_frags_T(RA, 136, 128, 64, reinterpret_cast<u16*>(p.ws + D_KNT) + (size_t)item * 8192, tid, NTHR);
  __syncthreads();
  {
    const float* Lm = reinterpret_cast<const float*>(RBk);
    float* Tm = reinterpret_cast<float*>(RA);
    float* Ms = reinterpret_cast<float*>(RC) + w * 256;
    {
      const int c = lane & 15, i0 = 16 * w;
      float tc[16];
#pragma unroll
      for (int r = 0; r < 16; ++r) {
        float a = (r == c) ? 1.f : 0.f;
#pragma unroll
        for (int k = 0; k < r; ++k) a -= Lm[(i0 + r) * 64 + i0 + k] * tc[k];
        tc[r] = a;
      }
      if (lane < 16) {
#pragma unroll
        for (int r = 0; r < 16; ++r) Tm[(i0 + r) * 64 + i0 + c] = tc[r];
      }
    }
    __syncthreads();
    {
      const int j = w;
      for (int i = j + 1; i < 4; ++i) {
        f32x4 macc = (f32x4){0.f, 0.f, 0.f, 0.f};
        for (int k = j; k < i; ++k) {
#pragma unroll
          for (int ks = 0; ks < 4; ++ks) {
            float av = Lm[(16 * i + lr) * 64 + 16 * k + 4 * ks + lq];
            float bv = Tm[(16 * k + 4 * ks + lq) * 64 + 16 * j + lr];
            macc = __builtin_amdgcn_mfma_f32_16x16x4f32(av, bv, macc, 0, 0, 0);
          }
        }
#pragma unroll
        for (int r = 0; r < 4; ++r) Ms[(4 * lq + r) * 16 + lr] = macc[r];
        __builtin_amdgcn_wave_barrier();
        f32x4 tacc = (f32x4){0.f, 0.f, 0.f, 0.f};
#pragma unroll
        for (int ks = 0; ks < 4; ++ks) {
          float av = Tm[(16 * i + lr) * 64 + 16 * i + 4 * ks + lq];
          float bv = Ms[(4 * ks + lq) * 16 + lr];
          tacc = __builtin_amdgcn_mfma_f32_16x16x4f32(av, bv, tacc, 0, 0, 0);
        }
#pragma unroll
        for (int r = 0; r < 4; ++r) Tm[(16 * i + 4 * lq + r) * 64 + 16 * j + lr] = -tacc[r];
        __builtin_amdgcn_wave_barrier();
      }
    }
    __syncthreads();
    {
      u16* Tb = RD + 64 * 72;
      for (int idx = tid; idx < 4096; idx += NTHR) {
        int r = idx >> 6, c = idx & 63;
        float v = ((c >> 4) <= (r >> 4)) ? Tm[idx] : 0.f;
        Tb[r * 72 + c] = f2bf(v);
      }
    }
    __syncthreads();
  }
  delta_rowpass<1>(p, t0, n, h, w, lane, Gv, RA, RBk, RC);
  __syncthreads();
  {
    const u16* Tm = RD + 64 * 72;
    bf16x8 tf[4][2];
#pragma unroll
    for (int cb = 0; cb < 4; ++cb)
#pragma unroll
      for (int ks = 0; ks < 2; ++ks) tf[cb][ks] = lds_frag(Tm, 72, cb * 16, ks * 32, lane);
    u16* valt = reinterpret_cast<u16*>(p.ws + D_VALT) + (size_t)item * 8192;
#pragma unroll
    for (int ee = 0; ee < 2; ++ee) {
      int eb = 2 * w + ee;
      bf16x8 a0 = lds_frag(RC, 72, eb * 16, 0, lane), a1 = lds_frag(RC, 72, eb * 16, 32, lane);
#pragma unroll
      for (int cb = 0; cb < 4; ++cb) {
        f32x4 c = (f32x4){0.f, 0.f, 0.f, 0.f};
        c = mfma16(a0, tf[cb][0], c);
        c = mfma16(a1, tf[cb][1], c);
        *reinterpret_cast<uint2*>(valt + ((size_t)(eb * 4 + cb) * 64 + lane) * 4) = make_uint2(pack2(c[0], c[1]), pack2(c[2], c[3]));
      }
    }
#pragma unroll
    for (int dd = 0; dd < 2; ++dd) {
      int db = 2 * w + dd;
      bf16x8 b0 = lds_frag(RA, 72, db * 16, 0, lane), b1 = lds_frag(RA, 72, db * 16, 32, lane);
#pragma unroll
      for (int cb = 0; cb < 4; ++cb) {
        f32x4 c = (f32x4){0.f, 0.f, 0.f, 0.f};
        c = mfma16(tf[cb][0], b0, c);
        c = mfma16(tf[cb][1], b1, c);
#pragma unroll
        for (int j = 0; j < 4; ++j) RBk[(cb * 16 + 4 * lq + j) * 136 + db * 16 + lr] = f2bf(c[j]);
      }
    }
  }
  __syncthreads();
  store_frags(RBk, 136, 64, 128, reinterpret_cast<u16*>(p.ws + D_KCD) + (size_t)item * 8192, tid, NTHR);
  __syncthreads();
}

__device__ __forceinline__ void m1_hgrn_item(const Params& p, int item, char* smem) {
  const int tid = VTID, lane = tid & 63, w = tid >> 6, lr = lane & 15, lq = lane >> 4;
  const int h = item & 3, n = (item >> 2) & 63, b = item >> 8;
  const int t0 = b * 2048 + n * 32;
  u16* QG = reinterpret_cast<u16*>(smem);
  u16* QR = reinterpret_cast<u16*>(smem + 8704);
  u16* KR = reinterpret_cast<u16*>(smem + 17408);
  u16* KGT = reinterpret_cast<u16*>(smem + 26112);
  u16* VT = reinterpret_cast<u16*>(smem + 36352);
  float* tot = reinterpret_cast<float*>(smem + 46592);
  float* bls = tot + 128;
  const u16* Zp = reinterpret_cast<const u16*>(p.ws + Z1);
  const int e = tid & 127, half = tid >> 7;
  const int he = h * 128 + e;
  const float lb = sigmoid_f(p.lb_logits[he] - p.lb_logits[512 + he]);
  float q[16], k[16], bc[16];
  float run = 0.f;
#pragma unroll
  for (int i = 0; i < 16; ++i) {
    const u16* zr = Zp + (size_t)(t0 + half * 16 + i) * 3072;
    float qb = bf2f(zr[1536 + he]), fb = bf2f(zr[2048 + he]);
    float f = lb + (1.f - lb) * sigmoid_f(fb);
    run += __logf(f);
    q[i] = silu_f(qb); k[i] = 1.f - f; bc[i] = run;
    VT[e * 40 + half * 16 + i] = zr[2560 + he];
  }
  if (half == 0) tot[e] = run;
  __syncthreads();
  const float bref = tot[e];
  if (half == 1) {
#pragma unroll
    for (int i = 0; i < 16; ++i) bc[i] += bref;
    bls[e] = bc[15];
  }
  __syncthreads();
  const float bl = bls[e];
  if (half == 0) reinterpret_cast<float*>(p.ws + H_EBL)[(size_t)item * 128 + e] = __expf(bl);
#pragma unroll
  for (int i = 0; i < 16; ++i) {
    int r = half * 16 + i;
    QG[r * 136 + e] = f2bf(q[i] * __expf(bc[i]));
    QR[r * 136 + e] = f2bf(q[i] * __expf(bc[i] - bref));
    KR[r * 136 + e] = f2bf(k[i] * __expf(bref - bc[i]));
    KGT[e * 40 + r] = f2bf(k[i] * __expf(bl - bc[i]));
  }
  __syncthreads();
  {
    const int ib = w >> 1, jb = w & 1;
    f32x4 c = (f32x4){0.f, 0.f, 0.f, 0.f};
    if (jb <= ib) {
#pragma unroll
      for (int ks = 0; ks < 4; ++ks) c = mfma16(lds_frag(QR, 136, ib * 16, ks * 32, lane), lds_frag(KR, 136, jb * 16, ks * 32, lane), c);
    }
    u16* att = reinterpret_cast<u16*>(p.ws + H_ATT) + (size_t)item * 1024;
#pragma unroll
    for (int j = 0; j < 4; ++j) {
      int i = ib * 16 + 4 * lq + j, jj = jb * 16 + lr;
      float v = (i >= jj) ? c[j] : 0.f;
      att[(ib * 64 + (i & 15) + 16 * (jj >> 3)) * 8 + (jj & 7)] = f2bf(v);
    }
  }
  store_frags(QG, 136, 32, 128, reinterpret_cast<u16*>(p.ws + H_QG) + (size_t)item * 4096, tid, NTHR);
  store_frags(KGT, 40, 128, 32, reinterpret_cast<u16*>(p.ws + H_KGT) + (size_t)item * 4096, tid, NTHR);
  store_frags(VT, 40, 128, 32, reinterpret_cast<u16*>(p.ws + H_VT) + (size_t)item * 4096, tid, NTHR);
  __syncthreads();
}

struct DPre {
  bf16x8 kcd[4], q[4], att[2], knt[2][2];
  uint2 val[2];
  float gc, gl;
  float4 gi;
};
__device__ __forceinline__ void m2d_loadA(const Params& p, int base, int es, int w, int lane, DPre& d) {
  const int lr = lane & 15, lq = lane >> 4;
  const bf16x8* kcd = reinterpret_cast<const bf16x8*>(p.ws + D_KCD + (size_t)base * 16384);
  const uint2* val = reinterpret_cast<const uint2*>(p.ws + D_VALT + (size_t)base * 16384);
  const float* gc = reinterpret_cast<const float*>(p.ws + D_GC) + (size_t)base * 64;
#pragma unroll
  for (int ks = 0; ks < 4; ++ks) d.kcd[ks] = kcd[(w * 4 + ks) * 64 + lane];
#pragma unroll
  for (int eb = 0; eb < 2; ++eb) d.val[eb] = val[((es * 2 + eb) * 4 + w) * 64 + lane];
  d.gc = gc[w * 16 + lr];
  d.gl = gc[63];
  d.gi = *reinterpret_cast<const float4*>(gc + 16 * w + 4 * lq);
}
__device__ __forceinline__ void m2d_loadB(const Params& p, int base, int w, int lane, DPre& d) {
  const bf16x8* qf = reinterpret_cast<const bf16x8*>(p.ws + D_QF + (size_t)base * 16384);
  const bf16x8* att = reinterpret_cast<const bf16x8*>(p.ws + D_ATT + (size_t)base * 8192);
#pragma unroll
  for (int ks = 0; ks < 4; ++ks) d.q[ks] = qf[(w * 4 + ks) * 64 + lane];
#pragma unroll
  for (int ks = 0; ks < 2; ++ks) d.att[ks] = att[(w * 2 + ks) * 64 + lane];
}
__device__ __forceinline__ void m2d_loadC(const Params& p, int base, int w, int lane, DPre& d) {
  const bf16x8* knt = reinterpret_cast<const bf16x8*>(p.ws + D_KNT + (size_t)base * 16384);
#pragma unroll
  for (int ks = 0; ks < 2; ++ks) {
    d.knt[0][ks] = knt[((2 * w) * 2 + ks) * 64 + lane];
    d.knt[1][ks] = knt[((2 * w + 1) * 2 + ks) * 64 + lane];
  }
}

__device__ __forceinline__ void m2_delta_item(const Params& p, int item, char* smem) {
  const int tid = VTID, lane = tid & 63, w = tid >> 6, lr = lane & 15, lq = lane >> 4;
  const int es = item & 3, h = (item >> 2) & 3, b = item >> 4;
  u16* Sb = reinterpret_cast<u16*>(smem);
  u16* Ub = reinterpret_cast<u16*>(smem + 17408);
  u16* Usb = reinterpret_cast<u16*>(smem + 22016);
  for (int i = tid; i < 32 * 136; i += NTHR) Sb[i] = 0;
  f32x4 accS[2][2];
#pragma unroll
  for (int i = 0; i < 2; ++i)
#pragma unroll
    for (int j = 0; j < 2; ++j) accS[i][j] = (f32x4){0.f, 0.f, 0.f, 0.f};
  u16* OA = reinterpret_cast<u16*>(reinterpret_cast<char*>(p.out) + YB_OA);
  DPre cur;
  m2d_loadA(p, (b * 32 + 0) * 4 + h, es, w, lane, cur);
  m2d_loadB(p, (b * 32 + 0) * 4 + h, w, lane, cur);
  m2d_loadC(p, (b * 32 + 0) * 4 + h, w, lane, cur);
  __syncthreads();
  for (int n = 0; n < 32; ++n) {
    const int nbase = (b * 32 + (n + 1 < 32 ? n + 1 : n)) * 4 + h;
    const u16* Sc = Sb + (n & 1) * (32 * 136);
    u16* Sn = Sb + ((n + 1) & 1) * (32 * 136);
    f32x4 accP[2];
    accP[0] = (f32x4){0.f, 0.f, 0.f, 0.f}; accP[1] = accP[0];
#pragma unroll
    for (int ks = 0; ks < 4; ++ks) {
      accP[0] = mfma16(lds_frag(Sc, 136, 0, ks * 32, lane), cur.kcd[ks], accP[0]);
      accP[1] = mfma16(lds_frag(Sc, 136, 16, ks * 32, lane), cur.kcd[ks], accP[1]);
    }
    const float egc = __expf(cur.gl - cur.gc);
    const float egl = __expf(cur.gl);
    const float egi[4] = {__expf(cur.gi.x), __expf(cur.gi.y), __expf(cur.gi.z), __expf(cur.gi.w)};
    float vv[2][4];
#pragma unroll
    for (int eb = 0; eb < 2; ++eb) { vv[eb][0] = lo2f(cur.val[eb].x); vv[eb][1] = hi2f(cur.val[eb].x); vv[eb][2] = lo2f(cur.val[eb].y); vv[eb][3] = hi2f(cur.val[eb].y); }
    m2d_loadA(p, nbase, es, w, lane, cur);
#pragma unroll
    for (int eb = 0; eb < 2; ++eb) {
#pragma unroll
      for (int j = 0; j < 4; ++j) {
        float u = vv[eb][j] - accP[eb][j];
        int e = eb * 16 + 4 * lq + j, c = 16 * w + lr;
        Ub[e * 72 + c] = f2bf(u);
        Usb[e * 72 + c] = f2bf(u * egc);
      }
    }
    lds_barrier();
    {
      f32x4 accO[2];
      accO[0] = (f32x4){0.f, 0.f, 0.f, 0.f}; accO[1] = accO[0];
#pragma unroll
      for (int ks = 0; ks < 4; ++ks) {
        accO[0] = mfma16(cur.q[ks], lds_frag(Sc, 136, 0, ks * 32, lane), accO[0]);
        accO[1] = mfma16(cur.q[ks], lds_frag(Sc, 136, 16, ks * 32, lane), accO[1]);
      }
#pragma unroll
      for (int eb = 0; eb < 2; ++eb)
#pragma unroll
        for (int j = 0; j < 4; ++j) accO[eb][j] *= egi[j];
#pragma unroll
      for (int ks = 0; ks < 2; ++ks) {
        accO[0] = mfma16(cur.att[ks], lds_frag(Ub, 72, 0, ks * 32, lane), accO[0]);
        accO[1] = mfma16(cur.att[ks], lds_frag(Ub, 72, 16, ks * 32, lane), accO[1]);
      }
      m2d_loadB(p, nbase, w, lane, cur);
#pragma unroll
      for (int eb = 0; eb < 2; ++eb)
#pragma unroll
        for (int j = 0; j < 4; ++j) {
          int tok = b * 2048 + n * 64 + 16 * w + 4 * lq + j;
          OA[(size_t)tok * 512 + h * 128 + es * 32 + eb * 16 + lr] = f2bf(accO[eb][j]);
        }
    }
    {
#pragma unroll
      for (int eb = 0; eb < 2; ++eb) {
        bf16x8 a0 = lds_frag(Usb, 72, eb * 16, 0, lane), a1 = lds_frag(Usb, 72, eb * 16, 32, lane);
#pragma unroll
        for (int dd = 0; dd < 2; ++dd) {
#pragma unroll
          for (int j = 0; j < 4; ++j) accS[eb][dd][j] *= egl;
          accS[eb][dd] = mfma16(a0, cur.knt[dd][0], accS[eb][dd]);
          accS[eb][dd] = mfma16(a1, cur.knt[dd][1], accS[eb][dd]);
#pragma unroll
          for (int j = 0; j < 4; ++j) Sn[(eb * 16 + 4 * lq + j) * 136 + (2 * w + dd) * 16 + lr] = f2bf(accS[eb][dd][j]);
        }
      }
    }
    m2d_loadC(p, nbase, w, lane, cur);
    lds_barrier();
  }
  float* outp = p.out + O_DELTAP + (size_t)(b * 4 + h) * 16384;
#pragma unroll
  for (int eb = 0; eb < 2; ++eb)
#pragma unroll
    for (int dd = 0; dd < 2; ++dd) {
      int d = (2 * w + dd) * 16 + lr, e0 = es * 32 + eb * 16 + 4 * lq;
      *reinterpret_cast<float4*>(outp + (size_t)d * 128 + e0) =
          make_float4(accS[eb][dd][0], accS[eb][dd][1], accS[eb][dd][2], accS[eb][dd][3]);
    }
  __syncthreads();
}

struct HPre {
  bf16x8 qg[4], att, vt[2], kgt[2];
  float ebl[2];
};
__device__ __forceinline__ HPre m2h_load(const Params& p, int base, int vs, int w, int lane) {
  HPre d;
  const int lr = lane & 15;
  const bf16x8* qg = reinterpret_cast<const bf16x8*>(p.ws + H_QG + (size_t)base * 8192);
  const bf16x8* att = reinterpret_cast<const bf16x8*>(p.ws + H_ATT + (size_t)base * 2048);
  const bf16x8* vt = reinterpret_cast<const bf16x8*>(p.ws + H_VT + (size_t)base * 8192);
  const bf16x8* kgt = reinterpret_cast<const bf16x8*>(p.ws + H_KGT + (size_t)base * 8192);
  const float* ebl = reinterpret_cast<const float*>(p.ws + H_EBL) + (size_t)base * 128;
  const int ib = w >> 1;
#pragma unroll
  for (int ks = 0; ks < 4; ++ks) d.qg[ks] = qg[(ib * 4 + ks) * 64 + lane];
  d.att = att[ib * 64 + lane];
  d.vt[0] = vt[(vs * 2 + 0) * 64 + lane];
  d.vt[1] = vt[(vs * 2 + 1) * 64 + lane];
  d.kgt[0] = kgt[(2 * w) * 64 + lane];
  d.kgt[1] = kgt[(2 * w + 1) * 64 + lane];
  d.ebl[0] = ebl[(2 * w) * 16 + lr];
  d.ebl[1] = ebl[(2 * w + 1) * 16 + lr];
  return d;
}

__device__ __forceinline__ void m2_hgrn_item(const Params& p, int item, char* smem) {
  const int tid = VTID, lane = tid & 63, w = tid >> 6, lr = lane & 15, lq = lane >> 4;
  const int vs = item & 3, h = (item >> 2) & 3, b = item >> 4;
  u16* Sb = reinterpret_cast<u16*>(smem);
  for (int i = tid; i < 32 * 136; i += NTHR) Sb[i] = 0;
  f32x4 accS[2][2];
#pragma unroll
  for (int i = 0; i < 2; ++i)
#pragma unroll
    for (int j = 0; j < 2; ++j) accS[i][j] = (f32x4){0.f, 0.f, 0.f, 0.f};
  u16* OB = reinterpret_cast<u16*>(reinterpret_cast<char*>(p.out) + YB_OB);
  const int ib = w >> 1, vb = w & 1;
  HPre cur = m2h_load(p, (b * 64 + 0) * 4 + h, vs, w, lane), nxt = cur;
  __syncthreads();
  for (int n = 0; n < 64; ++n) {
    if (n + 1 < 64) nxt = m2h_load(p, (b * 64 + n + 1) * 4 + h, vs, w, lane);
    const u16* Sc = Sb + (n & 1) * (32 * 136);
    u16* Sn = Sb + ((n + 1) & 1) * (32 * 136);
    {
      f32x4 o = (f32x4){0.f, 0.f, 0.f, 0.f};
#pragma unroll
      for (int ks = 0; ks < 4; ++ks) o = mfma16(cur.qg[ks], lds_frag(Sc, 136, vb * 16, ks * 32, lane), o);
      o = mfma16(cur.att, vb ? cur.vt[1] : cur.vt[0], o);
#pragma unroll
      for (int j = 0; j < 4; ++j) {
        int tok = b * 2048 + n * 32 + ib * 16 + 4 * lq + j;
        OB[(size_t)tok * 512 + h * 128 + vs * 32 + vb * 16 + lr] = f2bf(o[j]);
      }
    }
#pragma unroll
    for (int v2 = 0; v2 < 2; ++v2)
#pragma unroll
      for (int dd = 0; dd < 2; ++dd) {
#pragma unroll
        for (int j = 0; j < 4; ++j) accS[v2][dd][j] *= cur.ebl[dd];
        accS[v2][dd] = mfma16(cur.vt[v2], cur.kgt[dd], accS[v2][dd]);
#pragma unroll
        for (int j = 0; j < 4; ++j) Sn[(v2 * 16 + 4 * lq + j) * 136 + (2 * w + dd) * 16 + lr] = f2bf(accS[v2][dd][j]);
      }
    lds_barrier();
    cur = nxt;
  }
  float* outp = p.out + O_HGRNP + (size_t)(b * 4 + h) * 16384;
#pragma unroll
  for (int v2 = 0; v2 < 2; ++v2)
#pragma unroll
    for (int dd = 0; dd < 2; ++dd) {
      int e = (2 * w + dd) * 16 + lr, v0 = vs * 32 + v2 * 16 + 4 * lq;
      *reinterpret_cast<float4*>(outp + (size_t)e * 128 + v0) =
          make_float4(accS[v2][dd][0], accS[v2][dd][1], accS[v2][dd][2], accS[v2][dd][3]);
    }
  __syncthreads();
}

__device__ __forceinline__ void ms_delta_item(const Params& p, int item, char* smem) {
  const int tid = VTID, lane = tid & 63, w = tid >> 6;
  const int h = item & 3, b = item >> 2;
  const int R0 = TP + b * 4;
  float* qkv = reinterpret_cast<float*>(smem);
  float* red = reinterpret_cast<float*>(smem + 6144);
  const u16* Zp = reinterpret_cast<const u16*>(p.ws + Z1);
  for (int c = tid; c < 384; c += NTHR) {
    int col = c < 128 ? h * 128 + c : (c < 256 ? 512 + h * 128 + c - 128 : 1024 + h * 128 + c - 256);
    float xs[7];
#pragma unroll
    for (int j = 0; j < 3; ++j) xs[j] = p.cache_conv[(size_t)(b * 3 + j) * 1536 + col];
#pragma unroll
    for (int t = 0; t < 4; ++t) xs[3 + t] = bf2f(Zp[(size_t)(R0 + t) * 3072 + col]);
    float wc[4];
#pragma unroll
    for (int j = 0; j < 4; ++j) wc[j] = p.w_conv_a[j * 1536 + col];
#pragma unroll
    for (int t = 0; t < 4; ++t) {
      float y = xs[t] * wc[0] + xs[t + 1] * wc[1] + xs[t + 2] * wc[2] + xs[t + 3] * wc[3];
      qkv[t * 384 + c] = silu_f(y);
    }
  }
  __syncthreads();
  {
    const int t = w;
    float q0 = qkv[t * 384 + lane], q1 = qkv[t * 384 + 64 + lane];
    float k0 = qkv[t * 384 + 128 + lane], k1 = qkv[t * 384 + 192 + lane];
    float qs = wave_sum(q0 * q0 + q1 * q1), ks = wave_sum(k0 * k0 + k1 * k1);
    float qn = rsqrtf(qs + EPS) * 0.08838834764831845f, kn = rsqrtf(ks + EPS);
    qkv[t * 384 + lane] = q0 * qn; qkv[t * 384 + 64 + lane] = q1 * qn;
    qkv[t * 384 + 128 + lane] = k0 * kn; qkv[t * 384 + 192 + lane] = k1 * kn;
  }
  __syncthreads();
  const int e = tid & 127, dh = tid >> 7;
  float S[64];
  const float* s0 = p.state_delta + (size_t)(b * 4 + h) * 16384 + (size_t)(dh * 64) * 128 + e;
#pragma unroll
  for (int dd = 0; dd < 64; ++dd) S[dd] = s0[(size_t)dd * 128];
  const float* gdec = reinterpret_cast<const float*>(p.ws + SM_GDEC);
  const float* betap = reinterpret_cast<const float*>(p.ws + SM_BETA);
  u16* OA = reinterpret_cast<u16*>(reinterpret_cast<char*>(p.out) + YB_OA);
  for (int t = 0; t < 4; ++t) {
    const float a = __expf(gdec[(size_t)(R0 + t) * 4 + h]), bt = betap[(size_t)(R0 + t) * 4 + h];
    const float* qv = qkv + t * 384 + dh * 64;
    const float* kv = qkv + t * 384 + 128 + dh * 64;
    float rp = 0.f;
#pragma unroll
    for (int dd = 0; dd < 64; ++dd) rp += S[dd] * kv[dd];
    red[((t * 2 + 0) * 2 + dh) * 128 + e] = rp;
    __syncthreads();
    float r = a * (red[((t * 2 + 0) * 2 + 0) * 128 + e] + red[((t * 2 + 0) * 2 + 1) * 128 + e]);
    float u = bt * (qkv[t * 384 + 256 + e] - r);
    float op = 0.f;
#pragma unroll
    for (int dd = 0; dd < 64; ++dd) {
      S[dd] = a * S[dd] + kv[dd] * u;
      op += S[dd] * qv[dd];
    }
    red[((t * 2 + 1) * 2 + dh) * 128 + e] = op;
    __syncthreads();
    if (dh == 0) {
      float o = red[((t * 2 + 1) * 2 + 0) * 128 + e] + red[((t * 2 + 1) * 2 + 1) * 128 + e];
      OA[(size_t)(R0 + t) * 512 + h * 128 + e] = f2bf(o);
    }
  }
  float* so = p.out + O_DELTAS + (size_t)(b * 4 + h) * 16384 + (size_t)(dh * 64) * 128 + e;
#pragma unroll
  for (int dd = 0; dd < 64; ++dd) so[(size_t)dd * 128] = S[dd];
  __syncthreads();
}

__device__ __forceinline__ void ms_hgrn_item(const Params& p, int item, char* smem) {
  const int tid = VTID;
  const int h = item & 3, b = item >> 2;
  const int R0 = TP + b * 4;
  float* qs = reinterpret_cast<float*>(smem);
  float* fs = qs + 512;
  float* vsm = fs + 512;
  float* red = vsm + 512;
  const u16* Zp = reinterpret_cast<const u16*>(p.ws + Z1);
  for (int i = tid; i < 512; i += NTHR) {
    int t = i >> 7, e = i & 127, he = h * 128 + e;
    const u16* zr = Zp + (size_t)(R0 + t) * 3072;
    float lb = sigmoid_f(p.lb_logits[he] - p.lb_logits[512 + he]);
    qs[i] = silu_f(bf2f(zr[1536 + he]));
    fs[i] = lb + (1.f - lb) * sigmoid_f(bf2f(zr[2048 + he]));
    vsm[i] = bf2f(zr[2560 + he]);
  }
  __syncthreads();
  const int v = tid & 127, eh = tid >> 7;
  float S[64];
  const float* s0 = p.state_hgrn + (size_t)(b * 4 + h) * 16384 + (size_t)(eh * 64) * 128 + v;
#pragma unroll
  for (int ee = 0; ee < 64; ++ee) S[ee] = s0[(size_t)ee * 128];
  u16* OB = reinterpret_cast<u16*>(reinterpret_cast<char*>(p.out) + YB_OB);
  for (int t = 0; t < 4; ++t) {
    const float vv = vsm[t * 128 + v];
    const float* ft = fs + t * 128 + eh * 64;
    const float* qt = qs + t * 128 + eh * 64;
    float op = 0.f;
#pragma unroll
    for (int ee = 0; ee < 64; ++ee) {
      float f = ft[ee];
      S[ee] = f * S[ee] + (1.f - f) * vv;
      op += S[ee] * qt[ee];
    }
    red[(t * 2 + eh) * 128 + v] = op;
    __syncthreads();
    if (eh == 0) OB[(size_t)(R0 + t) * 512 + h * 128 + v] = f2bf(red[(t * 2) * 128 + v] + red[(t * 2 + 1) * 128 + v]);
  }
  float* so = p.out + O_HGRNS + (size_t)(b * 4 + h) * 16384 + (size_t)(eh * 64) * 128 + v;
#pragma unroll
  for (int ee = 0; ee < 64; ++ee) so[(size_t)ee * 128] = S[ee];
  __syncthreads();
}

__device__ __forceinline__ void phase_m3(const Params& p, char* smem, int bid, int nb) {
  const int tid = VTID, lane = tid & 63, w = tid >> 6;
  float* tl = reinterpret_cast<float*>(smem);
  const int NWT = 704 + 352;
  const int NTASK = (2 * TT) / 4;
  for (int item = bid; item < NWT + NTASK; item += nb) {
    if (item < NWT) {
      if (item < 704) {
        int blk = item >> 2, k0 = (item & 3) * 256;
        int grp = blk >> 3, sub = blk & 7, up = sub >> 2;
        wt_chunk((up ? p.w_ffn_up : p.w_ffn_gate) + grp * 128 + (sub & 3) * 32, DFF, 1024,
                 reinterpret_cast<u16*>(p.ws + W_GU) + (size_t)blk * 32 * 1024, p.g_ffn, tl, k0);
      } else {
        int q = item - 704;
        int n = (q / 11) * 32, k0 = (q % 11) * 256;
        wt_chunk(p.w_ffn_down + n, 1024, DFF, reinterpret_cast<u16*>(p.ws + W_DOWN) + (size_t)n * DFF, nullptr, tl, k0);
      }
    } else {
      int task = (item - NWT) * 4 + w;
      int tok = task >> 1, br = task & 1;
      u16* o = reinterpret_cast<u16*>(reinterpret_cast<char*>(p.out) + (br ? YB_OB : YB_OA)) + (size_t)tok * 512 + lane * 8;
      const u16* og = z2row(p, tok) + 2048 + br * 512 + lane * 8;
      const float* g = (br ? p.g_out_b : p.g_out_a) + (lane & 15) * 8;
      uint4 ov = *reinterpret_cast<const uint4*>(o), gv = *reinterpret_cast<const uint4*>(og);
      unsigned oo[4] = {ov.x, ov.y, ov.z, ov.w}, gg[4] = {gv.x, gv.y, gv.z, gv.w};
      float x[8], y[8];
#pragma unroll
      for (int j = 0; j < 4; ++j) { x[2 * j] = lo2f(oo[j]); x[2 * j + 1] = hi2f(oo[j]); y[2 * j] = lo2f(gg[j]); y[2 * j + 1] = hi2f(gg[j]); }
      float ss = 0.f;
#pragma unroll
      for (int j = 0; j < 8; ++j) ss += x[j] * x[j];
      ss += __shfl_xor(ss, 1, 64); ss += __shfl_xor(ss, 2, 64); ss += __shfl_xor(ss, 4, 64); ss += __shfl_xor(ss, 8, 64);
      float rstd = rsqrtf(ss * (1.f / 128.f) + EPS);
      unsigned r[4];
#pragma unroll
      for (int j = 0; j < 4; ++j)
        r[j] = pack2(x[2 * j] * rstd * g[2 * j] * silu_f(y[2 * j]), x[2 * j + 1] * rstd * g[2 * j + 1] * silu_f(y[2 * j + 1]));
      *reinterpret_cast<uint4*>(o) = make_uint4(r[0], r[1], r[2], r[3]);
    }
  }
}

__device__ __forceinline__ void phase_fixup(const Params& p, int bid, int nb) {
  const float* haloG = reinterpret_cast<const float*>(p.ws + HALO_G);
  const float* headG = reinterpret_cast<const float*>(p.ws + HEAD_G);
  const float* headU = reinterpret_cast<const float*>(p.ws + HEAD_U);
  u16* ACTp = reinterpret_cast<u16*>(p.ws + ACT);
  const int total = 256 * 2 * DFF;
  for (int i = bid * NTHR + VTID; i < total; i += nb * NTHR) {
    int ch = i % DFF, rr = (i / DFF) & 1, blk = i / (2 * DFF);
    if ((blk & 31) == 0) continue;
    float g0 = headG[(size_t)(blk * 2 + rr) * DFF + ch], u = headU[(size_t)(blk * 2 + rr) * DFF + ch];
    float gm1, gm2;
    if (rr == 0) { gm1 = haloG[(size_t)((blk - 1) * 2 + 1) * DFF + ch]; gm2 = haloG[(size_t)((blk - 1) * 2 + 0) * DFF + ch]; }
    else { gm1 = headG[(size_t)(blk * 2 + 0) * DFF + ch]; gm2 = haloG[(size_t)((blk - 1) * 2 + 1) * DFF + ch]; }
    float gc = p.w_ffn_conv[ch] * gm2 + p.w_ffn_conv[DFF + ch] * gm1 + p.w_ffn_conv[2 * DFF + ch] * g0;
    ACTp[(size_t)(blk * 64 + rr) * DFF + ch] = f2bf(silu_f(gc) * u);
  }
}

__device__ __forceinline__ void phase_final(const Params& p, int bid, int nb) {
  const int tid = VTID, lane = tid & 63, w = tid >> 6;
  for (int row = bid * 4 + w; row < TP; row += nb * 8) {
    const int rowB = row + nb * 4;
    const bool hasB = rowB < TP;
    float* ya = p.out + O_YP + (size_t)row * DM;
    float* yb = p.out + O_YP + (size_t)(hasB ? rowB : row) * DM;
    float4 xa[4], xb[4];
#pragma unroll
    for (int i = 0; i < 4; ++i) xa[i] = *reinterpret_cast<const float4*>(ya + i * 256 + lane * 4);
#pragma unroll
    for (int i = 0; i < 4; ++i) xb[i] = *reinterpret_cast<const float4*>(yb + i * 256 + lane * 4);
    float sa = 0.f, sb = 0.f;
#pragma unroll
    for (int i = 0; i < 4; ++i) {
      sa += xa[i].x * xa[i].x + xa[i].y * xa[i].y + xa[i].z * xa[i].z + xa[i].w * xa[i].w;
      sb += xb[i].x * xb[i].x + xb[i].y * xb[i].y + xb[i].z * xb[i].z + xb[i].w * xb[i].w;
    }
    sa = wave_sum(sa); sb = wave_sum(sb);
    const float ra = rsqrtf(sa * (1.f / DM) + EPS), rb = rsqrtf(sb * (1.f / DM) + EPS);
#pragma unroll
    for (int i = 0; i < 4; ++i) {
      float4 g = *reinterpret_cast<const float4*>(p.g_final + i * 256 + lane * 4);
      *reinterpret_cast<float4*>(ya + i * 256 + lane * 4) = make_float4(xa[i].x * ra * g.x, xa[i].y * ra * g.y, xa[i].z * ra * g.z, xa[i].w * ra * g.w);
      if (hasB) *reinterpret_cast<float4*>(yb + i * 256 + lane * 4) = make_float4(xb[i].x * rb * g.x, xb[i].y * rb * g.y, xb[i].z * rb * g.z, xb[i].w * rb * g.w);
    }
  }
  for (int row = TP + bid * 4 + w; row < TT; row += nb * 4) {
    float* y = p.out + O_YP + (size_t)row * DM;
    float4 xv[4];
    float ss = 0.f;
    const float* part = reinterpret_cast<const float*>(p.ws + PART) + (size_t)(row - TP) * 1024;
#pragma unroll
    for (int i = 0; i < 4; ++i) {
      xv[i] = *reinterpret_cast<const float4*>(y + i * 256 + lane * 4);
      for (int ks = 0; ks < 11; ++ks) {
        float4 pv = *reinterpret_cast<const float4*>(part + (size_t)ks * TS * 1024 + i * 256 + lane * 4);
        xv[i].x += pv.x; xv[i].y += pv.y; xv[i].z += pv.z; xv[i].w += pv.w;
      }
      ss += xv[i].x * xv[i].x + xv[i].y * xv[i].y + xv[i].z * xv[i].z + xv[i].w * xv[i].w;
    }
    ss = wave_sum(ss);
    float rstd = rsqrtf(ss * (1.f / DM) + EPS);
#pragma unroll
    for (int i = 0; i < 4; ++i) {
      float4 g = *reinterpret_cast<const float4*>(p.g_final + i * 256 + lane * 4);
      *reinterpret_cast<float4*>(y + i * 256 + lane * 4) =
          make_float4(xv[i].x * rstd * g.x, xv[i].y * rstd * g.y, xv[i].z * rstd * g.z, xv[i].w * rstd * g.w);
    }
  }
}

constexpr int NPHASE = 12;
__device__ __forceinline__ void run_phase(const Params& p, int ph, char* smem_all) {
  int half = threadIdx.x >> 8;
  asm volatile("" : "+v"(half));
  const int bid = blockIdx.x * 2 + half, nb = gridDim.x * 2;
  char* smem = smem_all + half * SMEM_HALF;
  LAS unsigned char* lds = (LAS unsigned char*)smem_all;
  const u16* HB = reinterpret_cast<const u16*>(reinterpret_cast<const char*>(p.out) + YB_H);
  switch (ph) {
    case 0: phase_prep(p, smem, bid, nb); break;
    case 1: { pg8::SchedStatic S; S.init(TT, 3072, (int)gridDim.x, (int)blockIdx.x, 0); gemm_phase8<EPI_Z1>(p, HB, reinterpret_cast<const u16*>(p.ws + W_MAIN), 1024, 1024, lds, S); } break;
    case 2:
      for (int it = bid; it < 1024 + 2048; it += nb) {
        if (it < 1024) m1_delta_item(p, it, smem); else m1_hgrn_item(p, it - 1024, smem);
      }
      break;
    case 3: {
      const int g = blockIdx.x;
      if (g < 128) {
        const int gg = g & 63, xcd = gg & 7, j = gg >> 3;
        const int q = xcd + 8 * (j >> 1), es = 2 * (j & 1) + half;
        if (g < 64) m2_delta_item(p, q * 4 + es, smem); else m2_hgrn_item(p, q * 4 + es, smem);
      } else {
        const int nrest = (gridDim.x - 128) * 2, v0 = (g - 128) * 2 + half;
        for (int it = v0; it < 1024; it += nrest) {
          if (it < 512) ms_delta_item(p, it, smem); else ms_hgrn_item(p, it - 512, smem);
        }
        __syncthreads();
        { pg8::SchedStatic S; S.init(TS, 3072, 24, g - 128, 64);
          gemm_phase8<EPI_Z2>(p, HB, reinterpret_cast<const u16*>(p.ws + W_G2), 1024, 1024, lds, S); }
      }
    } break;
    case 4: { pg8::SchedStatic S; S.init(TP, 3072, (int)gridDim.x, (int)blockIdx.x, 0); gemm_phase8<EPI_Z2>(p, HB, reinterpret_cast<const u16*>(p.ws + W_G2), 1024, 1024, lds, S); } break;
    case 5: phase_m3(p, smem, bid, nb); break;
    case 6: {
      const u16* OA = reinterpret_cast<const u16*>(reinterpret_cast<const char*>(p.out) + YB_OA);
      const u16* OB = reinterpret_cast<const u16*>(reinterpret_cast<const char*>(p.out) + YB_OB);
      { pg8::SchedStatic S; S.init(TT, 1024, (int)gridDim.x, (int)blockIdx.x, 0); gemm_phase8<EPI_MIXA>(p, OA, reinterpret_cast<const u16*>(p.ws + W_A), 512, 512, lds, S);
      gemm_phase8<EPI_MIXB>(p, OB, reinterpret_cast<const u16*>(p.ws + W_B), 512, 512, lds, S); }
    } break;
    case 7: { pg8::SchedStatic S; S.init(TT, 1024, (int)gridDim.x, (int)blockIdx.x, 0); gemm_phase8<EPI_WOUT>(p, reinterpret_cast<const u16*>(p.ws + MIX), reinterpret_cast<const u16*>(p.ws + W_OUT), 1024, 1024, lds, S); } break;
    case 8: {
      { pg8::SchedStatic S; S.init(TP, 5632, (int)gridDim.x, (int)blockIdx.x, 0);
        gemm_phase8<EPI_FFN1>(p, reinterpret_cast<const u16*>(p.ws + X1B), reinterpret_cast<const u16*>(p.ws + W_GU), 1024, 1024, lds, S); }
      { pg8::SchedStatic S; S.init(TS, 5632, (int)gridDim.x, (int)gridDim.x - 1 - (int)blockIdx.x, 64);
        gemm_phase8<EPI_FFN1S>(p, reinterpret_cast<const u16*>(p.ws + X1B), reinterpret_cast<const u16*>(p.ws + W_GU), 1024, 1024, lds, S); }
    } break;
    case 9: phase_fixup(p, bid, nb); break;
    case 10: {
      { pg8::SchedStatic S; S.init(TP, 1024, (int)gridDim.x, (int)blockIdx.x, 0);
        gemm_phase8<EPI_FFN2>(p, reinterpret_cast<const u16*>(p.ws + ACT), reinterpret_cast<const u16*>(p.ws + W_DOWN), DFF, DFF, lds, S); }
      { pg8::SchedSplit S; S.init(2, 4, 11, (int)gridDim.x, (int)blockIdx.x, 64);
        gemm_phase8<EPI_FFN2S>(p, reinterpret_cast<const u16*>(p.ws + ACT), reinterpret_cast<const u16*>(p.ws + W_DOWN), DFF, 256, lds, S); }
    } break;
    case 11: phase_final(p, bid, nb); break;
  }
}

__global__ void __launch_bounds__(512, 2) k_main(Params p, int ph0, int ph1) {
  extern __shared__ __attribute__((aligned(16))) char smem[];
  volatile LAS unsigned* xst = (volatile LAS unsigned*)(smem + 2 * SMEM_HALF);
  if (threadIdx.x == 0) { xst[0] = 0u; xst[1] = 0u; }
  __syncthreads();
  XcdBarrier xb = xcd_barrier_post(reinterpret_cast<unsigned*>(p.ws + BAR_OFF), xst);
  if (ph1 < 0) cg::this_grid().sync();
#define PHASE_STEP(N)                                        \
  if (ph0 <= N && N < ph1) run_phase(p, N, smem);            \
  if (ph0 <= N && N + 1 < ph1) xcd_barrier(xb);
  PHASE_STEP(0) PHASE_STEP(1) PHASE_STEP(2) PHASE_STEP(3) PHASE_STEP(4) PHASE_STEP(5)
  PHASE_STEP(6) PHASE_STEP(7) PHASE_STEP(8) PHASE_STEP(9) PHASE_STEP(10) PHASE_STEP(11)
#undef PHASE_STEP
}

extern "C" void kernel_launch(void* const* d_in, const int* in_sizes, int n_in, void* d_out, int out_size, void* d_ws,
                              size_t ws_size, hipStream_t stream) {
  static int grid_blocks = 0;
  if (!grid_blocks) {
    hipFuncSetAttribute((const void*)k_main, hipFuncAttributeMaxDynamicSharedMemorySize, SMEM_BYTES);
    int dev = 0, cus = 0, per_cu = 0;
    hipGetDevice(&dev);
    hipDeviceGetAttribute(&cus, hipDeviceAttributeMultiprocessorCount, dev);
    hipOccupancyMaxActiveBlocksPerMultiprocessor(&per_cu, k_main, 512, SMEM_BYTES);
    if (per_cu > 1) per_cu = 1;
    if (per_cu < 1) per_cu = 1;
    grid_blocks = cus * per_cu;
  }
  Params p{};
  const float** f = reinterpret_cast<const float**>(&p);
  for (int i = 0; i < 23; ++i) f[i] = reinterpret_cast<const float*>(d_in[i]);
  p.out = reinterpret_cast<float*>(d_out);
  p.ws = reinterpret_cast<char*>(d_ws);
  if (ws_size < WS_NEED) fprintf(stderr, "workspace too small: %zu < %zu\n", ws_size, (size_t)WS_NEED);
  hipMemsetAsync(p.ws + BAR_OFF, 0, 16384, stream);
#if MULTI_LAUNCH
  for (int ph = 0; ph < NPHASE; ++ph) {
    hipLaunchKernelGGL(k_main, dim3(grid_blocks), dim3(512), SMEM_BYTES, stream, p, ph, ph + 1);
  }
#else
  int ph0 = 0, ph1 = NPHASE;
  void* args[] = {&p, &ph0, &ph1};
  hipError_t e = hipLaunchCooperativeKernel((void*)k_main, dim3(grid_blocks), dim3(512), args, SMEM_BYTES, stream);
  if (e != hipSuccess) fprintf(stderr, "cooperative launch failed: %s (grid %d)\n", hipGetErrorString(e), grid_blocks);
#endif
}
```

```cpp
#include <hip/hip_runtime.h>
#include <hip/hip_cooperative_groups.h>
#include <cstdio>
#include <cstdint>
namespace cg = cooperative_groups;

#ifndef MULTI_LAUNCH
#define MULTI_LAUNCH 0
#endif

typedef unsigned short u16;
typedef __attribute__((ext_vector_type(8))) short bf16x8;
typedef __attribute__((ext_vector_type(4))) float f32x4;

constexpr int TP = 16384, TS = 512, TT = TP + TS;
constexpr int DM = 1024, NIN = 6152, DFF = 2816;
constexpr float EPS = 1e-6f;
constexpr int NTHR = 256;
#define VTID (threadIdx.x & 255)
constexpr int SMEM_HALF = 77824;
constexpr int SMEM_BYTES = 2 * SMEM_HALF + 16;

constexpr size_t O_YP = 0;
constexpr size_t O_YS = O_YP + (size_t)TP * DM;
constexpr size_t O_CONVP = O_YS + (size_t)TS * DM;
constexpr size_t O_DELTAP = O_CONVP + 8 * 3 * 1536;
constexpr size_t O_HGRNP = O_DELTAP + 8 * 4 * 128 * 128;
constexpr size_t O_FFNP = O_HGRNP + 8 * 4 * 128 * 128;
constexpr size_t O_CONVS = O_FFNP + 8 * 2 * DFF;
constexpr size_t O_DELTAS = O_CONVS + 128 * 3 * 1536;
constexpr size_t O_HGRNS = O_DELTAS + (size_t)128 * 4 * 128 * 128;
constexpr size_t O_FFNS = O_HGRNS + (size_t)128 * 4 * 128 * 128;

constexpr size_t al(size_t x) { return (x + 255) & ~(size_t)255; }
constexpr size_t W_MAIN = 0;
constexpr size_t W_G2 = W_MAIN + (size_t)3072 * 1024 * 2;
constexpr size_t W_A = W_G2 + (size_t)3072 * 1024 * 2;
constexpr size_t W_B = W_A + (size_t)1024 * 512 * 2;
constexpr size_t W_OUT = W_B + (size_t)1024 * 512 * 2;
constexpr size_t SM_GDEC = W_OUT + (size_t)1024 * 1024 * 2;
constexpr size_t SM_BETA = al(SM_GDEC + (size_t)TT * 16);
constexpr size_t SM_ROWSS = al(SM_BETA + (size_t)TT * 16);
constexpr size_t Z1 = al(SM_ROWSS + (size_t)TT * 4);
constexpr size_t Z1_SIZE = (size_t)TT * 3072 * 2;
constexpr size_t RB = al(Z1 + Z1_SIZE);
constexpr size_t D_QF = RB;
constexpr size_t D_KCD = D_QF + (size_t)1024 * 16384;
constexpr size_t D_KNT = D_KCD + (size_t)1024 * 16384;
constexpr size_t D_VALT = D_KNT + (size_t)1024 * 16384;
constexpr size_t D_ATT = D_VALT + (size_t)1024 * 16384;
constexpr size_t D_GC = D_ATT + (size_t)1024 * 8192;
constexpr size_t H_QG = D_GC + (size_t)1024 * 256;
constexpr size_t H_KGT = H_QG + (size_t)2048 * 8192;
constexpr size_t H_VT = H_KGT + (size_t)2048 * 8192;
constexpr size_t H_ATT = H_VT + (size_t)2048 * 8192;
constexpr size_t H_EBL = H_ATT + (size_t)2048 * 2048;
constexpr size_t RB_END1 = H_EBL + (size_t)2048 * 512;
constexpr size_t Z2 = RB;
constexpr size_t X1B = RB;
constexpr size_t ACT = RB + (size_t)TT * 1024 * 2;
constexpr size_t RB_END2 = ACT + (size_t)TT * DFF * 2;
constexpr size_t WS_NEED = (RB_END1 > RB_END2 ? RB_END1 : RB_END2);
constexpr size_t BAR_OFF = al(WS_NEED);
constexpr size_t Z2S = BAR_OFF + 16384;
static_assert(Z2S + (size_t)TS * 3072 * 2 <= (size_t)268435456, "workspace too large");
constexpr size_t W_GU = Z1;
constexpr size_t W_DOWN = W_GU + (size_t)5632 * 1024 * 2;
constexpr size_t MIX = W_DOWN + (size_t)1024 * DFF * 2;
constexpr size_t HALO_G = MIX + (size_t)TT * 1024 * 2;
constexpr size_t HEAD_G = HALO_G + (size_t)264 * 2 * DFF * 4;
constexpr size_t HEAD_U = HEAD_G + (size_t)264 * 2 * DFF * 4;
constexpr size_t PART = HEAD_U + (size_t)264 * 2 * DFF * 4;
static_assert(PART + (size_t)11 * TS * 1024 * 4 <= Z1 + Z1_SIZE, "z1 reuse overflow");
constexpr size_t YB_H = 0;
constexpr size_t YB_OA = (size_t)TT * 1024 * 2;
constexpr size_t YB_OB = YB_OA + (size_t)TT * 512 * 2;

struct Params {
  const float *x_prompt, *x_sample, *cache_conv, *state_delta, *state_hgrn, *cache_ffn;
  const float *g_attn, *w_in, *w_conv_a, *a_log, *dt_bias, *g_out_a, *w_branch_a, *lb_logits, *g_out_b,
      *w_branch_b, *w_out, *g_ffn, *w_ffn_gate, *w_ffn_up, *w_ffn_conv, *w_ffn_down, *g_final;
  float* out;
  char* ws;
};

__device__ __forceinline__ const unsigned short* z2row(const Params& p, int row) {
  return row < TP ? reinterpret_cast<const unsigned short*>(p.ws + Z2) + (size_t)row * 3072
                  : reinterpret_cast<const unsigned short*>(p.ws + Z2S) + (size_t)(row - TP) * 3072;
}
typedef __bf16 bf16x2_t __attribute__((ext_vector_type(2)));
typedef float f32x2_t __attribute__((ext_vector_type(2)));
__device__ __forceinline__ unsigned pack2(float a, float b) {
  f32x2_t v = {a, b};
  bf16x2_t r = __builtin_convertvector(v, bf16x2_t);
  return __builtin_bit_cast(unsigned, r);
}
__device__ __forceinline__ u16 f2bf(float f) { return (u16)(pack2(f, 0.f) & 0xffffu); }
__device__ __forceinline__ float bf2f(u16 h) { return __uint_as_float(((unsigned)h) << 16); }
__device__ __forceinline__ float lo2f(unsigned u) { return __uint_as_float(u << 16); }
__device__ __forceinline__ float hi2f(unsigned u) { return __uint_as_float(u & 0xffff0000u); }
__device__ __forceinline__ float silu_f(float x) { return x * __builtin_amdgcn_rcpf(1.f + __expf(-x)); }
__device__ __forceinline__ float sigmoid_f(float x) { return __builtin_amdgcn_rcpf(1.f + __expf(-x)); }
__device__ __forceinline__ float wave_sum(float v) {
#pragma unroll
  for (int o = 32; o >= 1; o >>= 1) v += __shfl_xor(v, o, 64);
  return v;
}
__device__ __forceinline__ void lds_barrier() {
  __builtin_amdgcn_fence(__ATOMIC_RELEASE, "workgroup", "local");
  __builtin_amdgcn_s_barrier();
  __builtin_amdgcn_fence(__ATOMIC_ACQUIRE, "workgroup", "local");
}
__device__ __forceinline__ f32x4 mfma16(bf16x8 a, bf16x8 b, f32x4 c) {
  return __builtin_amdgcn_mfma_f32_16x16x32_bf16(a, b, c, 0, 0, 0);
}
__device__ __forceinline__ bf16x8 lds_frag(const u16* base, int ld, int row0, int k0, int lane) {
  return *reinterpret_cast<const bf16x8*>(base + (row0 + (lane & 15)) * ld + k0 + 8 * (lane >> 4));
}
__device__ __forceinline__ void store_frags(const u16* lds, int ld, int R, int K, u16* dst, int t, int nt) {
  const int nkb = K >> 5, total = (R >> 4) * nkb * 64;
  for (int idx = t; idx < total; idx += nt) {
    int f = idx >> 6, pl = idx & 63, rb = f / nkb, kb = f - rb * nkb;
    uint4 v = *reinterpret_cast<const uint4*>(lds + (rb * 16 + (pl & 15)) * ld + kb * 32 + 8 * (pl >> 4));
    *reinterpret_cast<uint4*>(dst + (size_t)idx * 8) = v;
  }
}
__device__ __forceinline__ void store_frags_T(const u16* lds, int ld, int R2, int K2, u16* dst, int t, int nt) {
  const int nkb = K2 >> 5, total = (R2 >> 4) * nkb * 64;
  for (int idx = t; idx < total; idx += nt) {
    int f = idx >> 6, pl = idx & 63, rb = f / nkb, kb = f - rb * nkb;
    int d = rb * 16 + (pl & 15), c0 = kb * 32 + 8 * (pl >> 4);
    unsigned r[4];
#pragma unroll
    for (int j = 0; j < 4; ++j) {
      unsigned a = lds[(c0 + 2 * j) * ld + d], b = lds[(c0 + 2 * j + 1) * ld + d];
      r[j] = a | (b << 16);
    }
    *reinterpret_cast<uint4*>(dst + (size_t)idx * 8) = make_uint4(r[0], r[1], r[2], r[3]);
  }
}

#define XB_TMO 128
#define XB_XCNT(j) (256 + 64 * (j))
#define XB_XSUB(j) (1280 + 64 * (j))
#define XB_XGEN(j) (2304 + 64 * (j))
#define XB_TOP 3328
#define XB_TOPGEN 3392
#define XCD_BAR_WORDS 3456
#define XB_SPIN_CAP (1u << 18)
#define LAS __attribute__((address_space(3)))
__device__ __forceinline__ unsigned xb_ld(unsigned* p) { return __hip_atomic_load(p, __ATOMIC_RELAXED, __HIP_MEMORY_SCOPE_AGENT); }
__device__ __forceinline__ unsigned xb_add(unsigned* p, unsigned v) { return __hip_atomic_fetch_add(p, v, __ATOMIC_RELAXED, __HIP_MEMORY_SCOPE_AGENT); }
__device__ __forceinline__ unsigned xb_xcc_id() { return (unsigned)__builtin_amdgcn_s_getreg((3 << 11) | 20) & 0xFu; }
#define XB_SPIN(cond, bar) do { unsigned _sp = 0; while (cond) { __builtin_amdgcn_s_sleep(1); \
    if ((++_sp & 255u) == 0u) { if (xb_ld(&(bar)[XB_TMO])) break; if (_sp > XB_SPIN_CAP) { atomicAdd(&(bar)[XB_TMO], 1u); break; } } } } while (0)
struct XcdBarrier { unsigned* bar; unsigned x; volatile LAS unsigned* st; };
__device__ __forceinline__ XcdBarrier xcd_barrier_post(unsigned* bar, volatile LAS unsigned* st) {
  XcdBarrier b; b.bar = bar; b.x = xb_xcc_id(); b.st = st;
  if (threadIdx.x == 0) (void)xb_add(&bar[XB_XCNT(b.x)], 1u);
  return b;
}
__device__ __forceinline__ void xcd_barrier_complete(unsigned* bar, unsigned x, unsigned& nloc, unsigned& nx) {
  const unsigned G = gridDim.x * gridDim.y * gridDim.z;
  unsigned sum, cnt, mine, sp = 0u;
  for (;;) {
    sum = 0u; cnt = 0u; mine = 0u;
#pragma unroll
    for (unsigned j = 0; j < 16; ++j) { const unsigned c = xb_ld(&bar[XB_XCNT(j)]); sum += c; cnt += (c > 0u) ? 1u : 0u; mine = (j == x) ? c : mine; }
    if (sum == G) break;
    __builtin_amdgcn_s_sleep(1);
    if ((++sp & 255u) == 0u) { if (xb_ld(&bar[XB_TMO])) break; if (sp > XB_SPIN_CAP) { atomicAdd(&bar[XB_TMO], 1u); break; } }
  }
  nloc = mine > 0u ? mine : 1u; nx = cnt > 0u ? cnt : 1u;
}
__device__ __forceinline__ void xcd_barrier(const XcdBarrier& b) {
  asm volatile("s_waitcnt vmcnt(0)" ::: "memory");
  __syncthreads();
  if (threadIdx.x == 0) {
    unsigned* bar = b.bar;
    __builtin_amdgcn_s_waitcnt(0);
    unsigned nloc = b.st[0], nx = b.st[1];
    if (nloc == 0u) { xcd_barrier_complete(bar, b.x, nloc, nx); b.st[0] = nloc; b.st[1] = nx; }
    const unsigned old = xb_add(&bar[XB_XSUB(b.x)], 1u);
    const unsigned gen = old / nloc;
    if (old + 1u == (gen + 1u) * nloc) {
      __builtin_amdgcn_fence(__ATOMIC_RELEASE, "agent");
      asm volatile("s_waitcnt vmcnt(0)" ::: "memory");
      const unsigned og = xb_add(&bar[XB_TOP], 1u);
      const unsigned tg = og / nx;
      if (og + 1u == (tg + 1u) * nx) xb_add(&bar[XB_TOPGEN], 1u);
      else XB_SPIN(xb_ld(&bar[XB_TOPGEN]) == tg, bar);
      __builtin_amdgcn_fence(__ATOMIC_ACQUIRE, "agent");
      xb_add(&bar[XB_XGEN(b.x)], 1u);
      asm volatile("s_waitcnt vmcnt(0)" ::: "memory");
    } else {
      XB_SPIN(xb_ld(&bar[XB_XGEN(b.x)]) == gen, bar);
      __builtin_amdgcn_fence(__ATOMIC_ACQUIRE, "agent");
      asm volatile("s_waitcnt vmcnt(0)" ::: "memory");
    }
  }
  __syncthreads();
}

__device__ __forceinline__ void wt_block(const float* __restrict__ src, int ld, int K, u16* __restrict__ dst, const float* __restrict__ kscale,
                         float* lds) {
  const int t = VTID;
  for (int k0 = 0; k0 < K; k0 += 64) {
    {
      int n = t & 31, kk = t >> 5;
#pragma unroll
      for (int i = 0; i < 8; ++i) {
        int k = kk + 8 * i;
        float v = src[(size_t)(k0 + k) * ld + n];
        if (kscale) v *= kscale[k0 + k];
        lds[k * 33 + n] = v;
      }
    }
    __syncthreads();
    {
      int kp = t & 31, nn = t >> 5;
#pragma unroll
      for (int i = 0; i < 4; ++i) {
        int n = nn + 8 * i;
        unsigned v = pack2(lds[(2 * kp) * 33 + n], lds[(2 * kp + 1) * 33 + n]);
        *reinterpret_cast<unsigned*>(dst + (size_t)n * K + k0 + 2 * kp) = v;
      }
    }
    __syncthreads();
  }
}

__device__ __forceinline__ void wt_chunk(const float* __restrict__ src, int ld, int K, u16* __restrict__ dst, const float* __restrict__ kscale, float* lds, int k0) {
  const int t = VTID;
  {
    const int n = t & 31, kk = t >> 5;
    float v[32];
#pragma unroll
    for (int i = 0; i < 32; ++i) v[i] = src[(size_t)(k0 + kk + 8 * i) * ld + n];
    if (kscale) {
#pragma unroll
      for (int i = 0; i < 32; ++i) v[i] *= kscale[k0 + kk + 8 * i];
    }
#pragma unroll
    for (int i = 0; i < 32; ++i) lds[(kk + 8 * i) * 33 + n] = v[i];
  }
  __syncthreads();
  {
    const int kp = t & 127, nn = t >> 7;
#pragma unroll
    for (int i = 0; i < 16; ++i) {
      const int n = nn + 2 * i;
      *reinterpret_cast<unsigned*>(dst + (size_t)n * K + k0 + 2 * kp) = pack2(lds[(2 * kp) * 33 + n], lds[(2 * kp + 1) * 33 + n]);
    }
  }
  __syncthreads();
}

__device__ __forceinline__ void phase_prep(const Params& p, char* smem, int bid, int nb) {
  float* wab = reinterpret_cast<float*>(smem);
  float* tl = reinterpret_cast<float*>(smem + 32768);
  const int t = VTID, lane = t & 63, w = t >> 6;
  for (int i = t; i < 8192; i += NTHR) wab[i] = p.w_in[(size_t)(i >> 3) * NIN + 1536 + (i & 7)];
  for (int i = bid * NTHR + t; i < TT; i += nb * NTHR) reinterpret_cast<float*>(p.ws + SM_ROWSS)[i] = 0.f;
  __syncthreads();
  const int NWT = 384 + 384 + 64 + 64 + 128;
  const int NROW = TT / 4;
  for (int item = bid; item < NWT + NROW; item += nb) {
    if (item < NWT) {
      if (item < 384) {
        int n = (item >> 2) * 32, k0 = (item & 3) * 256;
        int col = n < 1536 ? n : 2056 + (n - 1536);
        wt_chunk(p.w_in + col, NIN, 1024, reinterpret_cast<u16*>(p.ws + W_MAIN) + (size_t)n * 1024, nullptr, tl, k0);
      } else if (item < 768) {
        int n = ((item - 384) >> 2) * 32, k0 = (item & 3) * 256;
        int col = n < 2048 ? 4104 + n : (n < 2560 ? 1544 + (n - 2048) : 3592 + (n - 2560));
        wt_chunk(p.w_in + col, NIN, 1024, reinterpret_cast<u16*>(p.ws + W_G2) + (size_t)n * 1024, nullptr, tl, k0);
      } else if (item < 832) {
        int n = ((item - 768) >> 1) * 32, k0 = (item & 1) * 256;
        wt_chunk(p.w_branch_a + n, 1024, 512, reinterpret_cast<u16*>(p.ws + W_A) + (size_t)n * 512, nullptr, tl, k0);
      } else if (item < 896) {
        int n = ((item - 832) >> 1) * 32, k0 = (item & 1) * 256;
        wt_chunk(p.w_branch_b + n, 1024, 512, reinterpret_cast<u16*>(p.ws + W_B) + (size_t)n * 512, nullptr, tl, k0);
      } else {
        int n = ((item - 896) >> 2) * 32, k0 = (item & 3) * 256;
        wt_chunk(p.w_out + n, 1024, 1024, reinterpret_cast<u16*>(p.ws + W_OUT) + (size_t)n * 1024, nullptr, tl, k0);
      }
    } else {
      int row = (item - NWT) * 4 + w;
      const float* x = row < TP ? p.x_prompt + (size_t)row * DM : p.x_sample + (size_t)(row - TP) * DM;
      float4 xv[4];
      float ss = 0.f;
#pragma unroll
      for (int i = 0; i < 4; ++i) {
        xv[i] = *reinterpret_cast<const float4*>(x + i * 256 + lane * 4);
        ss += xv[i].x * xv[i].x + xv[i].y * xv[i].y + xv[i].z * xv[i].z + xv[i].w * xv[i].w;
      }
      ss = wave_sum(ss);
      float rstd = rsqrtf(ss * (1.f / DM) + EPS);
      float dot[8];
#pragma unroll
      for (int c = 0; c < 8; ++c) dot[c] = 0.f;
      u16* hrow = reinterpret_cast<u16*>(reinterpret_cast<char*>(p.out) + YB_H) + (size_t)row * DM;
#pragma unroll
      for (int i = 0; i < 4; ++i) {
        int k = i * 256 + lane * 4;
        float4 g = *reinterpret_cast<const float4*>(p.g_attn + k);
        float h0 = xv[i].x * rstd * g.x, h1 = xv[i].y * rstd * g.y, h2 = xv[i].z * rstd * g.z, h3 = xv[i].w * rstd * g.w;
        *reinterpret_cast<uint2*>(hrow + k) = make_uint2(pack2(h0, h1), pack2(h2, h3));
        float hh[4] = {h0, h1, h2, h3};
#pragma unroll
        for (int j = 0; j < 4; ++j) {
          float4 wa = *reinterpret_cast<const float4*>(wab + (k + j) * 8);
          float4 wb = *reinterpret_cast<const float4*>(wab + (k + j) * 8 + 4);
          dot[0] += hh[j] * wa.x; dot[1] += hh[j] * wa.y; dot[2] += hh[j] * wa.z; dot[3] += hh[j] * wa.w;
          dot[4] += hh[j] * wb.x; dot[5] += hh[j] * wb.y; dot[6] += hh[j] * wb.z; dot[7] += hh[j] * wb.w;
        }
      }
#pragma unroll
      for (int c = 0; c < 8; ++c) dot[c] = wave_sum(dot[c]);
      if (lane < 4) {
        float aa = lane == 0 ? dot[0] : lane == 1 ? dot[1] : lane == 2 ? dot[2] : dot[3];
        float xx = aa + p.dt_bias[lane];
        float sp = xx > 20.f ? xx : log1pf(__expf(xx));
        reinterpret_cast<float*>(p.ws + SM_GDEC)[(size_t)row * 4 + lane] = -__expf(p.a_log[lane]) * sp;
      } else if (lane < 8) {
        float ba = lane == 4 ? dot[4] : lane == 5 ? dot[5] : lane == 6 ? dot[6] : dot[7];
        reinterpret_cast<float*>(p.ws + SM_BETA)[(size_t)row * 4 + lane - 4] = sigmoid_f(ba);
      }
    }
  }
}

enum { EPI_Z1 = 0, EPI_Z2 = 1, EPI_MIXA = 2, EPI_MIXB = 3, EPI_WOUT = 4, EPI_FFN1 = 5, EPI_FFN2 = 6, EPI_FFN2S = 7, EPI_FFN1S = 8 };
namespace pg8 {
constexpr int BM = 256, BK = 64, HALF = 128, HTB = HALF * BK * 2, STAGE_BYTES = 8 * HTB, NXCD = 8, WGM = 8;
__device__ __forceinline__ int lds_byte(int r, int c) { const int st = (r >> 4) * 2 + (c >> 5), rr = r & 15, cc = c & 31, ob = rr * 64 + cc * 2; return st * 1024 + (ob ^ (((ob >> 9) & 1) << 5)); }
__device__ __forceinline__ void stage_rc(int b, int& R, int& C) { const int st = b / 1024, sb = b % 1024, swz = sb ^ (((sb >> 9) & 1) << 5); R = (st >> 1) * 16 + swz / 64; C = (st & 1) * 32 + (swz % 64) / 2; }
__device__ __forceinline__ int perm32(int rho) { const int n = rho >> 4, i = rho & 15; return 8 * (i >> 2) + 4 * n + (i & 3); }
struct Unit { int pm, pn, ks; };
struct StaticOrder {
  int nM, nN, nwg, G, c;
  __device__ void init(int M, int N, int G_, int c_) { nM = M / BM; nN = N / BM; nwg = nM * nN; G = G_; c = c_; }
  __device__ bool next(int i, Unit& u) const {
    const long L = (long)i * G + c; if (L >= nwg) return false;
    int wgid = (int)L; { const int q = nwg / NXCD, r = nwg % NXCD, xcd = wgid % NXCD, off = wgid / NXCD; wgid = (xcd < r ? xcd * (q + 1) : r * (q + 1) + (xcd - r) * q) + off; }
    const int nig = WGM * nN, gid = wgid / nig, fm = gid * WGM, gsz = (nM - fm) < WGM ? (nM - fm) : WGM;
    u.pm = fm + ((wgid % nig) % gsz); u.pn = (wgid % nig) / gsz; return true;
  }
};
struct SchedStatic {
  StaticOrder S; int pm0;
  __device__ void init(int M, int N, int G, int c, int pm0_) { S.init(M, N, G, c); pm0 = pm0_; }
  __device__ bool next(int i, Unit& u) const { if (S.c >= S.G || !S.next(i, u)) return false; u.pm += pm0; u.ks = 0; return true; }
};
struct SchedSplit {
  int nN, nS, pm0, G, c, total;
  __device__ void init(int nM, int nN_, int nS_, int G_, int c_, int pm0_) { nN = nN_; nS = nS_; pm0 = pm0_; G = G_; c = c_; total = nM * nN_ * nS_; }
  __device__ bool next(int i, Unit& u) const {
    const int L = i * G + c; if (c >= G || L >= total) return false;
    u.ks = L % nS; const int t = L / nS; u.pn = t % nN; u.pm = pm0 + t / nN; return true;
  }
};
}

__device__ __forceinline__ float dpp_ror1(float v) { return __int_as_float(__builtin_amdgcn_update_dpp(0, __float_as_int(v), 0x121, 0xf, 0xf, false)); }
__device__ __forceinline__ float dpp_ror2(float v) { return __int_as_float(__builtin_amdgcn_update_dpp(0, __float_as_int(v), 0x122, 0xf, 0xf, false)); }

template <int MODE>
__device__ __forceinline__ void gemm_epilogue(const Params& p, f32x4 (&acc)[2][2][4][2], const pg8::Unit& u, int wr, int wc, int fr, int fq) {
  const int row0 = u.pm * 256 + wr * 64 + fr, col0 = u.pn * 256 + wc * 32 + 8 * fq;
  if constexpr (MODE == EPI_Z1 || MODE == EPI_Z2) {
#pragma unroll
    for (int ai = 0; ai < 2; ++ai)
#pragma unroll
      for (int m = 0; m < 4; ++m) {
        const int row = row0 + ai * 128 + m * 16;
        u16* rowp = (MODE == EPI_Z1 ? reinterpret_cast<u16*>(p.ws + Z1) + (size_t)row * 3072 : const_cast<u16*>(z2row(p, row))) + col0;
#pragma unroll
        for (int bj = 0; bj < 2; ++bj) {
          const f32x4 v0 = acc[ai][bj][m][0], v1 = acc[ai][bj][m][1];
          *reinterpret_cast<uint4*>(rowp + bj * 128) = make_uint4(pack2(v0[0], v0[1]), pack2(v0[2], v0[3]), pack2(v1[0], v1[1]), pack2(v1[2], v1[3]));
        }
        if (MODE == EPI_Z1 && u.pn < 6) {
          float* dst = nullptr;
          if (row < TP) {
            int pos = row & 2047;
            if (pos >= 2045) dst = p.out + O_CONVP + (size_t)((row >> 11) * 3 + pos - 2045) * 1536 + col0;
          } else {
            int pos = (row - TP) & 3;
            if (pos >= 1) dst = p.out + O_CONVS + (size_t)(((row - TP) >> 2) * 3 + pos - 1) * 1536 + col0;
          }
          if (dst) {
#pragma unroll
            for (int bj = 0; bj < 2; ++bj) {
              const f32x4 v0 = acc[ai][bj][m][0], v1 = acc[ai][bj][m][1];
              *reinterpret_cast<float4*>(dst + bj * 128) = make_float4(v0[0], v0[1], v0[2], v0[3]);
              *reinterpret_cast<float4*>(dst + bj * 128 + 4) = make_float4(v1[0], v1[1], v1[2], v1[3]);
            }
          }
        }
      }
  } else if constexpr (MODE == EPI_MIXA || MODE == EPI_MIXB) {
    u16* Mx = reinterpret_cast<u16*>(p.ws + MIX);
#pragma unroll
    for (int ai = 0; ai < 2; ++ai)
#pragma unroll
      for (int m = 0; m < 4; ++m) {
        const int row = row0 + ai * 128 + m * 16;
#pragma unroll
        for (int bj = 0; bj < 2; ++bj) {
          const int col = col0 + bj * 128;
          const uint4 gv = *reinterpret_cast<const uint4*>(z2row(p, row) + (MODE == EPI_MIXB ? 1024 : 0) + col);
          u16* mp = Mx + (size_t)row * 1024 + col;
          const f32x4 v0 = acc[ai][bj][m][0], v1 = acc[ai][bj][m][1];
          float r0 = v0[0] * sigmoid_f(lo2f(gv.x)), r1 = v0[1] * sigmoid_f(hi2f(gv.x));
          float r2 = v0[2] * sigmoid_f(lo2f(gv.y)), r3 = v0[3] * sigmoid_f(hi2f(gv.y));
          float r4 = v1[0] * sigmoid_f(lo2f(gv.z)), r5 = v1[1] * sigmoid_f(hi2f(gv.z));
          float r6 = v1[2] * sigmoid_f(lo2f(gv.w)), r7 = v1[3] * sigmoid_f(hi2f(gv.w));
          if (MODE == EPI_MIXB) {
            const uint4 mv = *reinterpret_cast<const uint4*>(mp);
            r0 += lo2f(mv.x); r1 += hi2f(mv.x); r2 += lo2f(mv.y); r3 += hi2f(mv.y);
            r4 += lo2f(mv.z); r5 += hi2f(mv.z); r6 += lo2f(mv.w); r7 += hi2f(mv.w);
          }
          *reinterpret_cast<uint4*>(mp) = make_uint4(pack2(r0, r1), pack2(r2, r3), pack2(r4, r5), pack2(r6, r7));
        }
        asm volatile("" ::: "memory");
      }
  } else if constexpr (MODE == EPI_WOUT) {
    float* rowss = reinterpret_cast<float*>(p.ws + SM_ROWSS);
    u16* XB = reinterpret_cast<u16*>(p.ws + X1B);
#pragma unroll
    for (int ai = 0; ai < 2; ++ai)
#pragma unroll
      for (int m = 0; m < 4; ++m) {
        const int row = row0 + ai * 128 + m * 16;
        const float* x = (row < TP ? p.x_prompt + (size_t)row * DM : p.x_sample + (size_t)(row - TP) * DM) + col0;
        float* y = p.out + O_YP + (size_t)row * DM + col0;
        float ss = 0.f;
#pragma unroll
        for (int bj = 0; bj < 2; ++bj) {
          const float4 x0 = *reinterpret_cast<const float4*>(x + bj * 128), x1 = *reinterpret_cast<const float4*>(x + bj * 128 + 4);
          const f32x4 a0 = acc[ai][bj][m][0], a1 = acc[ai][bj][m][1];
          const float4 v0 = make_float4(a0[0] + x0.x, a0[1] + x0.y, a0[2] + x0.z, a0[3] + x0.w);
          const float4 v1 = make_float4(a1[0] + x1.x, a1[1] + x1.y, a1[2] + x1.z, a1[3] + x1.w);
          *reinterpret_cast<float4*>(y + bj * 128) = v0;
          *reinterpret_cast<float4*>(y + bj * 128 + 4) = v1;
          *reinterpret_cast<uint4*>(XB + (size_t)row * DM + col0 + bj * 128) =
              make_uint4(pack2(v0.x, v0.y), pack2(v0.z, v0.w), pack2(v1.x, v1.y), pack2(v1.z, v1.w));
          ss += v0.x * v0.x + v0.y * v0.y + v0.z * v0.z + v0.w * v0.w + v1.x * v1.x + v1.y * v1.y + v1.z * v1.z + v1.w * v1.w;
        }
        ss += __shfl_xor(ss, 16, 64);
        ss += __shfl_xor(ss, 32, 64);
        if (fq == 0) atomicAdd(rowss + row, ss);
        asm volatile("" ::: "memory");
      }
  } else if constexpr (MODE == EPI_FFN2) {
#pragma unroll
    for (int ai = 0; ai < 2; ++ai)
#pragma unroll
      for (int m = 0; m < 4; ++m) {
        float* y = p.out + O_YP + (size_t)(row0 + ai * 128 + m * 16) * DM + col0;
#pragma unroll
        for (int bj = 0; bj < 2; ++bj) {
          float4 y0 = *reinterpret_cast<const float4*>(y + bj * 128), y1 = *reinterpret_cast<const float4*>(y + bj * 128 + 4);
          const f32x4 a0 = acc[ai][bj][m][0], a1 = acc[ai][bj][m][1];
          y0.x += a0[0]; y0.y += a0[1]; y0.z += a0[2]; y0.w += a0[3];
          y1.x += a1[0]; y1.y += a1[1]; y1.z += a1[2]; y1.w += a1[3];
          *reinterpret_cast<float4*>(y + bj * 128) = y0;
          *reinterpret_cast<float4*>(y + bj * 128 + 4) = y1;
        }
        asm volatile("" ::: "memory");
      }
  } else if constexpr (MODE == EPI_FFN2S) {
    float* part = reinterpret_cast<float*>(p.ws + PART) + (size_t)u.ks * TS * 1024;
#pragma unroll
    for (int ai = 0; ai < 2; ++ai)
#pragma unroll
      for (int m = 0; m < 4; ++m) {
        float* y = part + (size_t)(row0 + ai * 128 + m * 16 - TP) * 1024 + col0;
#pragma unroll
        for (int bj = 0; bj < 2; ++bj) {
          const f32x4 a0 = acc[ai][bj][m][0], a1 = acc[ai][bj][m][1];
          *reinterpret_cast<float4*>(y + bj * 128) = make_float4(a0[0], a0[1], a0[2], a0[3]);
          *reinterpret_cast<float4*>(y + bj * 128 + 4) = make_float4(a1[0], a1[1], a1[2], a1[3]);
        }
      }
  } else if constexpr (MODE == EPI_FFN1 || MODE == EPI_FFN1S) {
    const float* rowss = reinterpret_cast<const float*>(p.ws + SM_ROWSS);
    u16* ACTp = reinterpret_cast<u16*>(p.ws + ACT);
    float* haloG = reinterpret_cast<float*>(p.ws + HALO_G);
    float* headG = reinterpret_cast<float*>(p.ws + HEAD_G);
    float* headU = reinterpret_cast<float*>(p.ws + HEAD_U);
    const int ch = u.pn * 128 + wc * 32 + 8 * fq;
    float w0[8], w1[8], w2[8];
#pragma unroll
    for (int c = 0; c < 8; ++c) { w0[c] = p.w_ffn_conv[ch + c]; w1[c] = p.w_ffn_conv[DFF + ch + c]; w2[c] = p.w_ffn_conv[2 * DFF + ch + c]; }
    if constexpr (MODE == EPI_FFN1) {
#pragma unroll
      for (int ai = 0; ai < 2; ++ai) {
        const int blk = u.pm * 4 + ai * 2 + wr;
        const bool seqstart = (blk & 31) == 0, seqend = (blk & 31) == 31;
        float gprev[8];
#pragma unroll
        for (int c = 0; c < 8; ++c) gprev[c] = 0.f;
#pragma unroll
        for (int m = 0; m < 4; ++m) {
          const int row = row0 + ai * 128 + m * 16;
          const float rs = rsqrtf(rowss[row] * (1.f / DM) + EPS);
          float g0[8], uu[8];
#pragma unroll
          for (int c = 0; c < 4; ++c) {
            g0[c] = acc[ai][0][m][0][c] * rs; g0[4 + c] = acc[ai][0][m][1][c] * rs;
            uu[c] = acc[ai][1][m][0][c] * rs; uu[4 + c] = acc[ai][1][m][1][c] * rs;
          }
          float r[8];
#pragma unroll
          for (int c = 0; c < 8; ++c) {
            float gm1 = __int_as_float(__builtin_amdgcn_update_dpp(__float_as_int(dpp_ror1(gprev[c])), __float_as_int(g0[c]), 0x111, 0xf, 0xf, false));
            float gm2 = __int_as_float(__builtin_amdgcn_update_dpp(__float_as_int(dpp_ror2(gprev[c])), __float_as_int(g0[c]), 0x112, 0xf, 0xf, false));
            r[c] = silu_f(w0[c] * gm2 + w1[c] * gm1 + w2[c] * g0[c]) * uu[c];
          }
          bool defer = false;
          if (m == 0) {
            defer = !seqstart && fr < 2;
            if (defer) {
              float* dg = headG + (size_t)(blk * 2 + fr) * DFF + ch;
              float* du = headU + (size_t)(blk * 2 + fr) * DFF + ch;
              *reinterpret_cast<float4*>(dg) = make_float4(g0[0], g0[1], g0[2], g0[3]);
              *reinterpret_cast<float4*>(dg + 4) = make_float4(g0[4], g0[5], g0[6], g0[7]);
              *reinterpret_cast<float4*>(du) = make_float4(uu[0], uu[1], uu[2], uu[3]);
              *reinterpret_cast<float4*>(du + 4) = make_float4(uu[4], uu[5], uu[6], uu[7]);
            }
          }
          if (m == 3) {
            if (fr >= 14) {
              float* d = haloG + (size_t)(blk * 2 + fr - 14) * DFF + ch;
              *reinterpret_cast<float4*>(d) = make_float4(g0[0], g0[1], g0[2], g0[3]);
              *reinterpret_cast<float4*>(d + 4) = make_float4(g0[4], g0[5], g0[6], g0[7]);
              if (seqend) {
                float* o = p.out + O_FFNP + (size_t)((row >> 11) * 2 + fr - 14) * DFF + ch;
                *reinterpret_cast<float4*>(o) = make_float4(g0[0], g0[1], g0[2], g0[3]);
                *reinterpret_cast<float4*>(o + 4) = make_float4(g0[4], g0[5], g0[6], g0[7]);
              }
            }
          }
          if (!defer)
            *reinterpret_cast<uint4*>(ACTp + (size_t)row * DFF + ch) = make_uint4(pack2(r[0], r[1]), pack2(r[2], r[3]), pack2(r[4], r[5]), pack2(r[6], r[7]));
#pragma unroll
          for (int c = 0; c < 8; ++c) gprev[c] = g0[c];
          asm volatile("" ::: "memory");
        }
      }
    } else {
#pragma unroll
    for (int ai = 0; ai < 2; ++ai) {
      const int blk = u.pm * 4 + ai * 2 + wr;
      float gprev[8];
#pragma unroll
      for (int c = 0; c < 8; ++c) gprev[c] = 0.f;
#pragma unroll
      for (int m = 0; m < 4; ++m) {
        const int row = row0 + ai * 128 + m * 16;
        const int r64 = m * 16 + fr;
        const float rs = rsqrtf(rowss[row] * (1.f / DM) + EPS);
        float g0[8], uu[8];
#pragma unroll
        for (int c = 0; c < 4; ++c) {
          g0[c] = acc[ai][0][m][0][c] * rs; g0[4 + c] = acc[ai][0][m][1][c] * rs;
          uu[c] = acc[ai][1][m][0][c] * rs; uu[4 + c] = acc[ai][1][m][1][c] * rs;
        }
        const bool prompt = row < TP;
        int pos, b;
        if (prompt) { pos = row & 2047; b = row >> 11; } else { pos = (row - TP) & 3; b = (row - TP) >> 2; }
        const bool defer = (pos >= 1 && r64 < 1) || (pos >= 2 && r64 < 2);
        float gm1[8], gm2[8];
#pragma unroll
        for (int c = 0; c < 8; ++c) {
          gm1[c] = __int_as_float(__builtin_amdgcn_update_dpp(__float_as_int(dpp_ror1(gprev[c])), __float_as_int(g0[c]), 0x111, 0xf, 0xf, false));
          gm2[c] = __int_as_float(__builtin_amdgcn_update_dpp(__float_as_int(dpp_ror2(gprev[c])), __float_as_int(g0[c]), 0x112, 0xf, 0xf, false));
        }
        if (pos < 1) {
#pragma unroll
          for (int c = 0; c < 8; ++c) gm1[c] = prompt ? 0.f : p.cache_ffn[(size_t)(b * 2 + 1) * DFF + ch + c];
        }
        if (pos < 2) {
#pragma unroll
          for (int c = 0; c < 8; ++c) gm2[c] = prompt ? 0.f : p.cache_ffn[(size_t)(b * 2 + pos) * DFF + ch + c];
        }
        if (r64 >= 62) {
          float* d = haloG + (size_t)(blk * 2 + r64 - 62) * DFF + ch;
          *reinterpret_cast<float4*>(d) = make_float4(g0[0], g0[1], g0[2], g0[3]);
          *reinterpret_cast<float4*>(d + 4) = make_float4(g0[4], g0[5], g0[6], g0[7]);
        }
        {
          float* d = nullptr;
          if (prompt) { if (pos >= 2046) d = p.out + O_FFNP + (size_t)(b * 2 + pos - 2046) * DFF + ch; }
          else { if (pos >= 2) d = p.out + O_FFNS + (size_t)(b * 2 + pos - 2) * DFF + ch; }
          if (d) {
            *reinterpret_cast<float4*>(d) = make_float4(g0[0], g0[1], g0[2], g0[3]);
            *reinterpret_cast<float4*>(d + 4) = make_float4(g0[4], g0[5], g0[6], g0[7]);
          }
        }
        if (defer) {
          float* dg = headG + (size_t)(blk * 2 + r64) * DFF + ch;
          float* du = headU + (size_t)(blk * 2 + r64) * DFF + ch;
          *reinterpret_cast<float4*>(dg) = make_float4(g0[0], g0[1], g0[2], g0[3]);
          *reinterpret_cast<float4*>(dg + 4) = make_float4(g0[4], g0[5], g0[6], g0[7]);
          *reinterpret_cast<float4*>(du) = make_float4(uu[0], uu[1], uu[2], uu[3]);
          *reinterpret_cast<float4*>(du + 4) = make_float4(uu[4], uu[5], uu[6], uu[7]);
        } else {
          float r[8];
#pragma unroll
          for (int c = 0; c < 8; ++c) r[c] = silu_f(w0[c] * gm2[c] + w1[c] * gm1[c] + w2[c] * g0[c]) * uu[c];
          *reinterpret_cast<uint4*>(ACTp + (size_t)row * DFF + ch) = make_uint4(pack2(r[0], r[1]), pack2(r[2], r[3]), pack2(r[4], r[5]), pack2(r[6], r[7]));
        }
#pragma unroll
        for (int c = 0; c < 8; ++c) gprev[c] = g0[c];
        asm volatile("" ::: "memory");
      }
    }
    }
  }
}

template <int MODE, class Sched>
__device__ __forceinline__ void gemm_phase8(const Params& p, const u16* Ag, const u16* Btg, int ld, int Kunit, LAS unsigned char* lds, const Sched& S) {
  using namespace pg8;
  const int tid = threadIdx.x, wid = __builtin_amdgcn_readfirstlane(tid >> 6), lane = tid & 63, wr = wid >> 2, wc = wid & 3, fr = lane & 15, fq = lane >> 4;
  const int nt = Kunit / BK;
  unsigned voffA[2], voffB[2];
#pragma unroll
  for (int i = 0; i < 2; ++i) { int R, C; stage_rc(tid * 16 + i * 8192, R, C); const int Rb = (R & ~31) + perm32(R & 31);
    voffA[i] = (unsigned)(R * ld + C) * 2u; voffB[i] = (unsigned)(Rb * ld + C) * 2u; }
  const size_t kstep = (size_t)(BK * 2);
  const size_t hstep = (size_t)HALF * ld * 2;
  const size_t tstep = 2 * hstep;
  const size_t kub = (size_t)Kunit * 2;
  const unsigned ldsw = (unsigned)wid * 1024u;
  const int aoff = lds_byte(wr * 64 + fr, fq * 8), boff = lds_byte(wc * 32 + fr, fq * 8);
#define PG8_SA(b, h) (((b) * 2 + (h)) * HTB)
#define PG8_SB(b, h) ((4 + (b) * 2 + (h)) * HTB)
#define PG8_STAGE(bufoff, gbase, voff) do { _Pragma("unroll") for (int _i = 0; _i < 2; ++_i) \
    __builtin_amdgcn_global_load_lds((const unsigned*)((const char*)(gbase) + (voff)[_i]), (LAS unsigned*)(lds + (bufoff) + ldsw + _i * 8192), 16, 0, 0); } while (0)
#define PG8_LDA(dst, b, h) do { _Pragma("unroll") for (int m = 0; m < 4; ++m) _Pragma("unroll") for (int k = 0; k < 2; ++k) dst[m][k] = *(const LAS bf16x8*)(lds + PG8_SA(b, h) + aoff + m * 2048 + k * 1024); } while (0)
#define PG8_LDB(dst, b, h) do { _Pragma("unroll") for (int n = 0; n < 2; ++n) _Pragma("unroll") for (int k = 0; k < 2; ++k) dst[n][k] = *(const LAS bf16x8*)(lds + PG8_SB(b, h) + boff + n * 2048 + k * 1024); } while (0)
#define PG8_MMA(ai, bj, At, Bt) do { __builtin_amdgcn_s_setprio(1); _Pragma("unroll") for (int m = 0; m < 4; ++m) _Pragma("unroll") for (int n = 0; n < 2; ++n) _Pragma("unroll") for (int k = 0; k < 2; ++k) \
    acc[ai][bj][m][n] = __builtin_amdgcn_mfma_f32_16x16x32_bf16(Bt[n][k], At[m][k], acc[ai][bj][m][n], 0, 0, 0); __builtin_amdgcn_s_setprio(0); } while (0)
#define PG8_WAIT_V(n) asm volatile("s_waitcnt vmcnt(" #n ")" ::: "memory")
#define PG8_WAIT_L(n) asm volatile("s_waitcnt lgkmcnt(" #n ")" ::: "memory")
#define PG8_BAR __builtin_amdgcn_s_barrier()
#define PG8_SCHED __builtin_amdgcn_sched_barrier(0)
  Unit cur, nxt; int ui = 0;
  if (!S.next(0, cur)) return;
  f32x4 acc[2][2][4][2];
#pragma unroll
  for (int a = 0; a < 2; ++a)
#pragma unroll
    for (int b = 0; b < 2; ++b)
#pragma unroll
      for (int m = 0; m < 4; ++m)
#pragma unroll
        for (int n = 0; n < 2; ++n) acc[a][b][m][n] = (f32x4){0.f, 0.f, 0.f, 0.f};
  bf16x8 At[4][2], B0[2][2], B1[2][2];
  const char* cA = (const char*)Ag + (size_t)cur.pm * tstep + cur.ks * kub; const char* cB = (const char*)Btg + (size_t)cur.pn * tstep + cur.ks * kub;
  PG8_STAGE(PG8_SB(0, 0), cB, voffB); PG8_STAGE(PG8_SA(0, 0), cA, voffA); PG8_STAGE(PG8_SB(0, 1), cB + hstep, voffB); PG8_STAGE(PG8_SA(0, 1), cA + hstep, voffA);
  if (wr == 1) PG8_BAR;
  PG8_WAIT_V(4); PG8_BAR;
  PG8_STAGE(PG8_SB(1, 0), cB + kstep, voffB); PG8_STAGE(PG8_SA(1, 0), cA + kstep, voffA); PG8_STAGE(PG8_SB(1, 1), cB + hstep + kstep, voffB);
  PG8_WAIT_V(6); PG8_BAR;
  for (;;) {
    const bool has_next = S.next(ui + 1, nxt);
    const char* nA = has_next ? (const char*)Ag + (size_t)nxt.pm * tstep + nxt.ks * kub : cA; const char* nB = has_next ? (const char*)Btg + (size_t)nxt.pn * tstep + nxt.ks * kub : cB;
    for (int t = 0; t < nt; t += 2) {
      const bool last = (t == nt - 2);
      const char* a1 = cA + (size_t)(t + 1) * kstep;
      const char* a2 = last ? nA : cA + (size_t)(t + 2) * kstep; const char* b2 = last ? nB : cB + (size_t)(t + 2) * kstep;
      const char* a3 = a2 + kstep; const char* b3 = b2 + kstep;
      PG8_LDB(B0, 0, 0); PG8_SCHED; PG8_LDA(At, 0, 0); PG8_STAGE(PG8_SA(1, 1), a1 + hstep, voffA);
      PG8_WAIT_L(8); PG8_BAR; PG8_WAIT_L(0); PG8_MMA(0, 0, At, B0); PG8_BAR; PG8_SCHED;
      PG8_LDB(B1, 0, 1); PG8_STAGE(PG8_SB(0, 0), b2, voffB);
      PG8_BAR; PG8_WAIT_L(0); PG8_MMA(0, 1, At, B1); PG8_BAR;
      PG8_LDA(At, 0, 1); PG8_STAGE(PG8_SA(0, 0), a2, voffA);
      PG8_BAR; PG8_WAIT_L(0); PG8_MMA(1, 0, At, B0); PG8_BAR; PG8_SCHED;
      PG8_STAGE(PG8_SB(0, 1), b2 + hstep, voffB);
      PG8_WAIT_V(6); PG8_BAR; PG8_MMA(1, 1, At, B1); PG8_BAR;
      PG8_LDB(B0, 1, 0); PG8_SCHED; PG8_LDA(At, 1, 0); PG8_STAGE(PG8_SA(0, 1), a2 + hstep, voffA);
      PG8_WAIT_L(8); PG8_BAR; PG8_WAIT_L(0); PG8_MMA(0, 0, At, B0); PG8_BAR; PG8_SCHED;
      PG8_LDB(B1, 1, 1); PG8_STAGE(PG8_SB(1, 0), b3, voffB);
      PG8_BAR; PG8_WAIT_L(0); PG8_MMA(0, 1, At, B1); PG8_BAR;
      PG8_LDA(At, 1, 1); PG8_STAGE(PG8_SA(1, 0), a3, voffA);
      PG8_BAR; PG8_WAIT_L(0); PG8_MMA(1, 0, At, B0); PG8_BAR; PG8_SCHED;
      PG8_STAGE(PG8_SB(1, 1), b3 + hstep, voffB);
      PG8_WAIT_V(6); PG8_BAR; PG8_MMA(1, 1, At, B1); PG8_BAR;
    }
    gemm_epilogue<MODE>(p, acc, cur, wr, wc, fr, fq);
    if (!has_next) break;
#pragma unroll
    for (int a = 0; a < 2; ++a)
#pragma unroll
      for (int b = 0; b < 2; ++b)
#pragma unroll
        for (int m = 0; m < 4; ++m)
#pragma unroll
          for (int n = 0; n < 2; ++n) acc[a][b][m][n] = (f32x4){0.f, 0.f, 0.f, 0.f};
    cur = nxt; cA = nA; cB = nB; ++ui;
  }
  PG8_WAIT_V(0);
  if (wr == 0) PG8_BAR;
  PG8_BAR;
#undef PG8_SA
#undef PG8_SB
#undef PG8_STAGE
#undef PG8_LDA
#undef PG8_LDB
#undef PG8_MMA
#undef PG8_WAIT_V
#undef PG8_WAIT_L
#undef PG8_BAR
#undef PG8_SCHED
}


template <int PASS>
__device__ __forceinline__ void delta_rowpass(const Params& p, int t0, int n, int h, int w, int lane, float Gv, u16* RA, u16* RBk,
                                              u16* RC) {
  const u16* Zp = reinterpret_cast<const u16*>(p.ws + Z1);
  const float* betap = reinterpret_cast<const float*>(p.ws + SM_BETA);
  const int c1 = (PASS == 0 ? 0 : 512) + h * 128 + 2 * lane;
  const int c2 = (PASS == 0 ? 512 : 1024) + h * 128 + 2 * lane;
  float w1[4][2], w2[4][2];
#pragma unroll
  for (int j = 0; j < 4; ++j) {
    w1[j][0] = p.w_conv_a[j * 1536 + c1]; w1[j][1] = p.w_conv_a[j * 1536 + c1 + 1];
    w2[j][0] = p.w_conv_a[j * 1536 + c2]; w2[j][1] = p.w_conv_a[j * 1536 + c2 + 1];
  }
  const int r0 = 16 * w;
  const u16* zbase = Zp + (size_t)(t0 + r0) * 3072;
  float h1[3][2], h2[3][2];
#pragma unroll
  for (int j = 0; j < 3; ++j) {
    unsigned ua = 0u, ub = 0u;
    if (n * 64 + r0 + j - 3 >= 0) {
      ua = *reinterpret_cast<const unsigned*>(zbase + (ptrdiff_t)(j - 3) * 3072 + c1);
      ub = *reinterpret_cast<const unsigned*>(zbase + (ptrdiff_t)(j - 3) * 3072 + c2);
    }
    h1[j][0] = lo2f(ua); h1[j][1] = hi2f(ua); h2[j][0] = lo2f(ub); h2[j][1] = hi2f(ub);
  }
  unsigned qa0, qa1, qa2, qa3, qa4, qa5, qb0, qb1, qb2, qb3, qb4, qb5;
#define RLOAD(i, A_, B_) A_ = *reinterpret_cast<const unsigned*>(zbase + (size_t)(i) * 3072 + c1); B_ = *reinterpret_cast<const unsigned*>(zbase + (size_t)(i) * 3072 + c2);
  RLOAD(0, qa0, qb0) RLOAD(1, qa1, qb1) RLOAD(2, qa2, qb2) RLOAD(3, qa3, qb3) RLOAD(4, qa4, qb4) RLOAD(5, qa5, qb5)
#pragma unroll 1
  for (int rr = 0; rr < 16; ++rr) {
    const int r = r0 + rr;
    const unsigned ua = qa0, ub = qb0;
    qa0 = qa1; qa1 = qa2; qa2 = qa3; qa3 = qa4; qa4 = qa5;
    qb0 = qb1; qb1 = qb2; qb2 = qb3; qb3 = qb4; qb4 = qb5;
    if (rr + 6 < 16) { RLOAD(rr + 6, qa5, qb5) }
    const float a0 = lo2f(ua), a1 = hi2f(ua), b0 = lo2f(ub), b1 = hi2f(ub);
    float y10 = silu_f(w1[0][0] * h1[0][0] + w1[1][0] * h1[1][0] + w1[2][0] * h1[2][0] + w1[3][0] * a0);
    float y11 = silu_f(w1[0][1] * h1[0][1] + w1[1][1] * h1[1][1] + w1[2][1] * h1[2][1] + w1[3][1] * a1);
    float y20 = silu_f(w2[0][0] * h2[0][0] + w2[1][0] * h2[1][0] + w2[2][0] * h2[2][0] + w2[3][0] * b0);
    float y21 = silu_f(w2[0][1] * h2[0][1] + w2[1][1] * h2[1][1] + w2[2][1] * h2[2][1] + w2[3][1] * b1);
    const float bt = betap[(size_t)(t0 + r) * 4 + h];
    if (PASS == 0) {
      float qs = wave_sum(y10 * y10 + y11 * y11), ks = wave_sum(y20 * y20 + y21 * y21);
      float qn = rsqrtf(qs + EPS) * 0.08838834764831845f, kn = rsqrtf(ks + EPS);
      float k0 = y20 * kn, k1 = y21 * kn;
      *reinterpret_cast<unsigned*>(RA + r * 136 + 2 * lane) = pack2(k0, k1);
      *reinterpret_cast<unsigned*>(RBk + r * 136 + 2 * lane) = pack2(k0 * bt, k1 * bt);
      *reinterpret_cast<unsigned*>(RC + r * 136 + 2 * lane) = pack2(y10 * qn, y11 * qn);
    } else {
      float ks = wave_sum(y10 * y10 + y11 * y11);
      float sc = rsqrtf(ks + EPS) * bt * __expf(__shfl(Gv, r, 64));
      RA[(2 * lane) * 72 + r] = f2bf(y10 * sc);
      RA[(2 * lane + 1) * 72 + r] = f2bf(y11 * sc);
      RC[(2 * lane) * 72 + r] = f2bf(y20 * bt);
      RC[(2 * lane + 1) * 72 + r] = f2bf(y21 * bt);
    }
#pragma unroll
    for (int c = 0; c < 2; ++c) {
      h1[0][c] = h1[1][c]; h1[1][c] = h1[2][c];
      h2[0][c] = h2[1][c]; h2[1][c] = h2[2][c];
    }
    h1[2][0] = a0; h1[2][1] = a1; h2[2][0] = b0; h2[2][1] = b1;
  }
#undef RLOAD
}

__device__ __forceinline__ void m1_delta_item(const Params& p, int item, char* smem) {
  const int tid = VTID, lane = tid & 63, w = tid >> 6, lr = lane & 15, lq = lane >> 4;
  const int h = item & 3, n = (item >> 2) & 31, b = item >> 7;
  const int t0 = b * 2048 + n * 64;
  u16* RA = reinterpret_cast<u16*>(smem);
  u16* RBk = reinterpret_cast<u16*>(smem + 18432);
  u16* RC = reinterpret_cast<u16*>(smem + 36864);
  u16* RD = reinterpret_cast<u16*>(smem + 55296);
  float* Gs = reinterpret_cast<float*>(smem + 73728);
  const float* gdec = reinterpret_cast<const float*>(p.ws + SM_GDEC);

  float Gv = gdec[(size_t)(t0 + lane) * 4 + h];
#pragma unroll
  for (int o = 1; o < 64; o <<= 1) {
    float tv = __shfl_up(Gv, o, 64);
    if (lane >= o) Gv += tv;
  }
  if (w == 0) {
    Gs[lane] = Gv;
    reinterpret_cast<float*>(p.ws + D_GC)[(size_t)item * 64 + lane] = Gv;
  }
  delta_rowpass<0>(p, t0, n, h, w, lane, Gv, RA, RBk, RC);
  __syncthreads();
  {
    f32x4 accL[4], accA[4];
#pragma unroll
    for (int jb = 0; jb < 4; ++jb) { accL[jb] = (f32x4){0.f, 0.f, 0.f, 0.f}; accA[jb] = (f32x4){0.f, 0.f, 0.f, 0.f}; }
#pragma unroll
    for (int ks = 0; ks < 4; ++ks) {
      bf16x8 a1 = lds_frag(RBk, 136, 16 * w, ks * 32, lane);
      bf16x8 a2 = lds_frag(RC, 136, 16 * w, ks * 32, lane);
#pragma unroll
      for (int jb = 0; jb < 4; ++jb) {
        if (jb <= w) {
          bf16x8 bb = lds_frag(RA, 136, 16 * jb, ks * 32, lane);
          accL[jb] = mfma16(a1, bb, accL[jb]);
          accA[jb] = mfma16(a2, bb, accA[jb]);
        }
      }
    }
    __syncthreads();
    float* Lm = reinterpret_cast<float*>(RBk);
#pragma unroll
    for (int jb = 0; jb < 4; ++jb)
#pragma unroll
      for (int j = 0; j < 4; ++j) {
        int i = 16 * w + 4 * lq + j, jj = jb * 16 + lr;
        float dec = __expf(fminf(Gs[i] - Gs[jj], 0.f));
        float lv = (i > jj) ? accL[jb][j] * dec : 0.f;
        float av = (i >= jj) ? accA[jb][j] * dec : 0.f;
        Lm[i * 64 + jj] = lv;
        RD[i * 72 + jj] = f2bf(av);
      }
  }
  __syncthreads();
  store_frags(RC, 136, 64, 128, reinterpret_cast<u16*>(p.ws + D_QF) + (size_t)item * 8192, tid, NTHR);
  store_frags(RD, 72, 64, 64, reinterpret_cast<u16*>(p.ws + D_ATT) + (size_t)item * 4096, tid, NTHR);
  store_frags_T(RA, 136, 128, 64, reinterpret_cast<u16*>(p.ws + D_KNT) + (size_t)item * 8192, tid, NTHR);
  __syncthreads();
  {
    const float* Lm = reinterpret_cast<const float*>(RBk);
    float* Tm = reinterpret_cast<float*>(RA);
    float* Ms = reinterpret_cast<float*>(RC) + w * 256;
    {
      const int c = lane & 15, i0 = 16 * w;
      float tc[16];
#pragma unroll
      for (int r = 0; r < 16; ++r) {
        float a = (r == c) ? 1.f : 0.f;
#pragma unroll
        for (int k = 0; k < r; ++k) a -= Lm[(i0 + r) * 64 + i0 + k] * tc[k];
        tc[r] = a;
      }
      if (lane < 16) {
#pragma unroll
        for (int r = 0; r < 16; ++r) Tm[(i0 + r) * 64 + i0 + c] = tc[r];
      }
    }
    __syncthreads();
    {
      const int j = w;
      for (int i = j + 1; i < 4; ++i) {
        f32x4 macc = (f32x4){0.f, 0.f, 0.f, 0.f};
        for (int k = j; k < i; ++k) {
#pragma unroll
          for (int ks = 0; ks < 4; ++ks) {
            float av = Lm[(16 * i + lr) * 64 + 16 * k + 4 * ks + lq];
            float bv = Tm[(16 * k + 4 * ks + lq) * 64 + 16 * j + lr];
            macc = __builtin_amdgcn_mfma_f32_16x16x4f32(av, bv, macc, 0, 0, 0);
          }
        }
#pragma unroll
        for (int r = 0; r < 4; ++r) Ms[(4 * lq + r) * 16 + lr] = macc[r];
        __builtin_amdgcn_wave_barrier();
        f32x4 tacc = (f32x4){0.f, 0.f, 0.f, 0.f};
#pragma unroll
        for (int ks = 0; ks < 4; ++ks) {
          float av = Tm[(16 * i + lr) * 64 + 16 * i + 4 * ks + lq];
          float bv = Ms[(4 * ks + lq) * 16 + lr];
          tacc = __builtin_amdgcn_mfma_f32_16x16x4f32(av, bv, tacc, 0, 0, 0);
        }
#pragma unroll
        for (int r = 0; r < 4; ++r) Tm[(16 * i + 4 * lq + r) * 64 + 16 * j + lr] = -tacc[r];
        __builtin_amdgcn_wave_barrier();
      }
    }
    __syncthreads();
    {
      u16* Tb = RD + 64 * 72;
      for (int idx = tid; idx < 4096; idx += NTHR) {
        int r = idx >> 6, c = idx & 63;
        float v = ((c >> 4) <= (r >> 4)) ? Tm[idx] : 0.f;
        Tb[r * 72 + c] = f2bf(v);
      }
    }
    __syncthreads();
  }
  delta_rowpass<1>(p, t0, n, h, w, lane, Gv, RA, RBk, RC);
  __syncthreads();
  {
    const u16* Tm = RD + 64 * 72;
    bf16x8 tf[4][2];
#pragma unroll
    for (int cb = 0; cb < 4; ++cb)
#pragma unroll
      for (int ks = 0; ks < 2; ++ks) tf[cb][ks] = lds_frag(Tm, 72, cb * 16, ks * 32, lane);
    u16* valt = reinterpret_cast<u16*>(p.ws + D_VALT) + (size_t)item * 8192;
#pragma unroll
    for (int ee = 0; ee < 2; ++ee) {
      int eb = 2 * w + ee;
      bf16x8 a0 = lds_frag(RC, 72, eb * 16, 0, lane), a1 = lds_frag(RC, 72, eb * 16, 32, lane);
#pragma unroll
      for (int cb = 0; cb < 4; ++cb) {
        f32x4 c = (f32x4){0.f, 0.f, 0.f, 0.f};
        c = mfma16(a0, tf[cb][0], c);
        c = mfma16(a1, tf[cb][1], c);
        *reinterpret_cast<uint2*>(valt + ((size_t)(eb * 4 + cb) * 64 + lane) * 4) = make_uint2(pack2(c[0], c[1]), pack2(c[2], c[3]));
      }
    }
#pragma unroll
    for (int dd = 0; dd < 2; ++dd) {
      int db = 2 * w + dd;
      bf16x8 b0 = lds_frag(RA, 72, db * 16, 0, lane), b1 = lds_frag(RA, 72, db * 16, 32, lane);
#pragma unroll
      for (int cb = 0; cb < 4; ++cb) {
        f32x4 c = (f32x4){0.f, 0.f, 0.f, 0.f};
        c = mfma16(tf[cb][0], b0, c);
        c = mfma16(tf[cb][1], b1, c);
#pragma unroll
        for (int j = 0; j < 4; ++j) RBk[(cb * 16 + 4 * lq + j) * 136 + db * 16 + lr] = f2bf(c[j]);
      }
    }
  }
  __syncthreads();
  store_frags(RBk, 136, 64, 128, reinterpret_cast<u16*>(p.ws + D_KCD) + (size_t)item * 8192, tid, NTHR);
  __syncthreads();
}

__device__ __forceinline__ void m1_hgrn_item(const Params& p, int item, char* smem) {
  const int tid = VTID, lane = tid & 63, w = tid >> 6, lr = lane & 15, lq = lane >> 4;
  const int h = item & 3, n = (item >> 2) & 63, b = item >> 8;
  const int t0 = b * 2048 + n * 32;
  u16* QG = reinterpret_cast<u16*>(smem);
  u16* QR = reinterpret_cast<u16*>(smem + 8704);
  u16* KR = reinterpret_cast<u16*>(smem + 17408);
  u16* KGT = reinterpret_cast<u16*>(smem + 26112);
  u16* VT = reinterpret_cast<u16*>(smem + 36352);
  float* tot = reinterpret_cast<float*>(smem + 46592);
  float* bls = tot + 128;
  const u16* Zp = reinterpret_cast<const u16*>(p.ws + Z1);
  const int e = tid & 127, half = tid >> 7;
  const int he = h * 128 + e;
  const float lb = sigmoid_f(p.lb_logits[he] - p.lb_logits[512 + he]);
  float q[16], k[16], bc[16];
  float run = 0.f;
#pragma unroll
  for (int i = 0; i < 16; ++i) {
    const u16* zr = Zp + (size_t)(t0 + half * 16 + i) * 3072;
    float qb = bf2f(zr[1536 + he]), fb = bf2f(zr[2048 + he]);
    float f = lb + (1.f - lb) * sigmoid_f(fb);
    run += __logf(f);
    q[i] = silu_f(qb); k[i] = 1.f - f; bc[i] = run;
    VT[e * 40 + half * 16 + i] = zr[2560 + he];
  }
  if (half == 0) tot[e] = run;
  __syncthreads();
  const float bref = tot[e];
  if (half == 1) {
#pragma unroll
    for (int i = 0; i < 16; ++i) bc[i] += bref;
    bls[e] = bc[15];
  }
  __syncthreads();
  const float bl = bls[e];
  if (half == 0) reinterpret_cast<float*>(p.ws + H_EBL)[(size_t)item * 128 + e] = __expf(bl);
#pragma unroll
  for (int i = 0; i < 16; ++i) {
    int r = half * 16 + i;
    QG[r * 136 + e] = f2bf(q[i] * __expf(bc[i]));
    QR[r * 136 + e] = f2bf(q[i] * __expf(bc[i] - bref));
    KR[r * 136 + e] = f2bf(k[i] * __expf(bref - bc[i]));
    KGT[e * 40 + r] = f2bf(k[i] * __expf(bl - bc[i]));
  }
  __syncthreads();
  {
    const int ib = w >> 1, jb = w & 1;
    f32x4 c = (f32x4){0.f, 0.f, 0.f, 0.f};
    if (jb <= ib) {
#pragma unroll
      for (int ks = 0; ks < 4; ++ks) c = mfma16(lds_frag(QR, 136, ib * 16, ks * 32, lane), lds_frag(KR, 136, jb * 16, ks * 32, lane), c);
    }
    u16* att = reinterpret_cast<u16*>(p.ws + H_ATT) + (size_t)item * 1024;
#pragma unroll
    for (int j = 0; j < 4; ++j) {
      int i = ib * 16 + 4 * lq + j, jj = jb * 16 + lr;
      float v = (i >= jj) ? c[j] : 0.f;
      att[(ib * 64 + (i & 15) + 16 * (jj >> 3)) * 8 + (jj & 7)] = f2bf(v);
    }
  }
  store_frags(QG, 136, 32, 128, reinterpret_cast<u16*>(p.ws + H_QG) + (size_t)item * 4096, tid, NTHR);
  store_frags(KGT, 40, 128, 32, reinterpret_cast<u16*>(p.ws + H_KGT) + (size_t)item * 4096, tid, NTHR);
  store_frags(VT, 40, 128, 32, reinterpret_cast<u16*>(p.ws + H_VT) + (size_t)item * 4096, tid, NTHR);
  __syncthreads();
}

struct DPre {
  bf16x8 kcd[4], q[4], att[2], knt[2][2];
  uint2 val[2];
  float gc, gl;
  float4 gi;
};
__device__ __forceinline__ void m2d_loadA(const Params& p, int base, int es, int w, int lane, DPre& d) {
  const int lr = lane & 15, lq = lane >> 4;
  const bf16x8* kcd = reinterpret_cast<const bf16x8*>(p.ws + D_KCD + (size_t)base * 16384);
  const uint2* val = reinterpret_cast<const uint2*>(p.ws + D_VALT + (size_t)base * 16384);
  const float* gc = reinterpret_cast<const float*>(p.ws + D_GC) + (size_t)base * 64;
#pragma unroll
  for (int ks = 0; ks < 4; ++ks) d.kcd[ks] = kcd[(w * 4 + ks) * 64 + lane];
#pragma unroll
  for (int eb = 0; eb < 2; ++eb) d.val[eb] = val[((es * 2 + eb) * 4 + w) * 64 + lane];
  d.gc = gc[w * 16 + lr];
  d.gl = gc[63];
  d.gi = *reinterpret_cast<const float4*>(gc + 16 * w + 4 * lq);
}
__device__ __forceinline__ void m2d_loadB(const Params& p, int base, int w, int lane, DPre& d) {
  const bf16x8* qf = reinterpret_cast<const bf16x8*>(p.ws + D_QF + (size_t)base * 16384);
  const bf16x8* att = reinterpret_cast<const bf16x8*>(p.ws + D_ATT + (size_t)base * 8192);
#pragma unroll
  for (int ks = 0; ks < 4; ++ks) d.q[ks] = qf[(w * 4 + ks) * 64 + lane];
#pragma unroll
  for (int ks = 0; ks < 2; ++ks) d.att[ks] = att[(w * 2 + ks) * 64 + lane];
}
__device__ __forceinline__ void m2d_loadC(const Params& p, int base, int w, int lane, DPre& d) {
  const bf16x8* knt = reinterpret_cast<const bf16x8*>(p.ws + D_KNT + (size_t)base * 16384);
#pragma unroll
  for (int ks = 0; ks < 2; ++ks) {
    d.knt[0][ks] = knt[((2 * w) * 2 + ks) * 64 + lane];
    d.knt[1][ks] = knt[((2 * w + 1) * 2 + ks) * 64 + lane];
  }
}

__device__ __forceinline__ void m2_delta_item(const Params& p, int item, char* smem) {
  const int tid = VTID, lane = tid & 63, w = tid >> 6, lr = lane & 15, lq = lane >> 4;
  const int es = item & 3, h = (item >> 2) & 3, b = item >> 4;
  u16* Sb = reinterpret_cast<u16*>(smem);
  u16* Ub = reinterpret_cast<u16*>(smem + 17408);
  u16* Usb = reinterpret_cast<u16*>(smem + 22016);
  for (int i = tid; i < 32 * 136; i += NTHR) Sb[i] = 0;
  f32x4 accS[2][2];
#pragma unroll
  for (int i = 0; i < 2; ++i)
#pragma unroll
    for (int j = 0; j < 2; ++j) accS[i][j] = (f32x4){0.f, 0.f, 0.f, 0.f};
  u16* OA = reinterpret_cast<u16*>(reinterpret_cast<char*>(p.out) + YB_OA);
  DPre cur;
  m2d_loadA(p, (b * 32 + 0) * 4 + h, es, w, lane, cur);
  m2d_loadB(p, (b * 32 + 0) * 4 + h, w, lane, cur);
  m2d_loadC(p, (b * 32 + 0) * 4 + h, w, lane, cur);
  __syncthreads();
  for (int n = 0; n < 32; ++n) {
    const int nbase = (b * 32 + (n + 1 < 32 ? n + 1 : n)) * 4 + h;
    const u16* Sc = Sb + (n & 1) * (32 * 136);
    u16* Sn = Sb + ((n + 1) & 1) * (32 * 136);
    f32x4 accP[2];
    accP[0] = (f32x4){0.f, 0.f, 0.f, 0.f}; accP[1] = accP[0];
#pragma unroll
    for (int ks = 0; ks < 4; ++ks) {
      accP[0] = mfma16(lds_frag(Sc, 136, 0, ks * 32, lane), cur.kcd[ks], accP[0]);
      accP[1] = mfma16(lds_frag(Sc, 136, 16, ks * 32, lane), cur.kcd[ks], accP[1]);
    }
    const float egc = __expf(cur.gl - cur.gc);
    const float egl = __expf(cur.gl);
    const float egi[4] = {__expf(cur.gi.x), __expf(cur.gi.y), __expf(cur.gi.z), __expf(cur.gi.w)};
    float vv[2][4];
#pragma unroll
    for (int eb = 0; eb < 2; ++eb) { vv[eb][0] = lo2f(cur.val[eb].x); vv[eb][1] = hi2f(cur.val[eb].x); vv[eb][2] = lo2f(cur.val[eb].y); vv[eb][3] = hi2f(cur.val[eb].y); }
    m2d_loadA(p, nbase, es, w, lane, cur);
#pragma unroll
    for (int eb = 0; eb < 2; ++eb) {
#pragma unroll
      for (int j = 0; j < 4; ++j) {
        float u = vv[eb][j] - accP[eb][j];
        int e = eb * 16 + 4 * lq + j, c = 16 * w + lr;
        Ub[e * 72 + c] = f2bf(u);
        Usb[e * 72 + c] = f2bf(u * egc);
      }
    }
    lds_barrier();
    {
      f32x4 accO[2];
      accO[0] = (f32x4){0.f, 0.f, 0.f, 0.f}; accO[1] = accO[0];
#pragma unroll
      for (int ks = 0; ks < 4; ++ks) {
        accO[0] = mfma16(cur.q[ks], lds_frag(Sc, 136, 0, ks * 32, lane), accO[0]);
        accO[1] = mfma16(cur.q[ks], lds_frag(Sc, 136, 16, ks * 32, lane), accO[1]);
      }
#pragma unroll
      for (int eb = 0; eb < 2; ++eb)
#pragma unroll
        for (int j = 0; j < 4; ++j) accO[eb][j] *= egi[j];
#pragma unroll
      for (int ks = 0; ks < 2; ++ks) {
        accO[0] = mfma16(cur.att[ks], lds_frag(Ub, 72, 0, ks * 32, lane), accO[0]);
        accO[1] = mfma16(cur.att[ks], lds_frag(Ub, 72, 16, ks * 32, lane), accO[1]);
      }
      m2d_loadB(p, nbase, w, lane, cur);
#pragma unroll
      for (int eb = 0; eb < 2; ++eb)
#pragma unroll
        for (int j = 0; j < 4; ++j) {
          int tok = b * 2048 + n * 64 + 16 * w + 4 * lq + j;
          OA[(size_t)tok * 512 + h * 128 + es * 32 + eb * 16 + lr] = f2bf(accO[eb][j]);
        }
    }
    {
#pragma unroll
      for (int eb = 0; eb < 2; ++eb) {
        bf16x8 a0 = lds_frag(Usb, 72, eb * 16, 0, lane), a1 = lds_frag(Usb, 72, eb * 16, 32, lane);
#pragma unroll
        for (int dd = 0; dd < 2; ++dd) {
#pragma unroll
          for (int j = 0; j < 4; ++j) accS[eb][dd][j] *= egl;
          accS[eb][dd] = mfma16(a0, cur.knt[dd][0], accS[eb][dd]);
          accS[eb][dd] = mfma16(a1, cur.knt[dd][1], accS[eb][dd]);
#pragma unroll
          for (int j = 0; j < 4; ++j) Sn[(eb * 16 + 4 * lq + j) * 136 + (2 * w + dd) * 16 + lr] = f2bf(accS[eb][dd][j]);
        }
      }
    }
    m2d_loadC(p, nbase, w, lane, cur);
    lds_barrier();
  }
  float* outp = p.out + O_DELTAP + (size_t)(b * 4 + h) * 16384;
#pragma unroll
  for (int eb = 0; eb < 2; ++eb)
#pragma unroll
    for (int dd = 0; dd < 2; ++dd) {
      int d = (2 * w + dd) * 16 + lr, e0 = es * 32 + eb * 16 + 4 * lq;
      *reinterpret_cast<float4*>(outp + (size_t)d * 128 + e0) =
          make_float4(accS[eb][dd][0], accS[eb][dd][1], accS[eb][dd][2], accS[eb][dd][3]);
    }
  __syncthreads();
}

struct HPre {
  bf16x8 qg[4], att, vt[2], kgt[2];
  float ebl[2];
};
__device__ __forceinline__ HPre m2h_load(const Params& p, int base, int vs, int w, int lane) {
  HPre d;
  const int lr = lane & 15;
  const bf16x8* qg = reinterpret_cast<const bf16x8*>(p.ws + H_QG + (size_t)base * 8192);
  const bf16x8* att = reinterpret_cast<const bf16x8*>(p.ws + H_ATT + (size_t)base * 2048);
  const bf16x8* vt = reinterpret_cast<const bf16x8*>(p.ws + H_VT + (size_t)base * 8192);
  const bf16x8* kgt = reinterpret_cast<const bf16x8*>(p.ws + H_KGT + (size_t)base * 8192);
  const float* ebl = reinterpret_cast<const float*>(p.ws + H_EBL) + (size_t)base * 128;
  const int ib = w >> 1;
#pragma unroll
  for (int ks = 0; ks < 4; ++ks) d.qg[ks] = qg[(ib * 4 + ks) * 64 + lane];
  d.att = att[ib * 64 + lane];
  d.vt[0] = vt[(vs * 2 + 0) * 64 + lane];
  d.vt[1] = vt[(vs * 2 + 1) * 64 + lane];
  d.kgt[0] = kgt[(2 * w) * 64 + lane];
  d.kgt[1] = kgt[(2 * w + 1) * 64 + lane];
  d.ebl[0] = ebl[(2 * w) * 16 + lr];
  d.ebl[1] = ebl[(2 * w + 1) * 16 + lr];
  return d;
}

__device__ __forceinline__ void m2_hgrn_item(const Params& p, int item, char* smem) {
  const int tid = VTID, lane = tid & 63, w = tid >> 6, lr = lane & 15, lq = lane >> 4;
  const int vs = item & 3, h = (item >> 2) & 3, b = item >> 4;
  u16* Sb = reinterpret_cast<u16*>(smem);
  for (int i = tid; i < 32 * 136; i += NTHR) Sb[i] = 0;
  f32x4 accS[2][2];
#pragma unroll
  for (int i = 0; i < 2; ++i)
#pragma unroll
    for (int j = 0; j < 2; ++j) accS[i][j] = (f32x4){0.f, 0.f, 0.f, 0.f};
  u16* OB = reinterpret_cast<u16*>(reinterpret_cast<char*>(p.out) + YB_OB);
  const int ib = w >> 1, vb = w & 1;
  HPre cur = m2h_load(p, (b * 64 + 0) * 4 + h, vs, w, lane), nxt = cur;
  __syncthreads();
  for (int n = 0; n < 64; ++n) {
    if (n + 1 < 64) nxt = m2h_load(p, (b * 64 + n + 1) * 4 + h, vs, w, lane);
    const u16* Sc = Sb + (n & 1) * (32 * 136);
    u16* Sn = Sb + ((n + 1) & 1) * (32 * 136);
    {
      f32x4 o = (f32x4){0.f, 0.f, 0.f, 0.f};
#pragma unroll
      for (int ks = 0; ks < 4; ++ks) o = mfma16(cur.qg[ks], lds_frag(Sc, 136, vb * 16, ks * 32, lane), o);
      o = mfma16(cur.att, vb ? cur.vt[1] : cur.vt[0], o);
#pragma unroll
      for (int j = 0; j < 4; ++j) {
        int tok = b * 2048 + n * 32 + ib * 16 + 4 * lq + j;
        OB[(size_t)tok * 512 + h * 128 + vs * 32 + vb * 16 + lr] = f2bf(o[j]);
      }
    }
#pragma unroll
    for (int v2 = 0; v2 < 2; ++v2)
#pragma unroll
      for (int dd = 0; dd < 2; ++dd) {
#pragma unroll
        for (int j = 0; j < 4; ++j) accS[v2][dd][j] *= cur.ebl[dd];
        accS[v2][dd] = mfma16(cur.vt[v2], cur.kgt[dd], accS[v2][dd]);
#pragma unroll
        for (int j = 0; j < 4; ++j) Sn[(v2 * 16 + 4 * lq + j) * 136 + (2 * w + dd) * 16 + lr] = f2bf(accS[v2][dd][j]);
      }
    lds_barrier();
    cur = nxt;
  }
  float* outp = p.out + O_HGRNP + (size_t)(b * 4 + h) * 16384;
#pragma unroll
  for (int v2 = 0; v2 < 2; ++v2)
#pragma unroll
    for (int dd = 0; dd < 2; ++dd) {
      int e = (2 * w + dd) * 16 + lr, v0 = vs * 32 + v2 * 16 + 4 * lq;
      *reinterpret_cast<float4*>(outp + (size_t)e * 128 + v0) =
          make_float4(accS[v2][dd][0], accS[v2][dd][1], accS[v2][dd][2], accS[v2][dd][3]);
    }
  __syncthreads();
}

__device__ __forceinline__ void ms_delta_item(const Params& p, int item, char* smem) {
  const int tid = VTID, lane = tid & 63, w = tid >> 6;
  const int h = item & 3, b = item >> 2;
  const int R0 = TP + b * 4;
  float* qkv = reinterpret_cast<float*>(smem);
  float* red = reinterpret_cast<float*>(smem + 6144);
  const u16* Zp = reinterpret_cast<const u16*>(p.ws + Z1);
  for (int c = tid; c < 384; c += NTHR) {
    int col = c < 128 ? h * 128 + c : (c < 256 ? 512 + h * 128 + c - 128 : 1024 + h * 128 + c - 256);
    float xs[7];
#pragma unroll
    for (int j = 0; j < 3; ++j) xs[j] = p.cache_conv[(size_t)(b * 3 + j) * 1536 + col];
#pragma unroll
    for (int t = 0; t < 4; ++t) xs[3 + t] = bf2f(Zp[(size_t)(R0 + t) * 3072 + col]);
    float wc[4];
#pragma unroll
    for (int j = 0; j < 4; ++j) wc[j] = p.w_conv_a[j * 1536 + col];
#pragma unroll
    for (int t = 0; t < 4; ++t) {
      float y = xs[t] * wc[0] + xs[t + 1] * wc[1] + xs[t + 2] * wc[2] + xs[t + 3] * wc[3];
      qkv[t * 384 + c] = silu_f(y);
    }
  }
  __syncthreads();
  {
    const int t = w;
    float q0 = qkv[t * 384 + lane], q1 = qkv[t * 384 + 64 + lane];
    float k0 = qkv[t * 384 + 128 + lane], k1 = qkv[t * 384 + 192 + lane];
    float qs = wave_sum(q0 * q0 + q1 * q1), ks = wave_sum(k0 * k0 + k1 * k1);
    float qn = rsqrtf(qs + EPS) * 0.08838834764831845f, kn = rsqrtf(ks + EPS);
    qkv[t * 384 + lane] = q0 * qn; qkv[t * 384 + 64 + lane] = q1 * qn;
    qkv[t * 384 + 128 + lane] = k0 * kn; qkv[t * 384 + 192 + lane] = k1 * kn;
  }
  __syncthreads();
  const int e = tid & 127, dh = tid >> 7;
  float S[64];
  const float* s0 = p.state_delta + (size_t)(b * 4 + h) * 16384 + (size_t)(dh * 64) * 128 + e;
#pragma unroll
  for (int dd = 0; dd < 64; ++dd) S[dd] = s0[(size_t)dd * 128];
  const float* gdec = reinterpret_cast<const float*>(p.ws + SM_GDEC);
  const float* betap = reinterpret_cast<const float*>(p.ws + SM_BETA);
  u16* OA = reinterpret_cast<u16*>(reinterpret_cast<char*>(p.out) + YB_OA);
  for (int t = 0; t < 4; ++t) {
    const float a = __expf(gdec[(size_t)(R0 + t) * 4 + h]), bt = betap[(size_t)(R0 + t) * 4 + h];
    const float* qv = qkv + t * 384 + dh * 64;
    const float* kv = qkv + t * 384 + 128 + dh * 64;
    float rp = 0.f;
#pragma unroll
    for (int dd = 0; dd < 64; ++dd) rp += S[dd] * kv[dd];
    red[((t * 2 + 0) * 2 + dh) * 128 + e] = rp;
    __syncthreads();
    float r = a * (red[((t * 2 + 0) * 2 + 0) * 128 + e] + red[((t * 2 + 0) * 2 + 1) * 128 + e]);
    float u = bt * (qkv[t * 384 + 256 + e] - r);
    float op = 0.f;
#pragma unroll
    for (int dd = 0; dd < 64; ++dd) {
      S[dd] = a * S[dd] + kv[dd] * u;
      op += S[dd] * qv[dd];
    }
    red[((t * 2 + 1) * 2 + dh) * 128 + e] = op;
    __syncthreads();
    if (dh == 0) {
      float o = red[((t * 2 + 1) * 2 + 0) * 128 + e] + red[((t * 2 + 1) * 2 + 1) * 128 + e];
      OA[(size_t)(R0 + t) * 512 + h * 128 + e] = f2bf(o);
    }
  }
  float* so = p.out + O_DELTAS + (size_t)(b * 4 + h) * 16384 + (size_t)(dh * 64) * 128 + e;
#pragma unroll
  for (int dd = 0; dd < 64; ++dd) so[(size_t)dd * 128] = S[dd];
  __syncthreads();
}

__device__ __forceinline__ void ms_hgrn_item(const Params& p, int item, char* smem) {
  const int tid = VTID;
  const int h = item & 3, b = item >> 2;
  const int R0 = TP + b * 4;
  float* qs = reinterpret_cast<float*>(smem);
  float* fs = qs + 512;
  float* vsm = fs + 512;
  float* red = vsm + 512;
  const u16* Zp = reinterpret_cast<const u16*>(p.ws + Z1);
  for (int i = tid; i < 512; i += NTHR) {
    int t = i >> 7, e = i & 127, he = h * 128 + e;
    const u16* zr = Zp + (size_t)(R0 + t) * 3072;
    float lb = sigmoid_f(p.lb_logits[he] - p.lb_logits[512 + he]);
    qs[i] = silu_f(bf2f(zr[1536 + he]));
    fs[i] = lb + (1.f - lb) * sigmoid_f(bf2f(zr[2048 + he]));
    vsm[i] = bf2f(zr[2560 + he]);
  }
  __syncthreads();
  const int v = tid & 127, eh = tid >> 7;
  float S[64];
  const float* s0 = p.state_hgrn + (size_t)(b * 4 + h) * 16384 + (size_t)(eh * 64) * 128 + v;
#pragma unroll
  for (int ee = 0; ee < 64; ++ee) S[ee] = s0[(size_t)ee * 128];
  u16* OB = reinterpret_cast<u16*>(reinterpret_cast<char*>(p.out) + YB_OB);
  for (int t = 0; t < 4; ++t) {
    const float vv = vsm[t * 128 + v];
    const float* ft = fs + t * 128 + eh * 64;
    const float* qt = qs + t * 128 + eh * 64;
    float op = 0.f;
#pragma unroll
    for (int ee = 0; ee < 64; ++ee) {
      float f = ft[ee];
      S[ee] = f * S[ee] + (1.f - f) * vv;
      op += S[ee] * qt[ee];
    }
    red[(t * 2 + eh) * 128 + v] = op;
    __syncthreads();
    if (eh == 0) OB[(size_t)(R0 + t) * 512 + h * 128 + v] = f2bf(red[(t * 2) * 128 + v] + red[(t * 2 + 1) * 128 + v]);
  }
  float* so = p.out + O_HGRNS + (size_t)(b * 4 + h) * 16384 + (size_t)(eh * 64) * 128 + v;
#pragma unroll
  for (int ee = 0; ee < 64; ++ee) so[(size_t)ee * 128] = S[ee];
  __syncthreads();
}

__device__ __forceinline__ void phase_m3(const Params& p, char* smem, int bid, int nb) {
  const int tid = VTID, lane = tid & 63, w = tid >> 6;
  float* tl = reinterpret_cast<float*>(smem);
  const int NWT = 704 + 352;
  const int NTASK = (2 * TT) / 4;
  for (int item = bid; item < NWT + NTASK; item += nb) {
    if (item < NWT) {
      if (item < 704) {
        int blk = item >> 2, k0 = (item & 3) * 256;
        int grp = blk >> 3, sub = blk & 7, up = sub >> 2;
        wt_chunk((up ? p.w_ffn_up : p.w_ffn_gate) + grp * 128 + (sub & 3) * 32, DFF, 1024,
                 reinterpret_cast<u16*>(p.ws + W_GU) + (size_t)blk * 32 * 1024, p.g_ffn, tl, k0);
      } else {
        int q = item - 704;
        int n = (q / 11) * 32, k0 = (q % 11) * 256;
        wt_chunk(p.w_ffn_down + n, 1024, DFF, reinterpret_cast<u16*>(p.ws + W_DOWN) + (size_t)n * DFF, nullptr, tl, k0);
      }
    } else {
      int task = (item - NWT) * 4 + w;
      int tok = task >> 1, br = task & 1;
      u16* o = reinterpret_cast<u16*>(reinterpret_cast<char*>(p.out) + (br ? YB_OB : YB_OA)) + (size_t)tok * 512 + lane * 8;
      const u16* og = z2row(p, tok) + 2048 + br * 512 + lane * 8;
      const float* g = (br ? p.g_out_b : p.g_out_a) + (lane & 15) * 8;
      uint4 ov = *reinterpret_cast<const uint4*>(o), gv = *reinterpret_cast<const uint4*>(og);
      unsigned oo[4] = {ov.x, ov.y, ov.z, ov.w}, gg[4] = {gv.x, gv.y, gv.z, gv.w};
      float x[8], y[8];
#pragma unroll
      for (int j = 0; j < 4; ++j) { x[2 * j] = lo2f(oo[j]); x[2 * j + 1] = hi2f(oo[j]); y[2 * j] = lo2f(gg[j]); y[2 * j + 1] = hi2f(gg[j]); }
      float ss = 0.f;
#pragma unroll
      for (int j = 0; j < 8; ++j) ss += x[j] * x[j];
      ss += __shfl_xor(ss, 1, 64); ss += __shfl_xor(ss, 2, 64); ss += __shfl_xor(ss, 4, 64); ss += __shfl_xor(ss, 8, 64);
      float rstd = rsqrtf(ss * (1.f / 128.f) + EPS);
      unsigned r[4];
#pragma unroll
      for (int j = 0; j < 4; ++j)
        r[j] = pack2(x[2 * j] * rstd * g[2 * j] * silu_f(y[2 * j]), x[2 * j + 1] * rstd * g[2 * j + 1] * silu_f(y[2 * j + 1]));
      *reinterpret_cast<uint4*>(o) = make_uint4(r[0], r[1], r[2], r[3]);
    }
  }
}

__device__ __forceinline__ void phase_fixup(const Params& p, int bid, int nb) {
  const float* haloG = reinterpret_cast<const float*>(p.ws + HALO_G);
  const float* headG = reinterpret_cast<const float*>(p.ws + HEAD_G);
  const float* headU = reinterpret_cast<const float*>(p.ws + HEAD_U);
  u16* ACTp = reinterpret_cast<u16*>(p.ws + ACT);
  const int total = 256 * 2 * DFF;
  for (int i = bid * NTHR + VTID; i < total; i += nb * NTHR) {
    int ch = i % DFF, rr = (i / DFF) & 1, blk = i / (2 * DFF);
    if ((blk & 31) == 0) continue;
    float g0 = headG[(size_t)(blk * 2 + rr) * DFF + ch], u = headU[(size_t)(blk * 2 + rr) * DFF + ch];
    float gm1, gm2;
    if (rr == 0) { gm1 = haloG[(size_t)((blk - 1) * 2 + 1) * DFF + ch]; gm2 = haloG[(size_t)((blk - 1) * 2 + 0) * DFF + ch]; }
    else { gm1 = headG[(size_t)(blk * 2 + 0) * DFF + ch]; gm2 = haloG[(size_t)((blk - 1) * 2 + 1) * DFF + ch]; }
    float gc = p.w_ffn_conv[ch] * gm2 + p.w_ffn_conv[DFF + ch] * gm1 + p.w_ffn_conv[2 * DFF + ch] * g0;
    ACTp[(size_t)(blk * 64 + rr) * DFF + ch] = f2bf(silu_f(gc) * u);
  }
}

__device__ __forceinline__ void phase_final(const Params& p, int bid, int nb) {
  const int tid = VTID, lane = tid & 63, w = tid >> 6;
  for (int row = bid * 4 + w; row < TP; row += nb * 8) {
    const int rowB = row + nb * 4;
    const bool hasB = rowB < TP;
    float* ya = p.out + O_YP + (size_t)row * DM;
    float* yb = p.out + O_YP + (size_t)(hasB ? rowB : row) * DM;
    float4 xa[4], xb[4];
#pragma unroll
    for (int i = 0; i < 4; ++i) xa[i] = *reinterpret_cast<const float4*>(ya + i * 256 + lane * 4);
#pragma unroll
    for (int i = 0; i < 4; ++i) xb[i] = *reinterpret_cast<const float4*>(yb + i * 256 + lane * 4);
    float sa = 0.f, sb = 0.f;
#pragma unroll
    for (int i = 0; i < 4; ++i) {
      sa += xa[i].x * xa[i].x + xa[i].y * xa[i].y + xa[i].z * xa[i].z + xa[i].w * xa[i].w;
      sb += xb[i].x * xb[i].x + xb[i].y * xb[i].y + xb[i].z * xb[i].z + xb[i].w * xb[i].w;
    }
    sa = wave_sum(sa); sb = wave_sum(sb);
    const float ra = rsqrtf(sa * (1.f / DM) + EPS), rb = rsqrtf(sb * (1.f / DM) + EPS);
#pragma unroll
    for (int i = 0; i < 4; ++i) {
      float4 g = *reinterpret_cast<const float4*>(p.g_final + i * 256 + lane * 4);
      *reinterpret_cast<float4*>(ya + i * 256 + lane * 4) = make_float4(xa[i].x * ra * g.x, xa[i].y * ra * g.y, xa[i].z * ra * g.z, xa[i].w * ra * g.w);
      if (hasB) *reinterpret_cast<float4*>(yb + i * 256 + lane * 4) = make_float4(xb[i].x * rb * g.x, xb[i].y * rb * g.y, xb[i].z * rb * g.z, xb[i].w * rb * g.w);
    }
  }
  for (int row = TP + bid * 4 + w; row < TT; row += nb * 4) {
    float* y = p.out + O_YP + (size_t)row * DM;
    float4 xv[4];
    float ss = 0.f;
    const float* part = reinterpret_cast<const float*>(p.ws + PART) + (size_t)(row - TP) * 1024;
#pragma unroll
    for (int i = 0; i < 4; ++i) {
      xv[i] = *reinterpret_cast<const float4*>(y + i * 256 + lane * 4);
      for (int ks = 0; ks < 11; ++ks) {
        float4 pv = *reinterpret_cast<const float4*>(part + (size_t)ks * TS * 1024 + i * 256 + lane * 4);
        xv[i].x += pv.x; xv[i].y += pv.y; xv[i].z += pv.z; xv[i].w += pv.w;
      }
      ss += xv[i].x * xv[i].x + xv[i].y * xv[i].y + xv[i].z * xv[i].z + xv[i].w * xv[i].w;
    }
    ss = wave_sum(ss);
    float rstd = rsqrtf(ss * (1.f / DM) + EPS);
#pragma unroll
    for (int i = 0; i < 4; ++i) {
      float4 g = *reinterpret_cast<const float4*>(p.g_final + i * 256 + lane * 4);
      *reinterpret_cast<float4*>(y + i * 256 + lane * 4) =
          make_float4(xv[i].x * rstd * g.x, xv[i].y * rstd * g.y, xv[i].z * rstd * g.z, xv[i].w * rstd * g.w);
    }
  }
}

constexpr int NPHASE = 12;
__device__ __forceinline__ void run_phase(const Params& p, int ph, char* smem_all) {
  int half = threadIdx.x >> 8;
  asm volatile("" : "+v"(half));
  const int bid = blockIdx.x * 2 + half, nb = gridDim.x * 2;
  char* smem = smem_all + half * SMEM_HALF;
  LAS unsigned char* lds = (LAS unsigned char*)smem_all;
  const u16* HB = reinterpret_cast<const u16*>(reinterpret_cast<const char*>(p.out) + YB_H);
  switch (ph) {
    case 0: phase_prep(p, smem, bid, nb); break;
    case 1: { pg8::SchedStatic S; S.init(TT, 3072, (int)gridDim.x, (int)blockIdx.x, 0); gemm_phase8<EPI_Z1>(p, HB, reinterpret_cast<const u16*>(p.ws + W_MAIN), 1024, 1024, lds, S); } break;
    case 2:
      for (int it = bid; it < 1024 + 2048; it += nb) {
        if (it < 1024) m1_delta_item(p, it, smem); else m1_hgrn_item(p, it - 1024, smem);
      }
      break;
    case 3: {
      const int g = blockIdx.x;
      if (g < 128) {
        const int gg = g & 63, xcd = gg & 7, j = gg >> 3;
        const int q = xcd + 8 * (j >> 1), es = 2 * (j & 1) + half;
        if (g < 64) m2_delta_item(p, q * 4 + es, smem); else m2_hgrn_item(p, q * 4 + es, smem);
      } else {
        const int nrest = (gridDim.x - 128) * 2, v0 = (g - 128) * 2 + half;
        for (int it = v0; it < 1024; it += nrest) {
          if (it < 512) ms_delta_item(p, it, smem); else ms_hgrn_item(p, it - 512, smem);
        }
        __syncthreads();
        { pg8::SchedStatic S; S.init(TS, 3072, 24, g - 128, 64);
          gemm_phase8<EPI_Z2>(p, HB, reinterpret_cast<const u16*>(p.ws + W_G2), 1024, 1024, lds, S); }
      }
    } break;
    case 4: { pg8::SchedStatic S; S.init(TP, 3072, (int)gridDim.x, (int)blockIdx.x, 0); gemm_phase8<EPI_Z2>(p, HB, reinterpret_cast<const u16*>(p.ws + W_G2), 1024, 1024, lds, S); } break;
    case 5: phase_m3(p, smem, bid, nb); break;
    case 6: {
      const u16* OA = reinterpret_cast<const u16*>(reinterpret_cast<const char*>(p.out) + YB_OA);
      const u16* OB = reinterpret_cast<const u16*>(reinterpret_cast<const char*>(p.out) + YB_OB);
      { pg8::SchedStatic S; S.init(TT, 1024, (int)gridDim.x, (int)blockIdx.x, 0); gemm_phase8<EPI_MIXA>(p, OA, reinterpret_cast<const u16*>(p.ws + W_A), 512, 512, lds, S);
      gemm_phase8<EPI_MIXB>(p, OB, reinterpret_cast<const u16*>(p.ws + W_B), 512, 512, lds, S); }
    } break;
    case 7: { pg8::SchedStatic S; S.init(TT, 1024, (int)gridDim.x, (int)blockIdx.x, 0); gemm_phase8<EPI_WOUT>(p, reinterpret_cast<const u16*>(p.ws + MIX), reinterpret_cast<const u16*>(p.ws + W_OUT), 1024, 1024, lds, S); } break;
    case 8: {
      { pg8::SchedStatic S; S.init(TP, 5632, (int)gridDim.x, (int)blockIdx.x, 0);
        gemm_phase8<EPI_FFN1>(p, reinterpret_cast<const u16*>(p.ws + X1B), reinterpret_cast<const u16*>(p.ws + W_GU), 1024, 1024, lds, S); }
      { pg8::SchedStatic S; S.init(TS, 5632, (int)gridDim.x, (int)gridDim.x - 1 - (int)blockIdx.x, 64);
        gemm_phase8<EPI_FFN1S>(p, reinterpret_cast<const u16*>(p.ws + X1B), reinterpret_cast<const u16*>(p.ws + W_GU), 1024, 1024, lds, S); }
    } break;
    case 9: phase_fixup(p, bid, nb); break;
    case 10: {
      { pg8::SchedStatic S; S.init(TP, 1024, (int)gridDim.x, (int)blockIdx.x, 0);
        gemm_phase8<EPI_FFN2>(p, reinterpret_cast<const u16*>(p.ws + ACT), reinterpret_cast<const u16*>(p.ws + W_DOWN), DFF, DFF, lds, S); }
      { pg8::SchedSplit S; S.init(2, 4, 11, (int)gridDim.x, (int)blockIdx.x, 64);
        gemm_phase8<EPI_FFN2S>(p, reinterpret_cast<const u16*>(p.ws + ACT), reinterpret_cast<const u16*>(p.ws + W_DOWN), DFF, 256, lds, S); }
    } break;
    case 11: phase_final(p, bid, nb); break;
  }
}

__global__ void __launch_bounds__(512, 2) k_main(Params p, int ph0, int ph1) {
  extern __shared__ __attribute__((aligned(16))) char smem[];
  volatile LAS unsigned* xst = (volatile LAS unsigned*)(smem + 2 * SMEM_HALF);
  if (threadIdx.x == 0) { xst[0] = 0u; xst[1] = 0u; }
  __syncthreads();
  XcdBarrier xb = xcd_barrier_post(reinterpret_cast<unsigned*>(p.ws + BAR_OFF), xst);
  if (ph1 < 0) cg::this_grid().sync();
#define PHASE_STEP(N)                                        \
  if (ph0 <= N && N < ph1) run_phase(p, N, smem);            \
  if (ph0 <= N && N + 1 < ph1) xcd_barrier(xb);
  PHASE_STEP(0) PHASE_STEP(1) PHASE_STEP(2) PHASE_STEP(3) PHASE_STEP(4) PHASE_STEP(5)
  PHASE_STEP(6) PHASE_STEP(7) PHASE_STEP(8) PHASE_STEP(9) PHASE_STEP(10) PHASE_STEP(11)
#undef PHASE_STEP
}

extern "C" void kernel_launch(void* const* d_in, const int* in_sizes, int n_in, void* d_out, int out_size, void* d_ws,
                              size_t ws_size, hipStream_t stream) {
  static int grid_blocks = 0;
  if (!grid_blocks) {
    hipFuncSetAttribute((const void*)k_main, hipFuncAttributeMaxDynamicSharedMemorySize, SMEM_BYTES);
    int dev = 0, cus = 0, per_cu = 0;
    hipGetDevice(&dev);
    hipDeviceGetAttribute(&cus, hipDeviceAttributeMultiprocessorCount, dev);
    hipOccupancyMaxActiveBlocksPerMultiprocessor(&per_cu, k_main, 512, SMEM_BYTES);
    if (per_cu > 1) per_cu = 1;
    if (per_cu < 1) per_cu = 1;
    grid_blocks = cus * per_cu;
  }
  Params p{};
  const float** f = reinterpret_cast<const float**>(&p);
  for (int i = 0; i < 23; ++i) f[i] = reinterpret_cast<const float*>(d_in[i]);
  p.out = reinterpret_cast<float*>(d_out);
  p.ws = reinterpret_cast<char*>(d_ws);
  if (ws_size < WS_NEED) fprintf(stderr, "workspace too small: %zu < %zu\n", ws_size, (size_t)WS_NEED);
  hipMemsetAsync(p.ws + BAR_OFF, 0, 16384, stream);
#if MULTI_LAUNCH
  for (int ph = 0; ph < NPHASE; ++ph) {
    hipLaunchKernelGGL(k_main, dim3(grid_blocks), dim3(512), SMEM_BYTES, stream, p, ph, ph + 1);
  }
#else
  int ph0 = 0, ph1 = NPHASE;
  void* args[] = {&p, &ph0, &ph1};
  hipError_t e = hipLaunchCooperativeKernel((void*)k_main, dim3(grid_blocks), dim3(512), args, SMEM_BYTES, stream);
  if (e != hipSuccess) fprintf(stderr, "cooperative launch failed: %s (grid %d)\n", hipGetErrorString(e), grid_blocks);
#endif
}
```

```cpp
#include <hip/hip_runtime.h>
#include <hip/hip_cooperative_groups.h>
#include <cstdio>
#include <cstdint>
namespace cg = cooperative_groups;

#ifndef MULTI_LAUNCH
#define MULTI_LAUNCH 0
#endif

typedef unsigned short u16;
typedef __attribute__((ext_vector_type(8))) short bf16x8;
typedef __attribute__((ext_vector_type(4))) float f32x4;

constexpr int TP = 16384, TS = 512, TT = TP + TS;
constexpr int DM = 1024, NIN = 6152, DFF = 2816;
constexpr float EPS = 1e-6f;
constexpr int NTHR = 256;
#define VTID (threadIdx.x & 255)
constexpr int SMEM_HALF = 77824;
constexpr int SMEM_BYTES = 2 * SMEM_HALF + 16;

constexpr size_t O_YP = 0;
constexpr size_t O_YS = O_YP + (size_t)TP * DM;
constexpr size_t O_CONVP = O_YS + (size_t)TS * DM;
constexpr size_t O_DELTAP = O_CONVP + 8 * 3 * 1536;
constexpr size_t O_HGRNP = O_DELTAP + 8 * 4 * 128 * 128;
constexpr size_t O_FFNP = O_HGRNP + 8 * 4 * 128 * 128;
constexpr size_t O_CONVS = O_FFNP + 8 * 2 * DFF;
constexpr size_t O_DELTAS = O_CONVS + 128 * 3 * 1536;
constexpr size_t O_HGRNS = O_DELTAS + (size_t)128 * 4 * 128 * 128;
constexpr size_t O_FFNS = O_HGRNS + (size_t)128 * 4 * 128 * 128;

constexpr size_t al(size_t x) { return (x + 255) & ~(size_t)255; }
constexpr size_t W_MAIN = 0;
constexpr size_t W_G2 = W_MAIN + (size_t)3072 * 1024 * 2;
constexpr size_t W_A = W_G2 + (size_t)3072 * 1024 * 2;
constexpr size_t W_B = W_A + (size_t)1024 * 512 * 2;
constexpr size_t W_OUT = W_B + (size_t)1024 * 512 * 2;
constexpr size_t SM_GDEC = W_OUT + (size_t)1024 * 1024 * 2;
constexpr size_t SM_BETA = al(SM_GDEC + (size_t)TT * 16);
constexpr size_t SM_ROWSS = al(SM_BETA + (size_t)TT * 16);
constexpr size_t Z1 = al(SM_ROWSS + (size_t)TT * 4);
constexpr size_t Z1_SIZE = (size_t)TT * 3072 * 2;
constexpr size_t RB = al(Z1 + Z1_SIZE);
constexpr size_t D_QF = RB;
constexpr size_t D_KCD = D_QF + (size_t)1024 * 16384;
constexpr size_t D_KNT = D_KCD + (size_t)1024 * 16384;
constexpr size_t D_VALT = D_KNT + (size_t)1024 * 16384;
constexpr size_t D_ATT = D_VALT + (size_t)1024 * 16384;
constexpr size_t D_GC = D_ATT + (size_t)1024 * 8192;
constexpr size_t H_QG = D_GC + (size_t)1024 * 256;
constexpr size_t H_KGT = H_QG + (size_t)2048 * 8192;
constexpr size_t H_VT = H_KGT + (size_t)2048 * 8192;
constexpr size_t H_ATT = H_VT + (size_t)2048 * 8192;
constexpr size_t H_EBL = H_ATT + (size_t)2048 * 2048;
constexpr size_t RB_END1 = H_EBL + (size_t)2048 * 512;
constexpr size_t Z2 = RB;
constexpr size_t X1B = RB;
constexpr size_t ACT = RB + (size_t)TT * 1024 * 2;
constexpr size_t RB_END2 = ACT + (size_t)TT * DFF * 2;
constexpr size_t WS_NEED = (RB_END1 > RB_END2 ? RB_END1 : RB_END2);
constexpr size_t BAR_OFF = al(WS_NEED);
constexpr size_t Z2S = BAR_OFF + 16384;
static_assert(Z2S + (size_t)TS * 3072 * 2 <= (size_t)268435456, "workspace too large");
constexpr size_t W_GU = Z1;
constexpr size_t W_DOWN = W_GU + (size_t)5632 * 1024 * 2;
constexpr size_t MIX = W_DOWN + (size_t)1024 * DFF * 2;
constexpr size_t HALO_G = MIX + (size_t)TT * 1024 * 2;
constexpr size_t HEAD_G = HALO_G + (size_t)264 * 2 * DFF * 4;
constexpr size_t HEAD_U = HEAD_G + (size_t)264 * 2 * DFF * 4;
constexpr size_t PART = HEAD_U + (size_t)264 * 2 * DFF * 4;
static_assert(PART + (size_t)11 * TS * 1024 * 4 <= Z1 + Z1_SIZE, "z1 reuse overflow");
constexpr size_t YB_H = 0;
constexpr size_t YB_OA = (size_t)TT * 1024 * 2;
constexpr size_t YB_OB = YB_OA + (size_t)TT * 512 * 2;

struct Params {
  const float *x_prompt, *x_sample, *cache_conv, *state_delta, *state_hgrn, *cache_ffn;
  const float *g_attn, *w_in, *w_conv_a, *a_log, *dt_bias, *g_out_a, *w_branch_a, *lb_logits, *g_out_b,
      *w_branch_b, *w_out, *g_ffn, *w_ffn_gate, *w_ffn_up, *w_ffn_conv, *w_ffn_down, *g_final;
  float* out;
  char* ws;
};

__device__ __forceinline__ const unsigned short* z2row(const Params& p, int row) {
  return row < TP ? reinterpret_cast<const unsigned short*>(p.ws + Z2) + (size_t)row * 3072
                  : reinterpret_cast<const unsigned short*>(p.ws + Z2S) + (size_t)(row - TP) * 3072;
}
typedef __bf16 bf16x2_t __attribute__((ext_vector_type(2)));
typedef float f32x2_t __attribute__((ext_vector_type(2)));
__device__ __forceinline__ unsigned pack2(float a, float b) {
  f32x2_t v = {a, b};
  bf16x2_t r = __builtin_convertvector(v, bf16x2_t);
  return __builtin_bit_cast(unsigned, r);
}
__device__ __forceinline__ u16 f2bf(float f) { return (u16)(pack2(f, 0.f) & 0xffffu); }
__device__ __forceinline__ float bf2f(u16 h) { return __uint_as_float(((unsigned)h) << 16); }
__device__ __forceinline__ float lo2f(unsigned u) { return __uint_as_float(u << 16); }
__device__ __forceinline__ float hi2f(unsigned u) { return __uint_as_float(u & 0xffff0000u); }
__device__ __forceinline__ float silu_f(float x) { return x * __builtin_amdgcn_rcpf(1.f + __expf(-x)); }
__device__ __forceinline__ float sigmoid_f(float x) { return __builtin_amdgcn_rcpf(1.f + __expf(-x)); }
__device__ __forceinline__ float wave_sum(float v) {
#pragma unroll
  for (int o = 32; o >= 1; o >>= 1) v += __shfl_xor(v, o, 64);
  return v;
}
__device__ __forceinline__ void lds_barrier() {
  __builtin_amdgcn_fence(__ATOMIC_RELEASE, "workgroup", "local");
  __builtin_amdgcn_s_barrier();
  __builtin_amdgcn_fence(__ATOMIC_ACQUIRE, "workgroup", "local");
}
__device__ __forceinline__ f32x4 mfma16(bf16x8 a, bf16x8 b, f32x4 c) {
  return __builtin_amdgcn_mfma_f32_16x16x32_bf16(a, b, c, 0, 0, 0);
}
__device__ __forceinline__ bf16x8 lds_frag(const u16* base, int ld, int row0, int k0, int lane) {
  return *reinterpret_cast<const bf16x8*>(base + (row0 + (lane & 15)) * ld + k0 + 8 * (lane >> 4));
}
__device__ __forceinline__ void store_frags(const u16* lds, int ld, int R, int K, u16* dst, int t, int nt) {
  const int nkb = K >> 5, total = (R >> 4) * nkb * 64;
  for (int idx = t; idx < total; idx += nt) {
    int f = idx >> 6, pl = idx & 63, rb = f / nkb, kb = f - rb * nkb;
    uint4 v = *reinterpret_cast<const uint4*>(lds + (rb * 16 + (pl & 15)) * ld + kb * 32 + 8 * (pl >> 4));
    *reinterpret_cast<uint4*>(dst + (size_t)idx * 8) = v;
  }
}
__device__ __forceinline__ void store_frags_T(const u16* lds, int ld, int R2, int K2, u16* dst, int t, int nt) {
  const int nkb = K2 >> 5, total = (R2 >> 4) * nkb * 64;
  for (int idx = t; idx < total; idx += nt) {
    int f = idx >> 6, pl = idx & 63, rb = f / nkb, kb = f - rb * nkb;
    int d = rb * 16 + (pl & 15), c0 = kb * 32 + 8 * (pl >> 4);
    unsigned r[4];
#pragma unroll
    for (int j = 0; j < 4; ++j) {
      unsigned a = lds[(c0 + 2 * j) * ld + d], b = lds[(c0 + 2 * j + 1) * ld + d];
      r[j] = a | (b << 16);
    }
    *reinterpret_cast<uint4*>(dst + (size_t)idx * 8) = make_uint4(r[0], r[1], r[2], r[3]);
  }
}

#define XB_TMO 128
#define XB_XCNT(j) (256 + 64 * (j))
#define XB_XSUB(j) (1280 + 64 * (j))
#define XB_XGEN(j) (2304 + 64 * (j))
#define XB_TOP 3328
#define XB_TOPGEN 3392
#define XCD_BAR_WORDS 3456
#define XB_SPIN_CAP (1u << 18)
#define LAS __attribute__((address_space(3)))
__device__ __forceinline__ unsigned xb_ld(unsigned* p) { return __hip_atomic_load(p, __ATOMIC_RELAXED, __HIP_MEMORY_SCOPE_AGENT); }
__device__ __forceinline__ unsigned xb_add(unsigned* p, unsigned v) { return __hip_atomic_fetch_add(p, v, __ATOMIC_RELAXED, __HIP_MEMORY_SCOPE_AGENT); }
__device__ __forceinline__ unsigned xb_xcc_id() { return (unsigned)__builtin_amdgcn_s_getreg((3 << 11) | 20) & 0xFu; }
#define XB_SPIN(cond, bar) do { unsigned _sp = 0; while (cond) { __builtin_amdgcn_s_sleep(1); \
    if ((++_sp & 255u) == 0u) { if (xb_ld(&(bar)[XB_TMO])) break; if (_sp > XB_SPIN_CAP) { atomicAdd(&(bar)[XB_TMO], 1u); break; } } } } while (0)
struct XcdBarrier { unsigned* bar; unsigned x; volatile LAS unsigned* st; };
__device__ __forceinline__ XcdBarrier xcd_barrier_post(unsigned* bar, volatile LAS unsigned* st) {
  XcdBarrier b; b.bar = bar; b.x = xb_xcc_id(); b.st = st;
  if (threadIdx.x == 0) (void)xb_add(&bar[XB_XCNT(b.x)], 1u);
  return b;
}
__device__ __forceinline__ void xcd_barrier_complete(unsigned* bar, unsigned x, unsigned& nloc, unsigned& nx) {
  const unsigned G = gridDim.x * gridDim.y * gridDim.z;
  unsigned sum, cnt, mine, sp = 0u;
  for (;;) {
    sum = 0u; cnt = 0u; mine = 0u;
#pragma unroll
    for (unsigned j = 0; j < 16; ++j) { const unsigned c = xb_ld(&bar[XB_XCNT(j)]); sum += c; cnt += (c > 0u) ? 1u : 0u; mine = (j == x) ? c : mine; }
    if (sum == G) break;
    __builtin_amdgcn_s_sleep(1);
    if ((++sp & 255u) == 0u) { if (xb_ld(&bar[XB_TMO])) break; if (sp > XB_SPIN_CAP) { atomicAdd(&bar[XB_TMO], 1u); break; } }
  }
  nloc = mine > 0u ? mine : 1u; nx = cnt > 0u ? cnt : 1u;
}
__device__ __forceinline__ void xcd_barrier(const XcdBarrier& b) {
  asm volatile("s_waitcnt vmcnt(0)" ::: "memory");
  __syncthreads();
  if (threadIdx.x == 0) {
    unsigned* bar = b.bar;
    __builtin_amdgcn_s_waitcnt(0);
    unsigned nloc = b.st[0], nx = b.st[1];
    if (nloc == 0u) { xcd_barrier_complete(bar, b.x, nloc, nx); b.st[0] = nloc; b.st[1] = nx; }
    const unsigned old = xb_add(&bar[XB_XSUB(b.x)], 1u);
    const unsigned gen = old / nloc;
    if (old + 1u == (gen + 1u) * nloc) {
      __builtin_amdgcn_fence(__ATOMIC_RELEASE, "agent");
      asm volatile("s_waitcnt vmcnt(0)" ::: "memory");
      const unsigned og = xb_add(&bar[XB_TOP], 1u);
      const unsigned tg = og / nx;
      if (og + 1u == (tg + 1u) * nx) xb_add(&bar[XB_TOPGEN], 1u);
      else XB_SPIN(xb_ld(&bar[XB_TOPGEN]) == tg, bar);
      __builtin_amdgcn_fence(__ATOMIC_ACQUIRE, "agent");
      xb_add(&bar[XB_XGEN(b.x)], 1u);
      asm volatile("s_waitcnt vmcnt(0)" ::: "memory");
    } else {
      XB_SPIN(xb_ld(&bar[XB_XGEN(b.x)]) == gen, bar);
      __builtin_amdgcn_fence(__ATOMIC_ACQUIRE, "agent");
      asm volatile("s_waitcnt vmcnt(0)" ::: "memory");
    }
  }
  __syncthreads();
}

__device__ __forceinline__ void wt_block(const float* __restrict__ src, int ld, int K, u16* __restrict__ dst, const float* __restrict__ kscale,
                         float* lds) {
  const int t = VTID;
  for (int k0 = 0; k0 < K; k0 += 64) {
    {
      int n = t & 31, kk = t >> 5;
#pragma unroll
      for (int i = 0; i < 8; ++i) {
        int k = kk + 8 * i;
        float v = src[(size_t)(k0 + k) * ld + n];
        if (kscale) v *= kscale[k0 + k];
        lds[k * 33 + n] = v;
      }
    }
    __syncthreads();
    {
      int kp = t & 31, nn = t >> 5;
#pragma unroll
      for (int i = 0; i < 4; ++i) {
        int n = nn + 8 * i;
        unsigned v = pack2(lds[(2 * kp) * 33 + n], lds[(2 * kp + 1) * 33 + n]);
        *reinterpret_cast<unsigned*>(dst + (size_t)n * K + k0 + 2 * kp) = v;
      }
    }
    __syncthreads();
  }
}

__device__ __forceinline__ void wt_chunk(const float* __restrict__ src, int ld, int K, u16* __restrict__ dst, const float* __restrict__ kscale, float* lds, int k0) {
  const int t = VTID;
  {
    const int n = t & 31, kk = t >> 5;
    float v[32];
#pragma unroll
    for (int i = 0; i < 32; ++i) v[i] = src[(size_t)(k0 + kk + 8 * i) * ld + n];
    if (kscale) {
#pragma unroll
      for (int i = 0; i < 32; ++i) v[i] *= kscale[k0 + kk + 8 * i];
    }
#pragma unroll
    for (int i = 0; i < 32; ++i) lds[(kk + 8 * i) * 33 + n] = v[i];
  }
  __syncthreads();
  {
    const int kp = t & 127, nn = t >> 7;
#pragma unroll
    for (int i = 0; i < 16; ++i) {
      const int n = nn + 2 * i;
      *reinterpret_cast<unsigned*>(dst + (size_t)n * K + k0 + 2 * kp) = pack2(lds[(2 * kp) * 33 + n], lds[(2 * kp + 1) * 33 + n]);
    }
  }
  __syncthreads();
}

__device__ __forceinline__ void phase_prep(const Params& p, char* smem, int bid, int nb, int part) {
  float* wab = reinterpret_cast<float*>(smem);
  float* tl = reinterpret_cast<float*>(smem + 32768);
  const int t = VTID, lane = t & 63, w = t >> 6;
  for (int i = t; i < 8192; i += NTHR) wab[i] = p.w_in[(size_t)(i >> 3) * NIN + 1536 + (i & 7)];
  if (part == 0) { for (int i = bid * NTHR + t; i < TT; i += nb * NTHR) reinterpret_cast<float*>(p.ws + SM_ROWSS)[i] = 0.f; }
  __syncthreads();
  const int NWT = 384 + 384 + 64 + 64 + 128;
  const int NL = part == 0 ? 384 + 128 : 640 + 4096;
  const int lb = part == 0 ? bid : bid - 48, ln = part == 0 ? nb : nb - 48;
  for (int li = lb; li >= 0 && li < NL; li += ln) {
    const int item = part == 0 ? (li < 384 ? li : NWT + 4096 + (li - 384)) : (li < 640 ? 384 + li : NWT + (li - 640));
    if (item < NWT) {
      if (item < 384) {
        int n = (item >> 2) * 32, k0 = (item & 3) * 256;
        int col = n < 1536 ? n : 2056 + (n - 1536);
        wt_chunk(p.w_in + col, NIN, 1024, reinterpret_cast<u16*>(p.ws + W_MAIN) + (size_t)n * 1024, nullptr, tl, k0);
      } else if (item < 768) {
        int n = ((item - 384) >> 2) * 32, k0 = (item & 3) * 256;
        int col = n < 2048 ? 4104 + n : (n < 2560 ? 1544 + (n - 2048) : 3592 + (n - 2560));
        wt_chunk(p.w_in + col, NIN, 1024, reinterpret_cast<u16*>(p.ws + W_G2) + (size_t)n * 1024, nullptr, tl, k0);
      } else if (item < 832) {
        int n = ((item - 768) >> 1) * 32, k0 = (item & 1) * 256;
        wt_chunk(p.w_branch_a + n, 1024, 512, reinterpret_cast<u16*>(p.ws + W_A) + (size_t)n * 512, nullptr, tl, k0);
      } else if (item < 896) {
        int n = ((item - 832) >> 1) * 32, k0 = (item & 1) * 256;
        wt_chunk(p.w_branch_b + n, 1024, 512, reinterpret_cast<u16*>(p.ws + W_B) + (size_t)n * 512, nullptr, tl, k0);
      } else {
        int n = ((item - 896) >> 2) * 32, k0 = (item & 3) * 256;
        wt_chunk(p.w_out + n, 1024, 1024, reinterpret_cast<u16*>(p.ws + W_OUT) + (size_t)n * 1024, nullptr, tl, k0);
      }
    } else {
      int row = (item - NWT) * 4 + w;
      const float* x = row < TP ? p.x_prompt + (size_t)row * DM : p.x_sample + (size_t)(row - TP) * DM;
      float4 xv[4];
      float ss = 0.f;
#pragma unroll
      for (int i = 0; i < 4; ++i) {
        xv[i] = *reinterpret_cast<const float4*>(x + i * 256 + lane * 4);
        ss += xv[i].x * xv[i].x + xv[i].y * xv[i].y + xv[i].z * xv[i].z + xv[i].w * xv[i].w;
      }
      ss = wave_sum(ss);
      float rstd = rsqrtf(ss * (1.f / DM) + EPS);
      float dot[8];
#pragma unroll
      for (int c = 0; c < 8; ++c) dot[c] = 0.f;
      u16* hrow = reinterpret_cast<u16*>(reinterpret_cast<char*>(p.out) + YB_H) + (size_t)row * DM;
#pragma unroll
      for (int i = 0; i < 4; ++i) {
        int k = i * 256 + lane * 4;
        float4 g = *reinterpret_cast<const float4*>(p.g_attn + k);
        float h0 = xv[i].x * rstd * g.x, h1 = xv[i].y * rstd * g.y, h2 = xv[i].z * rstd * g.z, h3 = xv[i].w * rstd * g.w;
        *reinterpret_cast<uint2*>(hrow + k) = make_uint2(pack2(h0, h1), pack2(h2, h3));
        float hh[4] = {h0, h1, h2, h3};
#pragma unroll
        for (int j = 0; j < 4; ++j) {
          float4 wa = *reinterpret_cast<const float4*>(wab + (k + j) * 8);
          float4 wb = *reinterpret_cast<const float4*>(wab + (k + j) * 8 + 4);
          dot[0] += hh[j] * wa.x; dot[1] += hh[j] * wa.y; dot[2] += hh[j] * wa.z; dot[3] += hh[j] * wa.w;
          dot[4] += hh[j] * wb.x; dot[5] += hh[j] * wb.y; dot[6] += hh[j] * wb.z; dot[7] += hh[j] * wb.w;
        }
      }
#pragma unroll
      for (int c = 0; c < 8; ++c) dot[c] = wave_sum(dot[c]);
      if (lane < 4) {
        float aa = lane == 0 ? dot[0] : lane == 1 ? dot[1] : lane == 2 ? dot[2] : dot[3];
        float xx = aa + p.dt_bias[lane];
        float sp = xx > 20.f ? xx : log1pf(__expf(xx));
        reinterpret_cast<float*>(p.ws + SM_GDEC)[(size_t)row * 4 + lane] = -__expf(p.a_log[lane]) * sp;
      } else if (lane < 8) {
        float ba = lane == 4 ? dot[4] : lane == 5 ? dot[5] : lane == 6 ? dot[6] : dot[7];
        reinterpret_cast<float*>(p.ws + SM_BETA)[(size_t)row * 4 + lane - 4] = sigmoid_f(ba);
      }
    }
  }
}

enum { EPI_Z1 = 0, EPI_Z2 = 1, EPI_MIXA = 2, EPI_MIXB = 3, EPI_WOUT = 4, EPI_FFN1 = 5, EPI_FFN2 = 6, EPI_FFN2S = 7, EPI_FFN1S = 8 };
namespace pg8 {
constexpr int BM = 256, BK = 64, HALF = 128, HTB = HALF * BK * 2, STAGE_BYTES = 8 * HTB, NXCD = 8, WGM = 8;
__device__ __forceinline__ int lds_byte(int r, int c) { const int st = (r >> 4) * 2 + (c >> 5), rr = r & 15, cc = c & 31, ob = rr * 64 + cc * 2; return st * 1024 + (ob ^ (((ob >> 9) & 1) << 5)); }
__device__ __forceinline__ void stage_rc(int b, int& R, int& C) { const int st = b / 1024, sb = b % 1024, swz = sb ^ (((sb >> 9) & 1) << 5); R = (st >> 1) * 16 + swz / 64; C = (st & 1) * 32 + (swz % 64) / 2; }
__device__ __forceinline__ int perm32(int rho) { const int n = rho >> 4, i = rho & 15; return 8 * (i >> 2) + 4 * n + (i & 3); }
struct Unit { int pm, pn, ks; };
struct StaticOrder {
  int nM, nN, nwg, G, c;
  __device__ void init(int M, int N, int G_, int c_) { nM = M / BM; nN = N / BM; nwg = nM * nN; G = G_; c = c_; }
  __device__ bool next(int i, Unit& u) const {
    const long L = (long)i * G + c; if (L >= nwg) return false;
    int wgid = (int)L; { const int q = nwg / NXCD, r = nwg % NXCD, xcd = wgid % NXCD, off = wgid / NXCD; wgid = (xcd < r ? xcd * (q + 1) : r * (q + 1) + (xcd - r) * q) + off; }
    const int nig = WGM * nN, gid = wgid / nig, fm = gid * WGM, gsz = (nM - fm) < WGM ? (nM - fm) : WGM;
    u.pm = fm + ((wgid % nig) % gsz); u.pn = (wgid % nig) / gsz; return true;
  }
};
struct SchedStatic {
  StaticOrder S; int pm0;
  __device__ void init(int M, int N, int G, int c, int pm0_) { S.init(M, N, G, c); pm0 = pm0_; }
  __device__ bool next(int i, Unit& u) const { if (S.c >= S.G || !S.next(i, u)) return false; u.pm += pm0; u.ks = 0; return true; }
};
struct SchedSplit {
  int nN, nS, pm0, G, c, total;
  __device__ void init(int nM, int nN_, int nS_, int G_, int c_, int pm0_) { nN = nN_; nS = nS_; pm0 = pm0_; G = G_; c = c_; total = nM * nN_ * nS_; }
  __device__ bool next(int i, Unit& u) const {
    const int L = i * G + c; if (c >= G || L >= total) return false;
    u.ks = L % nS; const int t = L / nS; u.pn = t % nN; u.pm = pm0 + t / nN; return true;
  }
};
}

__device__ __forceinline__ float dpp_ror1(float v) { return __int_as_float(__builtin_amdgcn_update_dpp(0, __float_as_int(v), 0x121, 0xf, 0xf, false)); }
__device__ __forceinline__ float dpp_ror2(float v) { return __int_as_float(__builtin_amdgcn_update_dpp(0, __float_as_int(v), 0x122, 0xf, 0xf, false)); }

template <int MODE>
__device__ __forceinline__ void gemm_epilogue(const Params& p, f32x4 (&acc)[2][2][4][2], const pg8::Unit& u, int wr, int wc, int fr, int fq) {
  const int row0 = u.pm * 256 + wr * 64 + fr, col0 = u.pn * 256 + wc * 32 + 8 * fq;
  if constexpr (MODE == EPI_Z1 || MODE == EPI_Z2) {
#pragma unroll
    for (int ai = 0; ai < 2; ++ai)
#pragma unroll
      for (int m = 0; m < 4; ++m) {
        const int row = row0 + ai * 128 + m * 16;
        u16* rowp = (MODE == EPI_Z1 ? reinterpret_cast<u16*>(p.ws + Z1) + (size_t)row * 3072 : const_cast<u16*>(z2row(p, row))) + col0;
#pragma unroll
        for (int bj = 0; bj < 2; ++bj) {
          const f32x4 v0 = acc[ai][bj][m][0], v1 = acc[ai][bj][m][1];
          *reinterpret_cast<uint4*>(rowp + bj * 128) = make_uint4(pack2(v0[0], v0[1]), pack2(v0[2], v0[3]), pack2(v1[0], v1[1]), pack2(v1[2], v1[3]));
        }
        if (MODE == EPI_Z1 && u.pn < 6) {
          float* dst = nullptr;
          if (row < TP) {
            int pos = row & 2047;
            if (pos >= 2045) dst = p.out + O_CONVP + (size_t)((row >> 11) * 3 + pos - 2045) * 1536 + col0;
          } else {
            int pos = (row - TP) & 3;
            if (pos >= 1) dst = p.out + O_CONVS + (size_t)(((row - TP) >> 2) * 3 + pos - 1) * 1536 + col0;
          }
          if (dst) {
#pragma unroll
            for (int bj = 0; bj < 2; ++bj) {
              const f32x4 v0 = acc[ai][bj][m][0], v1 = acc[ai][bj][m][1];
              *reinterpret_cast<float4*>(dst + bj * 128) = make_float4(v0[0], v0[1], v0[2], v0[3]);
              *reinterpret_cast<float4*>(dst + bj * 128 + 4) = make_float4(v1[0], v1[1], v1[2], v1[3]);
            }
          }
        }
      }
  } else if constexpr (MODE == EPI_MIXA || MODE == EPI_MIXB) {
    u16* Mx = reinterpret_cast<u16*>(p.ws + MIX);
#pragma unroll
    for (int ai = 0; ai < 2; ++ai)
#pragma unroll
      for (int m = 0; m < 4; ++m) {
        const int row = row0 + ai * 128 + m * 16;
#pragma unroll
        for (int bj = 0; bj < 2; ++bj) {
          const int col = col0 + bj * 128;
          const uint4 gv = *reinterpret_cast<const uint4*>(z2row(p, row) + (MODE == EPI_MIXB ? 1024 : 0) + col);
          u16* mp = Mx + (size_t)row * 1024 + col;
          const f32x4 v0 = acc[ai][bj][m][0], v1 = acc[ai][bj][m][1];
          float r0 = v0[0] * sigmoid_f(lo2f(gv.x)), r1 = v0[1] * sigmoid_f(hi2f(gv.x));
          float r2 = v0[2] * sigmoid_f(lo2f(gv.y)), r3 = v0[3] * sigmoid_f(hi2f(gv.y));
          float r4 = v1[0] * sigmoid_f(lo2f(gv.z)), r5 = v1[1] * sigmoid_f(hi2f(gv.z));
          float r6 = v1[2] * sigmoid_f(lo2f(gv.w)), r7 = v1[3] * sigmoid_f(hi2f(gv.w));
          if (MODE == EPI_MIXB) {
            const uint4 mv = *reinterpret_cast<const uint4*>(mp);
            r0 += lo2f(mv.x); r1 += hi2f(mv.x); r2 += lo2f(mv.y); r3 += hi2f(mv.y);
            r4 += lo2f(mv.z); r5 += hi2f(mv.z); r6 += lo2f(mv.w); r7 += hi2f(mv.w);
          }
          *reinterpret_cast<uint4*>(mp) = make_uint4(pack2(r0, r1), pack2(r2, r3), pack2(r4, r5), pack2(r6, r7));
        }
        asm volatile("" ::: "memory");
      }
  } else if constexpr (MODE == EPI_WOUT) {
    float* rowss = reinterpret_cast<float*>(p.ws + SM_ROWSS);
    u16* XB = reinterpret_cast<u16*>(p.ws + X1B);
#pragma unroll
    for (int ai = 0; ai < 2; ++ai)
#pragma unroll
      for (int m = 0; m < 4; ++m) {
        const int row = row0 + ai * 128 + m * 16;
        const float* x = (row < TP ? p.x_prompt + (size_t)row * DM : p.x_sample + (size_t)(row - TP) * DM) + col0;
        float* y = p.out + O_YP + (size_t)row * DM + col0;
        float ss = 0.f;
#pragma unroll
        for (int bj = 0; bj < 2; ++bj) {
          const float4 x0 = *reinterpret_cast<const float4*>(x + bj * 128), x1 = *reinterpret_cast<const float4*>(x + bj * 128 + 4);
          const f32x4 a0 = acc[ai][bj][m][0], a1 = acc[ai][bj][m][1];
          const float4 v0 = make_float4(a0[0] + x0.x, a0[1] + x0.y, a0[2] + x0.z, a0[3] + x0.w);
          const float4 v1 = make_float4(a1[0] + x1.x, a1[1] + x1.y, a1[2] + x1.z, a1[3] + x1.w);
          *reinterpret_cast<float4*>(y + bj * 128) = v0;
          *reinterpret_cast<float4*>(y + bj * 128 + 4) = v1;
          *reinterpret_cast<uint4*>(XB + (size_t)row * DM + col0 + bj * 128) =
              make_uint4(pack2(v0.x, v0.y), pack2(v0.z, v0.w), pack2(v1.x, v1.y), pack2(v1.z, v1.w));
          ss += v0.x * v0.x + v0.y * v0.y + v0.z * v0.z + v0.w * v0.w + v1.x * v1.x + v1.y * v1.y + v1.z * v1.z + v1.w * v1.w;
        }
        ss += __shfl_xor(ss, 16, 64);
        ss += __shfl_xor(ss, 32, 64);
        if (fq == 0) atomicAdd(rowss + row, ss);
        asm volatile("" ::: "memory");
      }
  } else if constexpr (MODE == EPI_FFN2) {
#pragma unroll
    for (int ai = 0; ai < 2; ++ai)
#pragma unroll
      for (int m = 0; m < 4; ++m) {
        float* y = p.out + O_YP + (size_t)(row0 + ai * 128 + m * 16) * DM + col0;
#pragma unroll
        for (int bj = 0; bj < 2; ++bj) {
          float4 y0 = *reinterpret_cast<const float4*>(y + bj * 128), y1 = *reinterpret_cast<const float4*>(y + bj * 128 + 4);
          const f32x4 a0 = acc[ai][bj][m][0], a1 = acc[ai][bj][m][1];
          y0.x += a0[0]; y0.y += a0[1]; y0.z += a0[2]; y0.w += a0[3];
          y1.x += a1[0]; y1.y += a1[1]; y1.z += a1[2]; y1.w += a1[3];
          *reinterpret_cast<float4*>(y + bj * 128) = y0;
          *reinterpret_cast<float4*>(y + bj * 128 + 4) = y1;
        }
        asm volatile("" ::: "memory");
      }
  } else if constexpr (MODE == EPI_FFN2S) {
    float* part = reinterpret_cast<float*>(p.ws + PART) + (size_t)u.ks * TS * 1024;
#pragma unroll
    for (int ai = 0; ai < 2; ++ai)
#pragma unroll
      for (int m = 0; m < 4; ++m) {
        float* y = part + (size_t)(row0 + ai * 128 + m * 16 - TP) * 1024 + col0;
#pragma unroll
        for (int bj = 0; bj < 2; ++bj) {
          const f32x4 a0 = acc[ai][bj][m][0], a1 = acc[ai][bj][m][1];
          *reinterpret_cast<float4*>(y + bj * 128) = make_float4(a0[0], a0[1], a0[2], a0[3]);
          *reinterpret_cast<float4*>(y + bj * 128 + 4) = make_float4(a1[0], a1[1], a1[2], a1[3]);
        }
      }
  } else if constexpr (MODE == EPI_FFN1 || MODE == EPI_FFN1S) {
    const float* rowss = reinterpret_cast<const float*>(p.ws + SM_ROWSS);
    u16* ACTp = reinterpret_cast<u16*>(p.ws + ACT);
    float* haloG = reinterpret_cast<float*>(p.ws + HALO_G);
    float* headG = reinterpret_cast<float*>(p.ws + HEAD_G);
    float* headU = reinterpret_cast<float*>(p.ws + HEAD_U);
    const int ch = u.pn * 128 + wc * 32 + 8 * fq;
    float w0[8], w1[8], w2[8];
#pragma unroll
    for (int c = 0; c < 8; ++c) { w0[c] = p.w_ffn_conv[ch + c]; w1[c] = p.w_ffn_conv[DFF + ch + c]; w2[c] = p.w_ffn_conv[2 * DFF + ch + c]; }
    if constexpr (MODE == EPI_FFN1) {
#pragma unroll
      for (int ai = 0; ai < 2; ++ai) {
        const int blk = u.pm * 4 + ai * 2 + wr;
        const bool seqstart = (blk & 31) == 0, seqend = (blk & 31) == 31;
        float gprev[8];
#pragma unroll
        for (int c = 0; c < 8; ++c) gprev[c] = 0.f;
#pragma unroll
        for (int m = 0; m < 4; ++m) {
          const int row = row0 + ai * 128 + m * 16;
          const float rs = rsqrtf(rowss[row] * (1.f / DM) + EPS);
          float g0[8], uu[8];
#pragma unroll
          for (int c = 0; c < 4; ++c) {
            g0[c] = acc[ai][0][m][0][c] * rs; g0[4 + c] = acc[ai][0][m][1][c] * rs;
            uu[c] = acc[ai][1][m][0][c] * rs; uu[4 + c] = acc[ai][1][m][1][c] * rs;
          }
          float r[8];
#pragma unroll
          for (int c = 0; c < 8; ++c) {
            float gm1 = __int_as_float(__builtin_amdgcn_update_dpp(__float_as_int(dpp_ror1(gprev[c])), __float_as_int(g0[c]), 0x111, 0xf, 0xf, false));
            float gm2 = __int_as_float(__builtin_amdgcn_update_dpp(__float_as_int(dpp_ror2(gprev[c])), __float_as_int(g0[c]), 0x112, 0xf, 0xf, false));
            r[c] = silu_f(w0[c] * gm2 + w1[c] * gm1 + w2[c] * g0[c]) * uu[c];
          }
          bool defer = false;
          if (m == 0) {
            defer = !seqstart && fr < 2;
            if (defer) {
              float* dg = headG + (size_t)(blk * 2 + fr) * DFF + ch;
              float* du = headU + (size_t)(blk * 2 + fr) * DFF + ch;
              *reinterpret_cast<float4*>(dg) = make_float4(g0[0], g0[1], g0[2], g0[3]);
              *reinterpret_cast<float4*>(dg + 4) = make_float4(g0[4], g0[5], g0[6], g0[7]);
              *reinterpret_cast<float4*>(du) = make_float4(uu[0], uu[1], uu[2], uu[3]);
              *reinterpret_cast<float4*>(du + 4) = make_float4(uu[4], uu[5], uu[6], uu[7]);
            }
          }
          if (m == 3) {
            if (fr >= 14) {
              float* d = haloG + (size_t)(blk * 2 + fr - 14) * DFF + ch;
              *reinterpret_cast<float4*>(d) = make_float4(g0[0], g0[1], g0[2], g0[3]);
              *reinterpret_cast<float4*>(d + 4) = make_float4(g0[4], g0[5], g0[6], g0[7]);
              if (seqend) {
                float* o = p.out + O_FFNP + (size_t)((row >> 11) * 2 + fr - 14) * DFF + ch;
                *reinterpret_cast<float4*>(o) = make_float4(g0[0], g0[1], g0[2], g0[3]);
                *reinterpret_cast<float4*>(o + 4) = make_float4(g0[4], g0[5], g0[6], g0[7]);
              }
            }
          }
          if (!defer)
            *reinterpret_cast<uint4*>(ACTp + (size_t)row * DFF + ch) = make_uint4(pack2(r[0], r[1]), pack2(r[2], r[3]), pack2(r[4], r[5]), pack2(r[6], r[7]));
#pragma unroll
          for (int c = 0; c < 8; ++c) gprev[c] = g0[c];
          asm volatile("" ::: "memory");
        }
      }
    } else {
#pragma unroll
    for (int ai = 0; ai < 2; ++ai) {
      const int blk = u.pm * 4 + ai * 2 + wr;
      float gprev[8];
#pragma unroll
      for (int c = 0; c < 8; ++c) gprev[c] = 0.f;
#pragma unroll
      for (int m = 0; m < 4; ++m) {
        const int row = row0 + ai * 128 + m * 16;
        const int r64 = m * 16 + fr;
        const float rs = rsqrtf(rowss[row] * (1.f / DM) + EPS);
        float g0[8], uu[8];
#pragma unroll
        for (int c = 0; c < 4; ++c) {
          g0[c] = acc[ai][0][m][0][c] * rs; g0[4 + c] = acc[ai][0][m][1][c] * rs;
          uu[c] = acc[ai][1][m][0][c] * rs; uu[4 + c] = acc[ai][1][m][1][c] * rs;
        }
        const bool prompt = row < TP;
        int pos, b;
        if (prompt) { pos = row & 2047; b = row >> 11; } else { pos = (row - TP) & 3; b = (row - TP) >> 2; }
        const bool defer = (pos >= 1 && r64 < 1) || (pos >= 2 && r64 < 2);
        float gm1[8], gm2[8];
#pragma unroll
        for (int c = 0; c < 8; ++c) {
          gm1[c] = __int_as_float(__builtin_amdgcn_update_dpp(__float_as_int(dpp_ror1(gprev[c])), __float_as_int(g0[c]), 0x111, 0xf, 0xf, false));
          gm2[c] = __int_as_float(__builtin_amdgcn_update_dpp(__float_as_int(dpp_ror2(gprev[c])), __float_as_int(g0[c]), 0x112, 0xf, 0xf, false));
        }
        if (pos < 1) {
#pragma unroll
          for (int c = 0; c < 8; ++c) gm1[c] = prompt ? 0.f : p.cache_ffn[(size_t)(b * 2 + 1) * DFF + ch + c];
        }
        if (pos < 2) {
#pragma unroll
          for (int c = 0; c < 8; ++c) gm2[c] = prompt ? 0.f : p.cache_ffn[(size_t)(b * 2 + pos) * DFF + ch + c];
        }
        if (r64 >= 62) {
          float* d = haloG + (size_t)(blk * 2 + r64 - 62) * DFF + ch;
          *reinterpret_cast<float4*>(d) = make_float4(g0[0], g0[1], g0[2], g0[3]);
          *reinterpret_cast<float4*>(d + 4) = make_float4(g0[4], g0[5], g0[6], g0[7]);
        }
        {
          float* d = nullptr;
          if (prompt) { if (pos >= 2046) d = p.out + O_FFNP + (size_t)(b * 2 + pos - 2046) * DFF + ch; }
          else { if (pos >= 2) d = p.out + O_FFNS + (size_t)(b * 2 + pos - 2) * DFF + ch; }
          if (d) {
            *reinterpret_cast<float4*>(d) = make_float4(g0[0], g0[1], g0[2], g0[3]);
            *reinterpret_cast<float4*>(d + 4) = make_float4(g0[4], g0[5], g0[6], g0[7]);
          }
        }
        if (defer) {
          float* dg = headG + (size_t)(blk * 2 + r64) * DFF + ch;
          float* du = headU + (size_t)(blk * 2 + r64) * DFF + ch;
          *reinterpret_cast<float4*>(dg) = make_float4(g0[0], g0[1], g0[2], g0[3]);
          *reinterpret_cast<float4*>(dg + 4) = make_float4(g0[4], g0[5], g0[6], g0[7]);
          *reinterpret_cast<float4*>(du) = make_float4(uu[0], uu[1], uu[2], uu[3]);
          *reinterpret_cast<float4*>(du + 4) = make_float4(uu[4], uu[5], uu[6], uu[7]);
        } else {
          float r[8];
#pragma unroll
          for (int c = 0; c < 8; ++c) r[c] = silu_f(w0[c] * gm2[c] + w1[c] * gm1[c] + w2[c] * g0[c]) * uu[c];
          *reinterpret_cast<uint4*>(ACTp + (size_t)row * DFF + ch) = make_uint4(pack2(r[0], r[1]), pack2(r[2], r[3]), pack2(r[4], r[5]), pack2(r[6], r[7]));
        }
#pragma unroll
        for (int c = 0; c < 8; ++c) gprev[c] = g0[c];
        asm volatile("" ::: "memory");
      }
    }
    }
  }
}

template <int MODE, class Sched>
__device__ __forceinline__ void gemm_phase8(const Params& p, const u16* Ag, const u16* Btg, int ld, int Kunit, LAS unsigned char* lds, const Sched& S) {
  using namespace pg8;
  const int tid = threadIdx.x, wid = __builtin_amdgcn_readfirstlane(tid >> 6), lane = tid & 63, wr = wid >> 2, wc = wid & 3, fr = lane & 15, fq = lane >> 4;
  const int nt = Kunit / BK;
  unsigned voffA[2], voffB[2];
#pragma unroll
  for (int i = 0; i < 2; ++i) { int R, C; stage_rc(tid * 16 + i * 8192, R, C); const int Rb = (R & ~31) + perm32(R & 31);
    voffA[i] = (unsigned)(R * ld + C) * 2u; voffB[i] = (unsigned)(Rb * ld + C) * 2u; }
  const size_t kstep = (size_t)(BK * 2);
  const size_t hstep = (size_t)HALF * ld * 2;
  const size_t tstep = 2 * hstep;
  const size_t kub = (size_t)Kunit * 2;
  const unsigned ldsw = (unsigned)wid * 1024u;
  const int aoff = lds_byte(wr * 64 + fr, fq * 8), boff = lds_byte(wc * 32 + fr, fq * 8);
#define PG8_SA(b, h) (((b) * 2 + (h)) * HTB)
#define PG8_SB(b, h) ((4 + (b) * 2 + (h)) * HTB)
#define PG8_STAGE(bufoff, gbase, voff) do { _Pragma("unroll") for (int _i = 0; _i < 2; ++_i) \
    __builtin_amdgcn_global_load_lds((const unsigned*)((const char*)(gbase) + (voff)[_i]), (LAS unsigned*)(lds + (bufoff) + ldsw + _i * 8192), 16, 0, 0); } while (0)
#define PG8_LDA(dst, b, h) do { _Pragma("unroll") for (int m = 0; m < 4; ++m) _Pragma("unroll") for (int k = 0; k < 2; ++k) dst[m][k] = *(const LAS bf16x8*)(lds + PG8_SA(b, h) + aoff + m * 2048 + k * 1024); } while (0)
#define PG8_LDB(dst, b, h) do { _Pragma("unroll") for (int n = 0; n < 2; ++n) _Pragma("unroll") for (int k = 0; k < 2; ++k) dst[n][k] = *(const LAS bf16x8*)(lds + PG8_SB(b, h) + boff + n * 2048 + k * 1024); } while (0)
#define PG8_MMA(ai, bj, At, Bt) do { __builtin_amdgcn_s_setprio(1); _Pragma("unroll") for (int m = 0; m < 4; ++m) _Pragma("unroll") for (int n = 0; n < 2; ++n) _Pragma("unroll") for (int k = 0; k < 2; ++k) \
    acc[ai][bj][m][n] = __builtin_amdgcn_mfma_f32_16x16x32_bf16(Bt[n][k], At[m][k], acc[ai][bj][m][n], 0, 0, 0); __builtin_amdgcn_s_setprio(0); } while (0)
#define PG8_WAIT_V(n) asm volatile("s_waitcnt vmcnt(" #n ")" ::: "memory")
#define PG8_WAIT_L(n) asm volatile("s_waitcnt lgkmcnt(" #n ")" ::: "memory")
#define PG8_BAR __builtin_amdgcn_s_barrier()
#define PG8_SCHED __builtin_amdgcn_sched_barrier(0)
  Unit cur, nxt; int ui = 0;
  if (!S.next(0, cur)) return;
  f32x4 acc[2][2][4][2];
#pragma unroll
  for (int a = 0; a < 2; ++a)
#pragma unroll
    for (int b = 0; b < 2; ++b)
#pragma unroll
      for (int m = 0; m < 4; ++m)
#pragma unroll
        for (int n = 0; n < 2; ++n) acc[a][b][m][n] = (f32x4){0.f, 0.f, 0.f, 0.f};
  bf16x8 At[4][2], B0[2][2], B1[2][2];
  const char* cA = (const char*)Ag + (size_t)cur.pm * tstep + cur.ks * kub; const char* cB = (const char*)Btg + (size_t)cur.pn * tstep + cur.ks * kub;
  PG8_STAGE(PG8_SB(0, 0), cB, voffB); PG8_STAGE(PG8_SA(0, 0), cA, voffA); PG8_STAGE(PG8_SB(0, 1), cB + hstep, voffB); PG8_STAGE(PG8_SA(0, 1), cA + hstep, voffA);
  if (wr == 1) PG8_BAR;
  PG8_WAIT_V(4); PG8_BAR;
  PG8_STAGE(PG8_SB(1, 0), cB + kstep, voffB); PG8_STAGE(PG8_SA(1, 0), cA + kstep, voffA); PG8_STAGE(PG8_SB(1, 1), cB + hstep + kstep, voffB);
  PG8_WAIT_V(6); PG8_BAR;
  for (;;) {
    const bool has_next = S.next(ui + 1, nxt);
    const char* nA = has_next ? (const char*)Ag + (size_t)nxt.pm * tstep + nxt.ks * kub : cA; const char* nB = has_next ? (const char*)Btg + (size_t)nxt.pn * tstep + nxt.ks * kub : cB;
    for (int t = 0; t < nt; t += 2) {
      const bool last = (t == nt - 2);
      const char* a1 = cA + (size_t)(t + 1) * kstep;
      const char* a2 = last ? nA : cA + (size_t)(t + 2) * kstep; const char* b2 = last ? nB : cB + (size_t)(t + 2) * kstep;
      const char* a3 = a2 + kstep; const char* b3 = b2 + kstep;
      PG8_LDB(B0, 0, 0); PG8_SCHED; PG8_LDA(At, 0, 0); PG8_STAGE(PG8_SA(1, 1), a1 + hstep, voffA);
      PG8_WAIT_L(8); PG8_BAR; PG8_WAIT_L(0); PG8_MMA(0, 0, At, B0); PG8_BAR; PG8_SCHED;
      PG8_LDB(B1, 0, 1); PG8_STAGE(PG8_SB(0, 0), b2, voffB);
      PG8_BAR; PG8_WAIT_L(0); PG8_MMA(0, 1, At, B1); PG8_BAR;
      PG8_LDA(At, 0, 1); PG8_STAGE(PG8_SA(0, 0), a2, voffA);
      PG8_BAR; PG8_WAIT_L(0); PG8_MMA(1, 0, At, B0); PG8_BAR; PG8_SCHED;
      PG8_STAGE(PG8_SB(0, 1), b2 + hstep, voffB);
      PG8_WAIT_V(6); PG8_BAR; PG8_MMA(1, 1, At, B1); PG8_BAR;
      PG8_LDB(B0, 1, 0); PG8_SCHED; PG8_LDA(At, 1, 0); PG8_STAGE(PG8_SA(0, 1), a2 + hstep, voffA);
      PG8_WAIT_L(8); PG8_BAR; PG8_WAIT_L(0); PG8_MMA(0, 0, At, B0); PG8_BAR; PG8_SCHED;
      PG8_LDB(B1, 1, 1); PG8_STAGE(PG8_SB(1, 0), b3, voffB);
      PG8_BAR; PG8_WAIT_L(0); PG8_MMA(0, 1, At, B1); PG8_BAR;
      PG8_LDA(At, 1, 1); PG8_STAGE(PG8_SA(1, 0), a3, voffA);
      PG8_BAR; PG8_WAIT_L(0); PG8_MMA(1, 0, At, B0); PG8_BAR; PG8_SCHED;
      PG8_STAGE(PG8_SB(1, 1), b3 + hstep, voffB);
      PG8_WAIT_V(6); PG8_BAR; PG8_MMA(1, 1, At, B1); PG8_BAR;
    }
    gemm_epilogue<MODE>(p, acc, cur, wr, wc, fr, fq);
    if (!has_next) break;
#pragma unroll
    for (int a = 0; a < 2; ++a)
#pragma unroll
      for (int b = 0; b < 2; ++b)
#pragma unroll
        for (int m = 0; m < 4; ++m)
#pragma unroll
          for (int n = 0; n < 2; ++n) acc[a][b][m][n] = (f32x4){0.f, 0.f, 0.f, 0.f};
    cur = nxt; cA = nA; cB = nB; ++ui;
  }
  PG8_WAIT_V(0);
  if (wr == 0) PG8_BAR;
  PG8_BAR;
#undef PG8_SA
#undef PG8_SB
#undef PG8_STAGE
#undef PG8_LDA
#undef PG8_LDB
#undef PG8_MMA
#undef PG8_WAIT_V
#undef PG8_WAIT_L
#undef PG8_BAR
#undef PG8_SCHED
}


template <int PASS>
__device__ __forceinline__ void delta_rowpass(const Params& p, int t0, int n, int h, int w, int lane, float Gv, u16* RA, u16* RBk,
                                              u16* RC) {
  const u16* Zp = reinterpret_cast<const u16*>(p.ws + Z1);
  const float* betap = reinterpret_cast<const float*>(p.ws + SM_BETA);
  const int c1 = (PASS == 0 ? 0 : 512) + h * 128 + 2 * lane;
  const int c2 = (PASS == 0 ? 512 : 1024) + h * 128 + 2 * lane;
  float w1[4][2], w2[4][2];
#pragma unroll
  for (int j = 0; j < 4; ++j) {
    w1[j][0] = p.w_conv_a[j * 1536 + c1]; w1[j][1] = p.w_conv_a[j * 1536 + c1 + 1];
    w2[j][0] = p.w_conv_a[j * 1536 + c2]; w2[j][1] = p.w_conv_a[j * 1536 + c2 + 1];
  }
  const int r0 = 16 * w;
  const u16* zbase = Zp + (size_t)(t0 + r0) * 3072;
  float h1[3][2], h2[3][2];
#pragma unroll
  for (int j = 0; j < 3; ++j) {
    unsigned ua = 0u, ub = 0u;
    if (n * 64 + r0 + j - 3 >= 0) {
      ua = *reinterpret_cast<const unsigned*>(zbase + (ptrdiff_t)(j - 3) * 3072 + c1);
      ub = *reinterpret_cast<const unsigned*>(zbase + (ptrdiff_t)(j - 3) * 3072 + c2);
    }
    h1[j][0] = lo2f(ua); h1[j][1] = hi2f(ua); h2[j][0] = lo2f(ub); h2[j][1] = hi2f(ub);
  }
  unsigned qa0, qa1, qa2, qa3, qa4, qa5, qb0, qb1, qb2, qb3, qb4, qb5;
#define RLOAD(i, A_, B_) A_ = *reinterpret_cast<const unsigned*>(zbase + (size_t)(i) * 3072 + c1); B_ = *reinterpret_cast<const unsigned*>(zbase + (size_t)(i) * 3072 + c2);
  RLOAD(0, qa0, qb0) RLOAD(1, qa1, qb1) RLOAD(2, qa2, qb2) RLOAD(3, qa3, qb3) RLOAD(4, qa4, qb4) RLOAD(5, qa5, qb5)
#pragma unroll 1
  for (int rr = 0; rr < 16; ++rr) {
    const int r = r0 + rr;
    const unsigned ua = qa0, ub = qb0;
    qa0 = qa1; qa1 = qa2; qa2 = qa3; qa3 = qa4; qa4 = qa5;
    qb0 = qb1; qb1 = qb2; qb2 = qb3; qb3 = qb4; qb4 = qb5;
    if (rr + 6 < 16) { RLOAD(rr + 6, qa5, qb5) }
    const float a0 = lo2f(ua), a1 = hi2f(ua), b0 = lo2f(ub), b1 = hi2f(ub);
    float y10 = silu_f(w1[0][0] * h1[0][0] + w1[1][0] * h1[1][0] + w1[2][0] * h1[2][0] + w1[3][0] * a0);
    float y11 = silu_f(w1[0][1] * h1[0][1] + w1[1][1] * h1[1][1] + w1[2][1] * h1[2][1] + w1[3][1] * a1);
    float y20 = silu_f(w2[0][0] * h2[0][0] + w2[1][0] * h2[1][0] + w2[2][0] * h2[2][0] + w2[3][0] * b0);
    float y21 = silu_f(w2[0][1] * h2[0][1] + w2[1][1] * h2[1][1] + w2[2][1] * h2[2][1] + w2[3][1] * b1);
    const float bt = betap[(size_t)(t0 + r) * 4 + h];
    if (PASS == 0) {
      float qs = wave_sum(y10 * y10 + y11 * y11), ks = wave_sum(y20 * y20 + y21 * y21);
      float qn = rsqrtf(qs + EPS) * 0.08838834764831845f, kn = rsqrtf(ks + EPS);
      float k0 = y20 * kn, k1 = y21 * kn;
      *reinterpret_cast<unsigned*>(RA + r * 136 + 2 * lane) = pack2(k0, k1);
      *reinterpret_cast<unsigned*>(RBk + r * 136 + 2 * lane) = pack2(k0 * bt, k1 * bt);
      *reinterpret_cast<unsigned*>(RC + r * 136 + 2 * lane) = pack2(y10 * qn, y11 * qn);
    } else {
      float ks = wave_sum(y10 * y10 + y11 * y11);
      float sc = rsqrtf(ks + EPS) * bt * __expf(__shfl(Gv, r, 64));
      RA[(2 * lane) * 72 + r] = f2bf(y10 * sc);
      RA[(2 * lane + 1) * 72 + r] = f2bf(y11 * sc);
      RC[(2 * lane) * 72 + r] = f2bf(y20 * bt);
      RC[(2 * lane + 1) * 72 + r] = f2bf(y21 * bt);
    }
#pragma unroll
    for (int c = 0; c < 2; ++c) {
      h1[0][c] = h1[1][c]; h1[1][c] = h1[2][c];
      h2[0][c] = h2[1][c]; h2[1][c] = h2[2][c];
    }
    h1[2][0] = a0; h1[2][1] = a1; h2[2][0] = b0; h2[2][1] = b1;
  }
#undef RLOAD
}

__device__ __forceinline__ void m1_delta_item(const Params& p, int item, char* smem) {
  const int tid = VTID, lane = tid & 63, w = tid >> 6, lr = lane & 15, lq = lane >> 4;
  const int h = item & 3, n = (item >> 2) & 31, b = item >> 7;
  const int t0 = b * 2048 + n * 64;
  u16* RA = reinterpret_cast<u16*>(smem);
  u16* RBk = reinterpret_cast<u16*>(smem + 18432);
  u16* RC = reinterpret_cast<u16*>(smem + 36864);
  u16* RD = reinterpret_cast<u16*>(smem + 55296);
  float* Gs = reinterpret_cast<float*>(smem + 73728);
  const float* gdec = reinterpret_cast<const float*>(p.ws + SM_GDEC);

  float Gv = gdec[(size_t)(t0 + lane) * 4 + h];
#pragma unroll
  for (int o = 1; o < 64; o <<= 1) {
    float tv = __shfl_up(Gv, o, 64);
    if (lane >= o) Gv += tv;
  }
  if (w == 0) {
    Gs[lane] = Gv;
    reinterpret_cast<float*>(p.ws + D_GC)[(size_t)item * 64 + lane] = Gv;
  }
  delta_rowpass<0>(p, t0, n, h, w, lane, Gv, RA, RBk, RC);
  __syncthreads();
  {
    f32x4 accL[4], accA[4];
#pragma unroll
    for (int jb = 0; jb < 4; ++jb) { accL[jb] = (f32x4){0.f, 0.f, 0.f, 0.f}; accA[jb] = (f32x4){0.f, 0.f, 0.f, 0.f}; }
#pragma unroll
    for (int ks = 0; ks < 4; ++ks) {
      bf16x8 a1 = lds_frag(RBk, 136, 16 * w, ks * 32, lane);
      bf16x8 a2 = lds_frag(RC, 136, 16 * w, ks * 32, lane);
#pragma unroll
      for (int jb = 0; jb < 4; ++jb) {
        if (jb <= w) {
          bf16x8 bb = lds_frag(RA, 136, 16 * jb, ks * 32, lane);
          accL[jb] = mfma16(a1, bb, accL[jb]);
          accA[jb] = mfma16(a2, bb, accA[jb]);
        }
      }
    }
    __syncthreads();
    float* Lm = reinterpret_cast<float*>(RBk);
#pragma unroll
    for (int jb = 0; jb < 4; ++jb)
#pragma unroll
      for (int j = 0; j < 4; ++j) {
        int i = 16 * w + 4 * lq + j, jj = jb * 16 + lr;
        float dec = __expf(fminf(Gs[i] - Gs[jj], 0.f));
        float lv = (i > jj) ? accL[jb][j] * dec : 0.f;
        float av = (i >= jj) ? accA[jb][j] * dec : 0.f;
        Lm[i * 64 + jj] = lv;
        RD[i * 72 + jj] = f2bf(av);
      }
  }
  __syncthreads();
  store_frags(RC, 136, 64, 128, reinterpret_cast<u16*>(p.ws + D_QF) + (size_t)item * 8192, tid, NTHR);
  store_frags(RD, 72, 64, 64, reinterpret_cast<u16*>(p.ws + D_ATT) + (size_t)item * 4096, tid, NTHR);
  store_frags_T(RA, 136, 128, 64, reinterpret_cast<u16*>(p.ws + D_KNT) + (size_t)item * 8192, tid, NTHR);
  __syncthreads();
  {
    const float* Lm = reinterpret_cast<const float*>(RBk);
    float* Tm = reinterpret_cast<float*>(RA);
    float* Ms = reinterpret_cast<float*>(RC) + w * 256;
    {
      const int c = lane & 15, i0 = 16 * w;
      float tc[16];
#pragma unroll
      for (int r = 0; r < 16; ++r) {
        float a = (r == c) ? 1.f : 0.f;
#pragma unroll
        for (int k = 0; k < r; ++k) a -= Lm[(i0 + r) * 64 + i0 + k] * tc[k];
        tc[r] = a;
      }
      if (lane < 16) {
#pragma unroll
        for (int r = 0; r < 16; ++r) Tm[(i0 + r) * 64 + i0 + c] = tc[r];
      }
    }
    __syncthreads();
    {
      const int j = w;
      for (int i = j + 1; i < 4; ++i) {
        f32x4 macc = (f32x4){0.f, 0.f, 0.f, 0.f};
        for (int k = j; k < i; ++k) {
#pragma unroll
          for (int ks = 0; ks < 4; ++ks) {
            float av = Lm[(16 * i + lr) * 64 + 16 * k + 4 * ks + lq];
            float bv = Tm[(16 * k + 4 * ks + lq) * 64 + 16 * j + lr];
            macc = __builtin_amdgcn_mfma_f32_16x16x4f32(av, bv, macc, 0, 0, 0);
          }
        }
#pragma unroll
        for (int r = 0; r < 4; ++r) Ms[(4 * lq + r) * 16 + lr] = macc[r];
        __builtin_amdgcn_wave_barrier();
        f32x4 tacc = (f32x4){0.f, 0.f, 0.f, 0.f};
#pragma unroll
        for (int ks = 0; ks < 4; ++ks) {
          float av = Tm[(16 * i + lr) * 64 + 16 * i + 4 * ks + lq];
          float bv = Ms[(4 * ks + lq) * 16 + lr];
          tacc = __builtin_amdgcn_mfma_f32_16x16x4f32(av, bv, tacc, 0, 0, 0);
        }
#pragma unroll
        for (int r = 0; r < 4; ++r) Tm[(16 * i + 4 * lq + r) * 64 + 16 * j + lr] = -tacc[r];
        __builtin_amdgcn_wave_barrier();
      }
    }
    __syncthreads();
    {
      u16* Tb = RD + 64 * 72;
      for (int idx = tid; idx < 4096; idx += NTHR) {
        int r = idx >> 6, c = idx & 63;
        float v = ((c >> 4) <= (r >> 4)) ? Tm[idx] : 0.f;
        Tb[r * 72 + c] = f2bf(v);
      }
    }
    __syncthreads();
  }
  delta_rowpass<1>(p, t0, n, h, w, lane, Gv, RA, RBk, RC);
  __syncthreads();
  {
    const u16* Tm = RD + 64 * 72;
    bf16x8 tf[4][2];
#pragma unroll
    for (int cb = 0; cb < 4; ++cb)
#pragma unroll
      for (int ks = 0; ks < 2; ++ks) tf[cb][ks] = lds_frag(Tm, 72, cb * 16, ks * 32, lane);
    u16* valt = reinterpret_cast<u16*>(p.ws + D_VALT) + (size_t)item * 8192;
#pragma unroll
    for (int ee = 0; ee < 2; ++ee) {
      int eb = 2 * w + ee;
      bf16x8 a0 = lds_frag(RC, 72, eb * 16, 0, lane), a1 = lds_frag(RC, 72, eb * 16, 32, lane);
#pragma unroll
      for (int cb = 0; cb < 4; ++cb) {
        f32x4 c = (f32x4){0.f, 0.f, 0.f, 0.f};
        c = mfma16(a0, tf[cb][0], c);
        c = mfma16(a1, tf[cb][1], c);
        *reinterpret_cast<uint2*>(valt + ((size_t)(eb * 4 + cb) * 64 + lane) * 4) = make_uint2(pack2(c[0], c[1]), pack2(c[2], c[3]));
      }
    }
#pragma unroll
    for (int dd = 0; dd < 2; ++dd) {
      int db = 2 * w + dd;
      bf16x8 b0 = lds_frag(RA, 72, db * 16, 0, lane), b1 = lds_frag(RA, 72, db * 16, 32, lane);
#pragma unroll
      for (int cb = 0; cb < 4; ++cb) {
        f32x4 c = (f32x4){0.f, 0.f, 0.f, 0.f};
        c = mfma16(tf[cb][0], b0, c);
        c = mfma16(tf[cb][1], b1, c);
#pragma unroll
        for (int j = 0; j < 4; ++j) RBk[(cb * 16 + 4 * lq + j) * 136 + db * 16 + lr] = f2bf(c[j]);
      }
    }
  }
  __syncthreads();
  store_frags(RBk, 136, 64, 128, reinterpret_cast<u16*>(p.ws + D_KCD) + (size_t)item * 8192, tid, NTHR);
  __syncthreads();
}

__device__ __forceinline__ void m1_hgrn_item(const Params& p, int item, char* smem) {
  const int tid = VTID, lane = tid & 63, w = tid >> 6, lr = lane & 15, lq = lane >> 4;
  const int h = item & 3, n = (item >> 2) & 63, b = item >> 8;
  const int t0 = b * 2048 + n * 32;
  u16* QG = reinterpret_cast<u16*>(smem);
  u16* QR = reinterpret_cast<u16*>(smem + 8704);
  u16* KR = reinterpret_cast<u16*>(smem + 17408);
  u16* KGT = reinterpret_cast<u16*>(smem + 26112);
  u16* VT = reinterpret_cast<u16*>(smem + 36352);
  float* tot = reinterpret_cast<float*>(smem + 46592);
  float* bls = tot + 128;
  const u16* Zp = reinterpret_cast<const u16*>(p.ws + Z1);
  const int e = tid & 127, half = tid >> 7;
  const int he = h * 128 + e;
  const float lb = sigmoid_f(p.lb_logits[he] - p.lb_logits[512 + he]);
  float q[16], k[16], bc[16];
  float run = 0.f;
#pragma unroll
  for (int i = 0; i < 16; ++i) {
    const u16* zr = Zp + (size_t)(t0 + half * 16 + i) * 3072;
    float qb = bf2f(zr[1536 + he]), fb = bf2f(zr[2048 + he]);
    float f = lb + (1.f - lb) * sigmoid_f(fb);
    run += __logf(f);
    q[i] = silu_f(qb); k[i] = 1.f - f; bc[i] = run;
    VT[e * 40 + half * 16 + i] = zr[2560 + he];
  }
  if (half == 0) tot[e] = run;
  __syncthreads();
  const float bref = tot[e];
  if (half == 1) {
#pragma unroll
    for (int i = 0; i < 16; ++i) bc[i] += bref;
    bls[e] = bc[15];
  }
  __syncthreads();
  const float bl = bls[e];
  if (half == 0) reinterpret_cast<float*>(p.ws + H_EBL)[(size_t)item * 128 + e] = __expf(bl);
#pragma unroll
  for (int i = 0; i < 16; ++i) {
    int r = half * 16 + i;
    QG[r * 136 + e] = f2bf(q[i] * __expf(bc[i]));
    QR[r * 136 + e] = f2bf(q[i] * __expf(bc[i] - bref));
    KR[r * 136 + e] = f2bf(k[i] * __expf(bref - bc[i]));
    KGT[e * 40 + r] = f2bf(k[i] * __expf(bl - bc[i]));
  }
  __syncthreads();
  {
    const int ib = w >> 1, jb = w & 1;
    f32x4 c = (f32x4){0.f, 0.f, 0.f, 0.f};
    if (jb <= ib) {
#pragma unroll
      for (int ks = 0; ks < 4; ++ks) c = mfma16(lds_frag(QR, 136, ib * 16, ks * 32, lane), lds_frag(KR, 136, jb * 16, ks * 32, lane), c);
    }
    u16* att = reinterpret_cast<u16*>(p.ws + H_ATT) + (size_t)item * 1024;
#pragma unroll
    for (int j = 0; j < 4; ++j) {
      int i = ib * 16 + 4 * lq + j, jj = jb * 16 + lr;
      float v = (i >= jj) ? c[j] : 0.f;
      att[(ib * 64 + (i & 15) + 16 * (jj >> 3)) * 8 + (jj & 7)] = f2bf(v);
    }
  }
  store_frags(QG, 136, 32, 128, reinterpret_cast<u16*>(p.ws + H_QG) + (size_t)item * 4096, tid, NTHR);
  store_frags(KGT, 40, 128, 32, reinterpret_cast<u16*>(p.ws + H_KGT) + (size_t)item * 4096, tid, NTHR);
  store_frags(VT, 40, 128, 32, reinterpret_cast<u16*>(p.ws + H_VT) + (size_t)item * 4096, tid, NTHR);
  __syncthreads();
}

struct DPre {
  bf16x8 kcd[4], q[4], att[2], knt[2][2];
  uint2 val[2];
  float gc, gl;
  float4 gi;
};
__device__ __forceinline__ void m2d_loadA(const Params& p, int base, int es, int w, int lane, DPre& d) {
  const int lr = lane & 15, lq = lane >> 4;
  const bf16x8* kcd = reinterpret_cast<const bf16x8*>(p.ws + D_KCD + (size_t)base * 16384);
  const uint2* val = reinterpret_cast<const uint2*>(p.ws + D_VALT + (size_t)base * 16384);
  const float* gc = reinterpret_cast<const float*>(p.ws + D_GC) + (size_t)base * 64;
#pragma unroll
  for (int ks = 0; ks < 4; ++ks) d.kcd[ks] = kcd[(w * 4 + ks) * 64 + lane];
#pragma unroll
  for (int eb = 0; eb < 2; ++eb) d.val[eb] = val[((es * 2 + eb) * 4 + w) * 64 + lane];
  d.gc = gc[w * 16 + lr];
  d.gl = gc[63];
  d.gi = *reinterpret_cast<const float4*>(gc + 16 * w + 4 * lq);
}
__device__ __forceinline__ void m2d_loadB(const Params& p, int base, int w, int lane, DPre& d) {
  const bf16x8* qf = reinterpret_cast<const bf16x8*>(p.ws + D_QF + (size_t)base * 16384);
  const bf16x8* att = reinterpret_cast<const bf16x8*>(p.ws + D_ATT + (size_t)base * 8192);
#pragma unroll
  for (int ks = 0; ks < 4; ++ks) d.q[ks] = qf[(w * 4 + ks) * 64 + lane];
#pragma unroll
  for (int ks = 0; ks < 2; ++ks) d.att[ks] = att[(w * 2 + ks) * 64 + lane];
}
__device__ __forceinline__ void m2d_loadC(const Params& p, int base, int w, int lane, DPre& d) {
  const bf16x8* knt = reinterpret_cast<const bf16x8*>(p.ws + D_KNT + (size_t)base * 16384);
#pragma unroll
  for (int ks = 0; ks < 2; ++ks) {
    d.knt[0][ks] = knt[((2 * w) * 2 + ks) * 64 + lane];
    d.knt[1][ks] = knt[((2 * w + 1) * 2 + ks) * 64 + lane];
  }
}

__device__ __forceinline__ void m2_delta_item(const Params& p, int item, char* smem) {
  const int tid = VTID, lane = tid & 63, w = tid >> 6, lr = lane & 15, lq = lane >> 4;
  const int es = item & 3, h = (item >> 2) & 3, b = item >> 4;
  u16* Sb = reinterpret_cast<u16*>(smem);
  u16* Ub = reinterpret_cast<u16*>(smem + 17408);
  u16* Usb = reinterpret_cast<u16*>(smem + 22016);
  for (int i = tid; i < 32 * 136; i += NTHR) Sb[i] = 0;
  f32x4 accS[2][2];
#pragma unroll
  for (int i = 0; i < 2; ++i)
#pragma unroll
    for (int j = 0; j < 2; ++j) accS[i][j] = (f32x4){0.f, 0.f, 0.f, 0.f};
  u16* OA = reinterpret_cast<u16*>(reinterpret_cast<char*>(p.out) + YB_OA);
  DPre cur;
  m2d_loadA(p, (b * 32 + 0) * 4 + h, es, w, lane, cur);
  m2d_loadB(p, (b * 32 + 0) * 4 + h, w, lane, cur);
  m2d_loadC(p, (b * 32 + 0) * 4 + h, w, lane, cur);
  __syncthreads();
  for (int n = 0; n < 32; ++n) {
    const int nbase = (b * 32 + (n + 1 < 32 ? n + 1 : n)) * 4 + h;
    const u16* Sc = Sb + (n & 1) * (32 * 136);
    u16* Sn = Sb + ((n + 1) & 1) * (32 * 136);
    f32x4 accP[2];
    accP[0] = (f32x4){0.f, 0.f, 0.f, 0.f}; accP[1] = accP[0];
#pragma unroll
    for (int ks = 0; ks < 4; ++ks) {
      accP[0] = mfma16(lds_frag(Sc, 136, 0, ks * 32, lane), cur.kcd[ks], accP[0]);
      accP[1] = mfma16(lds_frag(Sc, 136, 16, ks * 32, lane), cur.kcd[ks], accP[1]);
    }
    const float egc = __expf(cur.gl - cur.gc);
    const float egl = __expf(cur.gl);
    const float egi[4] = {__expf(cur.gi.x), __expf(cur.gi.y), __expf(cur.gi.z), __expf(cur.gi.w)};
    float vv[2][4];
#pragma unroll
    for (int eb = 0; eb < 2; ++eb) { vv[eb][0] = lo2f(cur.val[eb].x); vv[eb][1] = hi2f(cur.val[eb].x); vv[eb][2] = lo2f(cur.val[eb].y); vv[eb][3] = hi2f(cur.val[eb].y); }
    m2d_loadA(p, nbase, es, w, lane, cur);
#pragma unroll
    for (int eb = 0; eb < 2; ++eb) {
#pragma unroll
      for (int j = 0; j < 4; ++j) {
        float u = vv[eb][j] - accP[eb][j];
        int e = eb * 16 + 4 * lq + j, c = 16 * w + lr;
        Ub[e * 72 + c] = f2bf(u);
        Usb[e * 72 + c] = f2bf(u * egc);
      }
    }
    lds_barrier();
    {
      f32x4 accO[2];
      accO[0] = (f32x4){0.f, 0.f, 0.f, 0.f}; accO[1] = accO[0];
#pragma unroll
      for (int ks = 0; ks < 4; ++ks) {
        accO[0] = mfma16(cur.q[ks], lds_frag(Sc, 136, 0, ks * 32, lane), accO[0]);
        accO[1] = mfma16(cur.q[ks], lds_frag(Sc, 136, 16, ks * 32, lane), accO[1]);
      }
#pragma unroll
      for (int eb = 0; eb < 2; ++eb)
#pragma unroll
        for (int j = 0; j < 4; ++j) accO[eb][j] *= egi[j];
#pragma unroll
      for (int ks = 0; ks < 2; ++ks) {
        accO[0] = mfma16(cur.att[ks], lds_frag(Ub, 72, 0, ks * 32, lane), accO[0]);
        accO[1] = mfma16(cur.att[ks], lds_frag(Ub, 72, 16, ks * 32, lane), accO[1]);
      }
      m2d_loadB(p, nbase, w, lane, cur);
#pragma unroll
      for (int eb = 0; eb < 2; ++eb)
#pragma unroll
        for (int j = 0; j < 4; ++j) {
          int tok = b * 2048 + n * 64 + 16 * w + 4 * lq + j;
          OA[(size_t)tok * 512 + h * 128 + es * 32 + eb * 16 + lr] = f2bf(accO[eb][j]);
        }
    }
    {
#pragma unroll
      for (int eb = 0; eb < 2; ++eb) {
        bf16x8 a0 = lds_frag(Usb, 72, eb * 16, 0, lane), a1 = lds_frag(Usb, 72, eb * 16, 32, lane);
#pragma unroll
        for (int dd = 0; dd < 2; ++dd) {
#pragma unroll
          for (int j = 0; j < 4; ++j) accS[eb][dd][j] *= egl;
          accS[eb][dd] = mfma16(a0, cur.knt[dd][0], accS[eb][dd]);
          accS[eb][dd] = mfma16(a1, cur.knt[dd][1], accS[eb][dd]);
#pragma unroll
          for (int j = 0; j < 4; ++j) Sn[(eb * 16 + 4 * lq + j) * 136 + (2 * w + dd) * 16 + lr] = f2bf(accS[eb][dd][j]);
        }
      }
    }
    m2d_loadC(p, nbase, w, lane, cur);
    lds_barrier();
  }
  float* outp = p.out + O_DELTAP + (size_t)(b * 4 + h) * 16384;
#pragma unroll
  for (int eb = 0; eb < 2; ++eb)
#pragma unroll
    for (int dd = 0; dd < 2; ++dd) {
      int d = (2 * w + dd) * 16 + lr, e0 = es * 32 + eb * 16 + 4 * lq;
      *reinterpret_cast<float4*>(outp + (size_t)d * 128 + e0) =
          make_float4(accS[eb][dd][0], accS[eb][dd][1], accS[eb][dd][2], accS[eb][dd][3]);
    }
  __syncthreads();
}

struct HPre {
  bf16x8 qg[4], att, vt[2], kgt[2];
  float ebl[2];
};
__device__ __forceinline__ HPre m2h_load(const Params& p, int base, int vs, int w, int lane) {
  HPre d;
  const int lr = lane & 15;
  const bf16x8* qg = reinterpret_cast<const bf16x8*>(p.ws + H_QG + (size_t)base * 8192);
  const bf16x8* att = reinterpret_cast<const bf16x8*>(p.ws + H_ATT + (size_t)base * 2048);
  const bf16x8* vt = reinterpret_cast<const bf16x8*>(p.ws + H_VT + (size_t)base * 8192);
  const bf16x8* kgt = reinterpret_cast<const bf16x8*>(p.ws + H_KGT + (size_t)base * 8192);
  const float* ebl = reinterpret_cast<const float*>(p.ws + H_EBL) + (size_t)base * 128;
  const int ib = w >> 1;
#pragma unroll
  for (int ks = 0; ks < 4; ++ks) d.qg[ks] = qg[(ib * 4 + ks) * 64 + lane];
  d.att = att[ib * 64 + lane];
  d.vt[0] = vt[(vs * 2 + 0) * 64 + lane];
  d.vt[1] = vt[(vs * 2 + 1) * 64 + lane];
  d.kgt[0] = kgt[(2 * w) * 64 + lane];
  d.kgt[1] = kgt[(2 * w + 1) * 64 + lane];
  d.ebl[0] = ebl[(2 * w) * 16 + lr];
  d.ebl[1] = ebl[(2 * w + 1) * 16 + lr];
  return d;
}

__device__ __forceinline__ void m2_hgrn_item(const Params& p, int item, char* smem) {
  const int tid = VTID, lane = tid & 63, w = tid >> 6, lr = lane & 15, lq = lane >> 4;
  const int vs = item & 3, h = (item >> 2) & 3, b = item >> 4;
  u16* Sb = reinterpret_cast<u16*>(smem);
  for (int i = tid; i < 32 * 136; i += NTHR) Sb[i] = 0;
  f32x4 accS[2][2];
#pragma unroll
  for (int i = 0; i < 2; ++i)
#pragma unroll
    for (int j = 0; j < 2; ++j) accS[i][j] = (f32x4){0.f, 0.f, 0.f, 0.f};
  u16* OB = reinterpret_cast<u16*>(reinterpret_cast<char*>(p.out) + YB_OB);
  const int ib = w >> 1, vb = w & 1;
  HPre cur = m2h_load(p, (b * 64 + 0) * 4 + h, vs, w, lane), nxt = cur;
  __syncthreads();
  for (int n = 0; n < 64; ++n) {
    if (n + 1 < 64) nxt = m2h_load(p, (b * 64 + n + 1) * 4 + h, vs, w, lane);
    const u16* Sc = Sb + (n & 1) * (32 * 136);
    u16* Sn = Sb + ((n + 1) & 1) * (32 * 136);
    {
      f32x4 o = (f32x4){0.f, 0.f, 0.f, 0.f};
#pragma unroll
      for (int ks = 0; ks < 4; ++ks) o = mfma16(cur.qg[ks], lds_frag(Sc, 136, vb * 16, ks * 32, lane), o);
      o = mfma16(cur.att, vb ? cur.vt[1] : cur.vt[0], o);
#pragma unroll
      for (int j = 0; j < 4; ++j) {
        int tok = b * 2048 + n * 32 + ib * 16 + 4 * lq + j;
        OB[(size_t)tok * 512 + h * 128 + vs * 32 + vb * 16 + lr] = f2bf(o[j]);
      }
    }
#pragma unroll
    for (int v2 = 0; v2 < 2; ++v2)
#pragma unroll
      for (int dd = 0; dd < 2; ++dd) {
#pragma unroll
        for (int j = 0; j < 4; ++j) accS[v2][dd][j] *= cur.ebl[dd];
        accS[v2][dd] = mfma16(cur.vt[v2], cur.kgt[dd], accS[v2][dd]);
#pragma unroll
        for (int j = 0; j < 4; ++j) Sn[(v2 * 16 + 4 * lq + j) * 136 + (2 * w + dd) * 16 + lr] = f2bf(accS[v2][dd][j]);
      }
    lds_barrier();
    cur = nxt;
  }
  float* outp = p.out + O_HGRNP + (size_t)(b * 4 + h) * 16384;
#pragma unroll
  for (int v2 = 0; v2 < 2; ++v2)
#pragma unroll
    for (int dd = 0; dd < 2; ++dd) {
      int e = (2 * w + dd) * 16 + lr, v0 = vs * 32 + v2 * 16 + 4 * lq;
      *reinterpret_cast<float4*>(outp + (size_t)e * 128 + v0) =
          make_float4(accS[v2][dd][0], accS[v2][dd][1], accS[v2][dd][2], accS[v2][dd][3]);
    }
  __syncthreads();
}

__device__ __forceinline__ void ms_delta_item(const Params& p, int item, char* smem) {
  const int tid = VTID, lane = tid & 63, w = tid >> 6;
  const int h = item & 3, b = item >> 2;
  const int R0 = TP + b * 4;
  float* qkv = reinterpret_cast<float*>(smem);
  float* red = reinterpret_cast<float*>(smem + 6144);
  const u16* Zp = reinterpret_cast<const u16*>(p.ws + Z1);
  for (int c = tid; c < 384; c += NTHR) {
    int col = c < 128 ? h * 128 + c : (c < 256 ? 512 + h * 128 + c - 128 : 1024 + h * 128 + c - 256);
    float xs[7];
#pragma unroll
    for (int j = 0; j < 3; ++j) xs[j] = p.cache_conv[(size_t)(b * 3 + j) * 1536 + col];
#pragma unroll
    for (int t = 0; t < 4; ++t) xs[3 + t] = bf2f(Zp[(size_t)(R0 + t) * 3072 + col]);
    float wc[4];
#pragma unroll
    for (int j = 0; j < 4; ++j) wc[j] = p.w_conv_a[j * 1536 + col];
#pragma unroll
    for (int t = 0; t < 4; ++t) {
      float y = xs[t] * wc[0] + xs[t + 1] * wc[1] + xs[t + 2] * wc[2] + xs[t + 3] * wc[3];
      qkv[t * 384 + c] = silu_f(y);
    }
  }
  __syncthreads();
  {
    const int t = w;
    float q0 = qkv[t * 384 + lane], q1 = qkv[t * 384 + 64 + lane];
    float k0 = qkv[t * 384 + 128 + lane], k1 = qkv[t * 384 + 192 + lane];
    float qs = wave_sum(q0 * q0 + q1 * q1), ks = wave_sum(k0 * k0 + k1 * k1);
    float qn = rsqrtf(qs + EPS) * 0.08838834764831845f, kn = rsqrtf(ks + EPS);
    qkv[t * 384 + lane] = q0 * qn; qkv[t * 384 + 64 + lane] = q1 * qn;
    qkv[t * 384 + 128 + lane] = k0 * kn; qkv[t * 384 + 192 + lane] = k1 * kn;
  }
  __syncthreads();
  const int e = tid & 127, dh = tid >> 7;
  float S[64];
  const float* s0 = p.state_delta + (size_t)(b * 4 + h) * 16384 + (size_t)(dh * 64) * 128 + e;
#pragma unroll
  for (int dd = 0; dd < 64; ++dd) S[dd] = s0[(size_t)dd * 128];
  const float* gdec = reinterpret_cast<const float*>(p.ws + SM_GDEC);
  const float* betap = reinterpret_cast<const float*>(p.ws + SM_BETA);
  u16* OA = reinterpret_cast<u16*>(reinterpret_cast<char*>(p.out) + YB_OA);
  for (int t = 0; t < 4; ++t) {
    const float a = __expf(gdec[(size_t)(R0 + t) * 4 + h]), bt = betap[(size_t)(R0 + t) * 4 + h];
    const float* qv = qkv + t * 384 + dh * 64;
    const float* kv = qkv + t * 384 + 128 + dh * 64;
    float rp = 0.f;
#pragma unroll
    for (int dd = 0; dd < 64; ++dd) rp += S[dd] * kv[dd];
    red[((t * 2 + 0) * 2 + dh) * 128 + e] = rp;
    __syncthreads();
    float r = a * (red[((t * 2 + 0) * 2 + 0) * 128 + e] + red[((t * 2 + 0) * 2 + 1) * 128 + e]);
    float u = bt * (qkv[t * 384 + 256 + e] - r);
    float op = 0.f;
#pragma unroll
    for (int dd = 0; dd < 64; ++dd) {
      S[dd] = a * S[dd] + kv[dd] * u;
      op += S[dd] * qv[dd];
    }
    red[((t * 2 + 1) * 2 + dh) * 128 + e] = op;
    __syncthreads();
    if (dh == 0) {
      float o = red[((t * 2 + 1) * 2 + 0) * 128 + e] + red[((t * 2 + 1) * 2 + 1) * 128 + e];
      OA[(size_t)(R0 + t) * 512 + h * 128 + e] = f2bf(o);
    }
  }
  float* so = p.out + O_DELTAS + (size_t)(b * 4 + h) * 16384 + (size_t)(dh * 64) * 128 + e;
#pragma unroll
  for (int dd = 0; dd < 64; ++dd) so[(size_t)dd * 128] = S[dd];
  __syncthreads();
}

__device__ __forceinline__ void ms_hgrn_item(const Params& p, int item, char* smem) {
  const int tid = VTID;
  const int h = item & 3, b = item >> 2;
  const int R0 = TP + b * 4;
  float* qs = reinterpret_cast<float*>(smem);
  float* fs = qs + 512;
  float* vsm = fs + 512;
  float* red = vsm + 512;
  const u16* Zp = reinterpret_cast<const u16*>(p.ws + Z1);
  for (int i = tid; i < 512; i += NTHR) {
    int t = i >> 7, e = i & 127, he = h * 128 + e;
    const u16* zr = Zp + (size_t)(R0 + t) * 3072;
    float lb = sigmoid_f(p.lb_logits[he] - p.lb_logits[512 + he]);
    qs[i] = silu_f(bf2f(zr[1536 + he]));
    fs[i] = lb + (1.f - lb) * sigmoid_f(bf2f(zr[2048 + he]));
    vsm[i] = bf2f(zr[2560 + he]);
  }
  __syncthreads();
  const int v = tid & 127, eh = tid >> 7;
  float S[64];
  const float* s0 = p.state_hgrn + (size_t)(b * 4 + h) * 16384 + (size_t)(eh * 64) * 128 + v;
#pragma unroll
  for (int ee = 0; ee < 64; ++ee) S[ee] = s0[(size_t)ee * 128];
  u16* OB = reinterpret_cast<u16*>(reinterpret_cast<char*>(p.out) + YB_OB);
  for (int t = 0; t < 4; ++t) {
    const float vv = vsm[t * 128 + v];
    const float* ft = fs + t * 128 + eh * 64;
    const float* qt = qs + t * 128 + eh * 64;
    float op = 0.f;
#pragma unroll
    for (int ee = 0; ee < 64; ++ee) {
      float f = ft[ee];
      S[ee] = f * S[ee] + (1.f - f) * vv;
      op += S[ee] * qt[ee];
    }
    red[(t * 2 + eh) * 128 + v] = op;
    __syncthreads();
    if (eh == 0) OB[(size_t)(R0 + t) * 512 + h * 128 + v] = f2bf(red[(t * 2) * 128 + v] + red[(t * 2 + 1) * 128 + v]);
  }
  float* so = p.out + O_HGRNS + (size_t)(b * 4 + h) * 16384 + (size_t)(eh * 64) * 128 + v;
#pragma unroll
  for (int ee = 0; ee < 64; ++ee) so[(size_t)ee * 128] = S[ee];
  __syncthreads();
}

__device__ __forceinline__ void phase_m3(const Params& p, char* smem, int bid, int nb) {
  const int tid = VTID, lane = tid & 63, w = tid >> 6;
  float* tl = reinterpret_cast<float*>(smem);
  const int NWT = 704 + 352;
  const int NTASK = (2 * TT) / 4;
  for (int item = bid; item < NWT + NTASK; item += nb) {
    if (item < NWT) {
      if (item < 704) {
        int blk = item >> 2, k0 = (item & 3) * 256;
        int grp = blk >> 3, sub = blk & 7, up = sub >> 2;
        wt_chunk((up ? p.w_ffn_up : p.w_ffn_gate) + grp * 128 + (sub & 3) * 32, DFF, 1024,
                 reinterpret_cast<u16*>(p.ws + W_GU) + (size_t)blk * 32 * 1024, p.g_ffn, tl, k0);
      } else {
        int q = item - 704;
        int n = (q / 11) * 32, k0 = (q % 11) * 256;
        wt_chunk(p.w_ffn_down + n, 1024, DFF, reinterpret_cast<u16*>(p.ws + W_DOWN) + (size_t)n * DFF, nullptr, tl, k0);
      }
    } else {
      int task = (item - NWT) * 4 + w;
      int tok = task >> 1, br = task & 1;
      u16* o = reinterpret_cast<u16*>(reinterpret_cast<char*>(p.out) + (br ? YB_OB : YB_OA)) + (size_t)tok * 512 + lane * 8;
      const u16* og = z2row(p, tok) + 2048 + br * 512 + lane * 8;
      const float* g = (br ? p.g_out_b : p.g_out_a) + (lane & 15) * 8;
      uint4 ov = *reinterpret_cast<const uint4*>(o), gv = *reinterpret_cast<const uint4*>(og);
      unsigned oo[4] = {ov.x, ov.y, ov.z, ov.w}, gg[4] = {gv.x, gv.y, gv.z, gv.w};
      float x[8], y[8];
#pragma unroll
      for (int j = 0; j < 4; ++j) { x[2 * j] = lo2f(oo[j]); x[2 * j + 1] = hi2f(oo[j]); y[2 * j] = lo2f(gg[j]); y[2 * j + 1] = hi2f(gg[j]); }
      float ss = 0.f;
#pragma unroll
      for (int j = 0; j < 8; ++j) ss += x[j] * x[j];
      ss += __shfl_xor(ss, 1, 64); ss += __shfl_xor(ss, 2, 64); ss += __shfl_xor(ss, 4, 64); ss += __shfl_xor(ss, 8, 64);
      float rstd = rsqrtf(ss * (1.f / 128.f) + EPS);
      unsigned r[4];
#pragma unroll
      for (int j = 0; j < 4; ++j)
        r[j] = pack2(x[2 * j] * rstd * g[2 * j] * silu_f(y[2 * j]), x[2 * j + 1] * rstd * g[2 * j + 1] * silu_f(y[2 * j + 1]));
      *reinterpret_cast<uint4*>(o) = make_uint4(r[0], r[1], r[2], r[3]);
    }
  }
}

__device__ __forceinline__ void phase_fixup(const Params& p, int bid, int nb) {
  const float* haloG = reinterpret_cast<const float*>(p.ws + HALO_G);
  const float* headG = reinterpret_cast<const float*>(p.ws + HEAD_G);
  const float* headU = reinterpret_cast<const float*>(p.ws + HEAD_U);
  u16* ACTp = reinterpret_cast<u16*>(p.ws + ACT);
  const int total = 256 * 2 * DFF;
  for (int i = bid * NTHR + VTID; i < total; i += nb * NTHR) {
    int ch = i % DFF, rr = (i / DFF) & 1, blk = i / (2 * DFF);
    if ((blk & 31) == 0) continue;
    float g0 = headG[(size_t)(blk * 2 + rr) * DFF + ch], u = headU[(size_t)(blk * 2 + rr) * DFF + ch];
    float gm1, gm2;
    if (rr == 0) { gm1 = haloG[(size_t)((blk - 1) * 2 + 1) * DFF + ch]; gm2 = haloG[(size_t)((blk - 1) * 2 + 0) * DFF + ch]; }
    else { gm1 = headG[(size_t)(blk * 2 + 0) * DFF + ch]; gm2 = haloG[(size_t)((blk - 1) * 2 + 1) * DFF + ch]; }
    float gc = p.w_ffn_conv[ch] * gm2 + p.w_ffn_conv[DFF + ch] * gm1 + p.w_ffn_conv[2 * DFF + ch] * g0;
    ACTp[(size_t)(blk * 64 + rr) * DFF + ch] = f2bf(silu_f(gc) * u);
  }
}

__device__ __forceinline__ void phase_final(const Params& p, int bid, int nb) {
  const int tid = VTID, lane = tid & 63, w = tid >> 6;
  for (int row = bid * 4 + w; row < TP; row += nb * 8) {
    const int rowB = row + nb * 4;
    const bool hasB = rowB < TP;
    float* ya = p.out + O_YP + (size_t)row * DM;
    float* yb = p.out + O_YP + (size_t)(hasB ? rowB : row) * DM;
    float4 xa[4], xb[4];
#pragma unroll
    for (int i = 0; i < 4; ++i) xa[i] = *reinterpret_cast<const float4*>(ya + i * 256 + lane * 4);
#pragma unroll
    for (int i = 0; i < 4; ++i) xb[i] = *reinterpret_cast<const float4*>(yb + i * 256 + lane * 4);
    float sa = 0.f, sb = 0.f;
#pragma unroll
    for (int i = 0; i < 4; ++i) {
      sa += xa[i].x * xa[i].x + xa[i].y * xa[i].y + xa[i].z * xa[i].z + xa[i].w * xa[i].w;
      sb += xb[i].x * xb[i].x + xb[i].y * xb[i].y + xb[i].z * xb[i].z + xb[i].w * xb[i].w;
    }
    sa = wave_sum(sa); sb = wave_sum(sb);
    const float ra = rsqrtf(sa * (1.f / DM) + EPS), rb = rsqrtf(sb * (1.f / DM) + EPS);
#pragma unroll
    for (int i = 0; i < 4; ++i) {
      float4 g = *reinterpret_cast<const float4*>(p.g_final + i * 256 + lane * 4);
      *reinterpret_cast<float4*>(ya + i * 256 + lane * 4) = make_float4(xa[i].x * ra * g.x, xa[i].y * ra * g.y, xa[i].z * ra * g.z, xa[i].w * ra * g.w);
      if (hasB) *reinterpret_cast<float4*>(yb + i * 256 + lane * 4) = make_float4(xb[i].x * rb * g.x, xb[i].y * rb * g.y, xb[i].z * rb * g.z, xb[i].w * rb * g.w);
    }
  }
  for (int row = TP + bid * 4 + w; row < TT; row += nb * 4) {
    float* y = p.out + O_YP + (size_t)row * DM;
    float4 xv[4];
    float ss = 0.f;
    const float* part = reinterpret_cast<const float*>(p.ws + PART) + (size_t)(row - TP) * 1024;
#pragma unroll
    for (int i = 0; i < 4; ++i) {
      xv[i] = *reinterpret_cast<const float4*>(y + i * 256 + lane * 4);
      for (int ks = 0; ks < 11; ++ks) {
        float4 pv = *reinterpret_cast<const float4*>(part + (size_t)ks * TS * 1024 + i * 256 + lane * 4);
        xv[i].x += pv.x; xv[i].y += pv.y; xv[i].z += pv.z; xv[i].w += pv.w;
      }
      ss += xv[i].x * xv[i].x + xv[i].y * xv[i].y + xv[i].z * xv[i].z + xv[i].w * xv[i].w;
    }
    ss = wave_sum(ss);
    float rstd = rsqrtf(ss * (1.f / DM) + EPS);
#pragma unroll
    for (int i = 0; i < 4; ++i) {
      float4 g = *reinterpret_cast<const float4*>(p.g_final + i * 256 + lane * 4);
      *reinterpret_cast<float4*>(y + i * 256 + lane * 4) =
          make_float4(xv[i].x * rstd * g.x, xv[i].y * rstd * g.y, xv[i].z * rstd * g.z, xv[i].w * rstd * g.w);
    }
  }
}

constexpr int NPHASE = 13;
__device__ __forceinline__ void run_phase(const Params& p, int ph, char* smem_all) {
  int half = threadIdx.x >> 8;
  asm volatile("" : "+v"(half));
  const int bid = blockIdx.x * 2 + half, nb = gridDim.x * 2;
  char* smem = smem_all + half * SMEM_HALF;
  LAS unsigned char* lds = (LAS unsigned char*)smem_all;
  const u16* HB = reinterpret_cast<const u16*>(reinterpret_cast<const char*>(p.out) + YB_H);
  switch (ph) {
    case 0: phase_prep(p, smem, bid, nb, 0); break;
    case 1: {
      { pg8::SchedStatic S; S.init(TS, 3072, 24, (int)blockIdx.x, 64);
        gemm_phase8<EPI_Z1>(p, HB, reinterpret_cast<const u16*>(p.ws + W_MAIN), 1024, 1024, lds, S); }
      phase_prep(p, smem, bid, nb, 1);
    } break;
    case 2: { pg8::SchedStatic S; S.init(TP, 3072, (int)gridDim.x, (int)blockIdx.x, 0); gemm_phase8<EPI_Z1>(p, HB, reinterpret_cast<const u16*>(p.ws + W_MAIN), 1024, 1024, lds, S); } break;
    case 3:
      for (int it = bid; it < 1024; it += nb) m1_delta_item(p, it, smem);
      for (int it = bid; it < 2048; it += nb) m1_hgrn_item(p, it, smem);
      break;
    case 4: {
      const int g = blockIdx.x;
      if (g < 128) {
        const int gg = g & 63, xcd = gg & 7, j = gg >> 3;
        const int q = xcd + 8 * (j >> 1), es = 2 * (j & 1) + half;
        if (g < 64) m2_delta_item(p, q * 4 + es, smem); else m2_hgrn_item(p, q * 4 + es, smem);
      } else {
        const int nrest = (gridDim.x - 128) * 2, v0 = (g - 128) * 2 + half;
        for (int it = v0; it < 1024; it += nrest) {
          if (it < 512) ms_delta_item(p, it, smem); else ms_hgrn_item(p, it - 512, smem);
        }
        __syncthreads();
        { pg8::SchedStatic S; S.init(TS, 3072, 24, g - 128, 64);
          gemm_phase8<EPI_Z2>(p, HB, reinterpret_cast<const u16*>(p.ws + W_G2), 1024, 1024, lds, S); }
      }
    } break;
    case 5: { pg8::SchedStatic S; S.init(TP, 3072, (int)gridDim.x, (int)blockIdx.x, 0); gemm_phase8<EPI_Z2>(p, HB, reinterpret_cast<const u16*>(p.ws + W_G2), 1024, 1024, lds, S); } break;
    case 6: phase_m3(p, smem, bid, nb); break;
    case 7: {
      const u16* OA = reinterpret_cast<const u16*>(reinterpret_cast<const char*>(p.out) + YB_OA);
      const u16* OB = reinterpret_cast<const u16*>(reinterpret_cast<const char*>(p.out) + YB_OB);
      { pg8::SchedStatic S; S.init(TT, 1024, (int)gridDim.x, (int)blockIdx.x, 0); gemm_phase8<EPI_MIXA>(p, OA, reinterpret_cast<const u16*>(p.ws + W_A), 512, 512, lds, S);
      gemm_phase8<EPI_MIXB>(p, OB, reinterpret_cast<const u16*>(p.ws + W_B), 512, 512, lds, S); }
    } break;
    case 8: { pg8::SchedStatic S; S.init(TT, 1024, (int)gridDim.x, (int)blockIdx.x, 0); gemm_phase8<EPI_WOUT>(p, reinterpret_cast<const u16*>(p.ws + MIX), reinterpret_cast<const u16*>(p.ws + W_OUT), 1024, 1024, lds, S); } break;
    case 9: {
      { pg8::SchedStatic S; S.init(TP, 5632, (int)gridDim.x, (int)blockIdx.x, 0);
        gemm_phase8<EPI_FFN1>(p, reinterpret_cast<const u16*>(p.ws + X1B), reinterpret_cast<const u16*>(p.ws + W_GU), 1024, 1024, lds, S); }
      { pg8::SchedStatic S; S.init(TS, 5632, (int)gridDim.x, (int)gridDim.x - 1 - (int)blockIdx.x, 64);
        gemm_phase8<EPI_FFN1S>(p, reinterpret_cast<const u16*>(p.ws + X1B), reinterpret_cast<const u16*>(p.ws + W_GU), 1024, 1024, lds, S); }
    } break;
    case 10: phase_fixup(p, bid, nb); break;
    case 11: {
      { pg8::SchedStatic S; S.init(TP, 1024, (int)gridDim.x, (int)blockIdx.x, 0);
        gemm_phase8<EPI_FFN2>(p, reinterpret_cast<const u16*>(p.ws + ACT), reinterpret_cast<const u16*>(p.ws + W_DOWN), DFF, DFF, lds, S); }
      { pg8::SchedSplit S; S.init(2, 4, 11, (int)gridDim.x, (int)blockIdx.x, 64);
        gemm_phase8<EPI_FFN2S>(p, reinterpret_cast<const u16*>(p.ws + ACT), reinterpret_cast<const u16*>(p.ws + W_DOWN), DFF, 256, lds, S); }
    } break;
    case 12: phase_final(p, bid, nb); break;
  }
}

__global__ void __launch_bounds__(512, 2) k_main(Params p, int ph0, int ph1) {
  extern __shared__ __attribute__((aligned(16))) char smem[];
  volatile LAS unsigned* xst = (volatile LAS unsigned*)(smem + 2 * SMEM_HALF);
  if (threadIdx.x == 0) { xst[0] = 0u; xst[1] = 0u; }
  __syncthreads();
  XcdBarrier xb = xcd_barrier_post(reinterpret_cast<unsigned*>(p.ws + BAR_OFF), xst);
  if (ph1 < 0) cg::this_grid().sync();
#define PHASE_STEP(N)                                        \
  if (ph0 <= N && N < ph1) run_phase(p, N, smem);            \
  if (ph0 <= N && N + 1 < ph1) xcd_barrier(xb);
  PHASE_STEP(0) PHASE_STEP(1) PHASE_STEP(2) PHASE_STEP(3) PHASE_STEP(4) PHASE_STEP(5)
  PHASE_STEP(6) PHASE_STEP(7) PHASE_STEP(8) PHASE_STEP(9) PHASE_STEP(10) PHASE_STEP(11) PHASE_STEP(12)
#undef PHASE_STEP
}

extern "C" void kernel_launch(void* const* d_in, const int* in_sizes, int n_in, void* d_out, int out_size, void* d_ws,
                              size_t ws_size, hipStream_t stream) {
  static int grid_blocks = 0;
  if (!grid_blocks) {
    hipFuncSetAttribute((const void*)k_main, hipFuncAttributeMaxDynamicSharedMemorySize, SMEM_BYTES);
    int dev = 0, cus = 0, per_cu = 0;
    hipGetDevice(&dev);
    hipDeviceGetAttribute(&cus, hipDeviceAttributeMultiprocessorCount, dev);
    hipOccupancyMaxActiveBlocksPerMultiprocessor(&per_cu, k_main, 512, SMEM_BYTES);
    if (per_cu > 1) per_cu = 1;
    if (per_cu < 1) per_cu = 1;
    grid_blocks = cus * per_cu;
  }
  Params p{};
  const float** f = reinterpret_cast<const float**>(&p);
  for (int i = 0; i < 23; ++i) f[i] = reinterpret_cast<const float*>(d_in[i]);
  p.out = reinterpret_cast<float*>(d_out);
  p.ws = reinterpret_cast<char*>(d_ws);
  if (ws_size < WS_NEED) fprintf(stderr, "workspace too small: %zu < %zu\n", ws_size, (size_t)WS_NEED);
  hipMemsetAsync(p.ws + BAR_OFF, 0, 16384, stream);
#if MULTI_LAUNCH
  for (int ph = 0; ph < NPHASE; ++ph) {
    hipLaunchKernelGGL(k_main, dim3(grid_blocks), dim3(512), SMEM_BYTES, stream, p, ph, ph + 1);
  }
#else
  int ph0 = 0, ph1 = NPHASE;
  void* args[] = {&p, &ph0, &ph1};
  hipError_t e = hipLaunchCooperativeKernel((void*)k_main, dim3(grid_blocks), dim3(512), args, SMEM_BYTES, stream);
  if (e != hipSuccess) fprintf(stderr, "cooperative launch failed: %s (grid %d)\n", hipGetErrorString(e), grid_blocks);
#endif
}
```

```cpp
#include <hip/hip_runtime.h>
#include <hip/hip_cooperative_groups.h>
#include <cstdio>
#include <cstdint>
namespace cg = cooperative_groups;

#ifndef MULTI_LAUNCH
#define MULTI_LAUNCH 0
#endif

typedef unsigned short u16;
typedef __attribute__((ext_vector_type(8))) short bf16x8;
typedef __attribute__((ext_vector_type(4))) float f32x4;

constexpr int TP = 16384, TS = 512, TT = TP + TS;
constexpr int DM = 1024, NIN = 6152, DFF = 2816;
constexpr float EPS = 1e-6f;
constexpr int NTHR = 256;
#define VTID (threadIdx.x & 255)
constexpr int SMEM_HALF = 77824;
constexpr int SMEM_BYTES = 2 * SMEM_HALF + 16;

constexpr size_t O_YP = 0;
constexpr size_t O_YS = O_YP + (size_t)TP * DM;
constexpr size_t O_CONVP = O_YS + (size_t)TS * DM;
constexpr size_t O_DELTAP = O_CONVP + 8 * 3 * 1536;
constexpr size_t O_HGRNP = O_DELTAP + 8 * 4 * 128 * 128;
constexpr size_t O_FFNP = O_HGRNP + 8 * 4 * 128 * 128;
constexpr size_t O_CONVS = O_FFNP + 8 * 2 * DFF;
constexpr size_t O_DELTAS = O_CONVS + 128 * 3 * 1536;
constexpr size_t O_HGRNS = O_DELTAS + (size_t)128 * 4 * 128 * 128;
constexpr size_t O_FFNS = O_HGRNS + (size_t)128 * 4 * 128 * 128;

constexpr size_t al(size_t x) { return (x + 255) & ~(size_t)255; }
constexpr size_t W_MAIN = 0;
constexpr size_t W_G2 = W_MAIN + (size_t)3072 * 1024 * 2;
constexpr size_t W_A = W_G2 + (size_t)3072 * 1024 * 2;
constexpr size_t W_B = W_A + (size_t)1024 * 512 * 2;
constexpr size_t W_OUT = W_B + (size_t)1024 * 512 * 2;
constexpr size_t SM_GDEC = W_OUT + (size_t)1024 * 1024 * 2;
constexpr size_t SM_BETA = al(SM_GDEC + (size_t)TT * 16);
constexpr size_t SM_ROWSS = al(SM_BETA + (size_t)TT * 16);
constexpr size_t Z1 = al(SM_ROWSS + (size_t)TT * 4);
constexpr size_t Z1_SIZE = (size_t)TT * 3072 * 2;
constexpr size_t RB = al(Z1 + Z1_SIZE);
constexpr size_t D_QF = RB;
constexpr size_t D_KCD = D_QF + (size_t)1024 * 16384;
constexpr size_t D_KNT = D_KCD + (size_t)1024 * 16384;
constexpr size_t D_VALT = D_KNT + (size_t)1024 * 16384;
constexpr size_t D_ATT = D_VALT + (size_t)1024 * 16384;
constexpr size_t D_GC = D_ATT + (size_t)1024 * 8192;
constexpr size_t H_QG = D_GC + (size_t)1024 * 256;
constexpr size_t H_KGT = H_QG + (size_t)2048 * 8192;
constexpr size_t H_VT = H_KGT + (size_t)2048 * 8192;
constexpr size_t H_ATT = H_VT + (size_t)2048 * 8192;
constexpr size_t H_EBL = H_ATT + (size_t)2048 * 2048;
constexpr size_t RB_END1 = H_EBL + (size_t)2048 * 512;
constexpr size_t Z2 = RB;
constexpr size_t X1B = RB;
constexpr size_t ACT = RB + (size_t)TT * 1024 * 2;
constexpr size_t RB_END2 = ACT + (size_t)TT * DFF * 2;
constexpr size_t WS_NEED = (RB_END1 > RB_END2 ? RB_END1 : RB_END2);
constexpr size_t BAR_OFF = al(WS_NEED);
constexpr size_t Z2S = BAR_OFF + 16384;
static_assert(Z2S + (size_t)TS * 3072 * 2 <= (size_t)268435456, "workspace too large");
constexpr size_t W_GU = Z1;
constexpr size_t W_DOWN = W_GU + (size_t)5632 * 1024 * 2;
constexpr size_t MIX = W_DOWN + (size_t)1024 * DFF * 2;
constexpr size_t HALO_G = MIX + (size_t)TT * 1024 * 2;
constexpr size_t HEAD_G = HALO_G + (size_t)264 * 2 * DFF * 4;
constexpr size_t HEAD_U = HEAD_G + (size_t)264 * 2 * DFF * 4;
constexpr size_t PART = HEAD_U + (size_t)264 * 2 * DFF * 4;
static_assert(PART + (size_t)11 * TS * 1024 * 4 <= Z1 + Z1_SIZE, "z1 reuse overflow");
constexpr size_t YB_H = 0;
constexpr size_t YB_OA = (size_t)TT * 1024 * 2;
constexpr size_t YB_OB = YB_OA + (size_t)TT * 512 * 2;

struct Params {
  const float *x_prompt, *x_sample, *cache_conv, *state_delta, *state_hgrn, *cache_ffn;
  const float *g_attn, *w_in, *w_conv_a, *a_log, *dt_bias, *g_out_a, *w_branch_a, *lb_logits, *g_out_b,
      *w_branch_b, *w_out, *g_ffn, *w_ffn_gate, *w_ffn_up, *w_ffn_conv, *w_ffn_down, *g_final;
  float* out;
  char* ws;
};

__device__ __forceinline__ const unsigned short* z2row(const Params& p, int row) {
  return row < TP ? reinterpret_cast<const unsigned short*>(p.ws + Z2) + (size_t)row * 3072
                  : reinterpret_cast<const unsigned short*>(p.ws + Z2S) + (size_t)(row - TP) * 3072;
}
typedef __bf16 bf16x2_t __attribute__((ext_vector_type(2)));
typedef float f32x2_t __attribute__((ext_vector_type(2)));
__device__ __forceinline__ unsigned pack2(float a, float b) {
  f32x2_t v = {a, b};
  bf16x2_t r = __builtin_convertvector(v, bf16x2_t);
  return __builtin_bit_cast(unsigned, r);
}
__device__ __forceinline__ u16 f2bf(float f) { return (u16)(pack2(f, 0.f) & 0xffffu); }
__device__ __forceinline__ float bf2f(u16 h) { return __uint_as_float(((unsigned)h) << 16); }
__device__ __forceinline__ float lo2f(unsigned u) { return __uint_as_float(u << 16); }
__device__ __forceinline__ float hi2f(unsigned u) { return __uint_as_float(u & 0xffff0000u); }
__device__ __forceinline__ float silu_f(float x) { return x * __builtin_amdgcn_rcpf(1.f + __expf(-x)); }
__device__ __forceinline__ float sigmoid_f(float x) { return __builtin_amdgcn_rcpf(1.f + __expf(-x)); }
#define DPP_ADD(v, ctrl, rmask) v += __int_as_float(__builtin_amdgcn_update_dpp(0, __float_as_int(v), ctrl, rmask, 0xf, false))
__device__ __forceinline__ float wave_sum(float v) {
  DPP_ADD(v, 0xB1, 0xf);
  DPP_ADD(v, 0x4E, 0xf);
  DPP_ADD(v, 0x141, 0xf);
  DPP_ADD(v, 0x140, 0xf);
  DPP_ADD(v, 0x142, 0xa);
  DPP_ADD(v, 0x143, 0xc);
  return __int_as_float(__builtin_amdgcn_readlane(__float_as_int(v), 63));
}
__device__ __forceinline__ void lds_barrier() {
  __builtin_amdgcn_fence(__ATOMIC_RELEASE, "workgroup", "local");
  __builtin_amdgcn_s_barrier();
  __builtin_amdgcn_fence(__ATOMIC_ACQUIRE, "workgroup", "local");
}
__device__ __forceinline__ f32x4 mfma16(bf16x8 a, bf16x8 b, f32x4 c) {
  return __builtin_amdgcn_mfma_f32_16x16x32_bf16(a, b, c, 0, 0, 0);
}
__device__ __forceinline__ bf16x8 lds_frag(const u16* base, int ld, int row0, int k0, int lane) {
  return *reinterpret_cast<const bf16x8*>(base + (row0 + (lane & 15)) * ld + k0 + 8 * (lane >> 4));
}
__device__ __forceinline__ void store_frags(const u16* lds, int ld, int R, int K, u16* dst, int t, int nt) {
  const int nkb = K >> 5, total = (R >> 4) * nkb * 64;
  for (int idx = t; idx < total; idx += nt) {
    int f = idx >> 6, pl = idx & 63, rb = f / nkb, kb = f - rb * nkb;
    uint4 v = *reinterpret_cast<const uint4*>(lds + (rb * 16 + (pl & 15)) * ld + kb * 32 + 8 * (pl >> 4));
    *reinterpret_cast<uint4*>(dst + (size_t)idx * 8) = v;
  }
}
__device__ __forceinline__ void store_frags_T(const u16* lds, int ld, int R2, int K2, u16* dst, int t, int nt) {
  const int nkb = K2 >> 5, total = (R2 >> 4) * nkb * 64;
  for (int idx = t; idx < total; idx += nt) {
    int f = idx >> 6, pl = idx & 63, rb = f / nkb, kb = f - rb * nkb;
    int d = rb * 16 + (pl & 15), c0 = kb * 32 + 8 * (pl >> 4);
    unsigned r[4];
#pragma unroll
    for (int j = 0; j < 4; ++j) {
      unsigned a = lds[(c0 + 2 * j) * ld + d], b = lds[(c0 + 2 * j + 1) * ld + d];
      r[j] = a | (b << 16);
    }
    *reinterpret_cast<uint4*>(dst + (size_t)idx * 8) = make_uint4(r[0], r[1], r[2], r[3]);
  }
}

#define XB_TMO 128
#define XB_XCNT(j) (256 + 64 * (j))
#define XB_XSUB(j) (1280 + 64 * (j))
#define XB_XGEN(j) (2304 + 64 * (j))
#define XB_TOP 3328
#define XB_TOPGEN 3392
#define XCD_BAR_WORDS 3456
#define XB_SPIN_CAP (1u << 18)
#define LAS __attribute__((address_space(3)))
__device__ __forceinline__ unsigned xb_ld(unsigned* p) { return __hip_atomic_load(p, __ATOMIC_RELAXED, __HIP_MEMORY_SCOPE_AGENT); }
__device__ __forceinline__ unsigned xb_add(unsigned* p, unsigned v) { return __hip_atomic_fetch_add(p, v, __ATOMIC_RELAXED, __HIP_MEMORY_SCOPE_AGENT); }
__device__ __forceinline__ unsigned xb_xcc_id() { return (unsigned)__builtin_amdgcn_s_getreg((3 << 11) | 20) & 0xFu; }
#define XB_SPIN(cond, bar) do { unsigned _sp = 0; while (cond) { __builtin_amdgcn_s_sleep(1); \
    if ((++_sp & 255u) == 0u) { if (xb_ld(&(bar)[XB_TMO])) break; if (_sp > XB_SPIN_CAP) { atomicAdd(&(bar)[XB_TMO], 1u); break; } } } } while (0)
struct XcdBarrier { unsigned* bar; unsigned x; volatile LAS unsigned* st; };
__device__ __forceinline__ XcdBarrier xcd_barrier_post(unsigned* bar, volatile LAS unsigned* st) {
  XcdBarrier b; b.bar = bar; b.x = xb_xcc_id(); b.st = st;
  if (threadIdx.x == 0) (void)xb_add(&bar[XB_XCNT(b.x)], 1u);
  return b;
}
__device__ __forceinline__ void xcd_barrier_complete(unsigned* bar, unsigned x, unsigned& nloc, unsigned& nx) {
  const unsigned G = gridDim.x * gridDim.y * gridDim.z;
  unsigned sum, cnt, mine, sp = 0u;
  for (;;) {
    sum = 0u; cnt = 0u; mine = 0u;
#pragma unroll
    for (unsigned j = 0; j < 16; ++j) { const unsigned c = xb_ld(&bar[XB_XCNT(j)]); sum += c; cnt += (c > 0u) ? 1u : 0u; mine = (j == x) ? c : mine; }
    if (sum == G) break;
    __builtin_amdgcn_s_sleep(1);
    if ((++sp & 255u) == 0u) { if (xb_ld(&bar[XB_TMO])) break; if (sp > XB_SPIN_CAP) { atomicAdd(&bar[XB_TMO], 1u); break; } }
  }
  nloc = mine > 0u ? mine : 1u; nx = cnt > 0u ? cnt : 1u;
}
__device__ __forceinline__ void xcd_barrier(const XcdBarrier& b) {
  asm volatile("s_waitcnt vmcnt(0)" ::: "memory");
  __syncthreads();
  if (threadIdx.x == 0) {
    unsigned* bar = b.bar;
    __builtin_amdgcn_s_waitcnt(0);
    unsigned nloc = b.st[0], nx = b.st[1];
    if (nloc == 0u) { xcd_barrier_complete(bar, b.x, nloc, nx); b.st[0] = nloc; b.st[1] = nx; }
    const unsigned old = xb_add(&bar[XB_XSUB(b.x)], 1u);
    const unsigned gen = old / nloc;
    if (old + 1u == (gen + 1u) * nloc) {
      __builtin_amdgcn_fence(__ATOMIC_RELEASE, "agent");
      asm volatile("s_waitcnt vmcnt(0)" ::: "memory");
      const unsigned og = xb_add(&bar[XB_TOP], 1u);
      const unsigned tg = og / nx;
      if (og + 1u == (tg + 1u) * nx) xb_add(&bar[XB_TOPGEN], 1u);
      else XB_SPIN(xb_ld(&bar[XB_TOPGEN]) == tg, bar);
      __builtin_amdgcn_fence(__ATOMIC_ACQUIRE, "agent");
      xb_add(&bar[XB_XGEN(b.x)], 1u);
      asm volatile("s_waitcnt vmcnt(0)" ::: "memory");
    } else {
      XB_SPIN(xb_ld(&bar[XB_XGEN(b.x)]) == gen, bar);
      __builtin_amdgcn_fence(__ATOMIC_ACQUIRE, "agent");
      asm volatile("s_waitcnt vmcnt(0)" ::: "memory");
    }
  }
  __syncthreads();
}

__device__ __forceinline__ void wt_block(const float* __restrict__ src, int ld, int K, u16* __restrict__ dst, const float* __restrict__ kscale,
                         float* lds) {
  const int t = VTID;
  for (int k0 = 0; k0 < K; k0 += 64) {
    {
      int n = t & 31, kk = t >> 5;
#pragma unroll
      for (int i = 0; i < 8; ++i) {
        int k = kk + 8 * i;
        float v = src[(size_t)(k0 + k) * ld + n];
        if (kscale) v *= kscale[k0 + k];
        lds[k * 33 + n] = v;
      }
    }
    __syncthreads();
    {
      int kp = t & 31, nn = t >> 5;
#pragma unroll
      for (int i = 0; i < 4; ++i) {
        int n = nn + 8 * i;
        unsigned v = pack2(lds[(2 * kp) * 33 + n], lds[(2 * kp + 1) * 33 + n]);
        *reinterpret_cast<unsigned*>(dst + (size_t)n * K + k0 + 2 * kp) = v;
      }
    }
    __syncthreads();
  }
}

__device__ __forceinline__ void wt_chunk(const float* __restrict__ src, int ld, int K, u16* __restrict__ dst, const float* __restrict__ kscale, float* lds, int k0) {
  const int t = VTID;
  {
    const int n = t & 31, kk = t >> 5;
    float v[32];
#pragma unroll
    for (int i = 0; i < 32; ++i) v[i] = src[(size_t)(k0 + kk + 8 * i) * ld + n];
    if (kscale) {
#pragma unroll
      for (int i = 0; i < 32; ++i) v[i] *= kscale[k0 + kk + 8 * i];
    }
#pragma unroll
    for (int i = 0; i < 32; ++i) lds[(kk + 8 * i) * 33 + n] = v[i];
  }
  __syncthreads();
  {
    const int kp = t & 127, nn = t >> 7;
#pragma unroll
    for (int i = 0; i < 16; ++i) {
      const int n = nn + 2 * i;
      *reinterpret_cast<unsigned*>(dst + (size_t)n * K + k0 + 2 * kp) = pack2(lds[(2 * kp) * 33 + n], lds[(2 * kp + 1) * 33 + n]);
    }
  }
  __syncthreads();
}

__device__ __forceinline__ void phase_prep(const Params& p, char* smem, int bid, int nb, int part) {
  float* wab = reinterpret_cast<float*>(smem);
  float* tl = reinterpret_cast<float*>(smem + 32768);
  const int t = VTID, lane = t & 63, w = t >> 6;
  for (int i = t; i < 8192; i += NTHR) wab[i] = p.w_in[(size_t)(i >> 3) * NIN + 1536 + (i & 7)];
  if (part == 0) { for (int i = bid * NTHR + t; i < TT; i += nb * NTHR) reinterpret_cast<float*>(p.ws + SM_ROWSS)[i] = 0.f; }
  __syncthreads();
  const int NWT = 384 + 384 + 64 + 64 + 128;
  const int NL = part == 0 ? 384 + 128 : 640 + 4096;
  const int lb = part == 0 ? bid : bid - 48, ln = part == 0 ? nb : nb - 48;
  for (int li = lb; li >= 0 && li < NL; li += ln) {
    const int item = part == 0 ? (li < 384 ? li : NWT + 4096 + (li - 384)) : (li < 640 ? 384 + li : NWT + (li - 640));
    if (item < NWT) {
      if (item < 384) {
        int n = (item >> 2) * 32, k0 = (item & 3) * 256;
        int col = n < 1536 ? n : 2056 + (n - 1536);
        wt_chunk(p.w_in + col, NIN, 1024, reinterpret_cast<u16*>(p.ws + W_MAIN) + (size_t)n * 1024, nullptr, tl, k0);
      } else if (item < 768) {
        int n = ((item - 384) >> 2) * 32, k0 = (item & 3) * 256;
        int col = n < 2048 ? 4104 + n : (n < 2560 ? 1544 + (n - 2048) : 3592 + (n - 2560));
        wt_chunk(p.w_in + col, NIN, 1024, reinterpret_cast<u16*>(p.ws + W_G2) + (size_t)n * 1024, nullptr, tl, k0);
      } else if (item < 832) {
        int n = ((item - 768) >> 1) * 32, k0 = (item & 1) * 256;
        wt_chunk(p.w_branch_a + n, 1024, 512, reinterpret_cast<u16*>(p.ws + W_A) + (size_t)n * 512, nullptr, tl, k0);
      } else if (item < 896) {
        int n = ((item - 832) >> 1) * 32, k0 = (item & 1) * 256;
        wt_chunk(p.w_branch_b + n, 1024, 512, reinterpret_cast<u16*>(p.ws + W_B) + (size_t)n * 512, nullptr, tl, k0);
      } else {
        int n = ((item - 896) >> 2) * 32, k0 = (item & 3) * 256;
        wt_chunk(p.w_out + n, 1024, 1024, reinterpret_cast<u16*>(p.ws + W_OUT) + (size_t)n * 1024, nullptr, tl, k0);
      }
    } else {
      int row = (item - NWT) * 4 + w;
      const float* x = row < TP ? p.x_prompt + (size_t)row * DM : p.x_sample + (size_t)(row - TP) * DM;
      float4 xv[4];
      float ss = 0.f;
#pragma unroll
      for (int i = 0; i < 4; ++i) {
        xv[i] = *reinterpret_cast<const float4*>(x + i * 256 + lane * 4);
        ss += xv[i].x * xv[i].x + xv[i].y * xv[i].y + xv[i].z * xv[i].z + xv[i].w * xv[i].w;
      }
      ss = wave_sum(ss);
      float rstd = rsqrtf(ss * (1.f / DM) + EPS);
      float dot[8];
#pragma unroll
      for (int c = 0; c < 8; ++c) dot[c] = 0.f;
      u16* hrow = reinterpret_cast<u16*>(reinterpret_cast<char*>(p.out) + YB_H) + (size_t)row * DM;
#pragma unroll
      for (int i = 0; i < 4; ++i) {
        int k = i * 256 + lane * 4;
        float4 g = *reinterpret_cast<const float4*>(p.g_attn + k);
        float h0 = xv[i].x * rstd * g.x, h1 = xv[i].y * rstd * g.y, h2 = xv[i].z * rstd * g.z, h3 = xv[i].w * rstd * g.w;
        *reinterpret_cast<uint2*>(hrow + k) = make_uint2(pack2(h0, h1), pack2(h2, h3));
        float hh[4] = {h0, h1, h2, h3};
#pragma unroll
        for (int j = 0; j < 4; ++j) {
          float4 wa = *reinterpret_cast<const float4*>(wab + (k + j) * 8);
          float4 wb = *reinterpret_cast<const float4*>(wab + (k + j) * 8 + 4);
          dot[0] += hh[j] * wa.x; dot[1] += hh[j] * wa.y; dot[2] += hh[j] * wa.z; dot[3] += hh[j] * wa.w;
          dot[4] += hh[j] * wb.x; dot[5] += hh[j] * wb.y; dot[6] += hh[j] * wb.z; dot[7] += hh[j] * wb.w;
        }
      }
#pragma unroll
      for (int c = 0; c < 8; ++c) dot[c] = wave_sum(dot[c]);
      if (lane < 4) {
        float aa = lane == 0 ? dot[0] : lane == 1 ? dot[1] : lane == 2 ? dot[2] : dot[3];
        float xx = aa + p.dt_bias[lane];
        float sp = xx > 20.f ? xx : log1pf(__expf(xx));
        reinterpret_cast<float*>(p.ws + SM_GDEC)[(size_t)row * 4 + lane] = -__expf(p.a_log[lane]) * sp;
      } else if (lane < 8) {
        float ba = lane == 4 ? dot[4] : lane == 5 ? dot[5] : lane == 6 ? dot[6] : dot[7];
        reinterpret_cast<float*>(p.ws + SM_BETA)[(size_t)row * 4 + lane - 4] = sigmoid_f(ba);
      }
    }
  }
}

enum { EPI_Z1 = 0, EPI_Z2 = 1, EPI_MIXA = 2, EPI_MIXB = 3, EPI_WOUT = 4, EPI_FFN1 = 5, EPI_FFN2 = 6, EPI_FFN2S = 7, EPI_FFN1S = 8 };
namespace pg8 {
constexpr int BM = 256, BK = 64, HALF = 128, HTB = HALF * BK * 2, STAGE_BYTES = 8 * HTB, NXCD = 8, WGM = 8;
__device__ __forceinline__ int lds_byte(int r, int c) { const int st = (r >> 4) * 2 + (c >> 5), rr = r & 15, cc = c & 31, ob = rr * 64 + cc * 2; return st * 1024 + (ob ^ (((ob >> 9) & 1) << 5)); }
__device__ __forceinline__ void stage_rc(int b, int& R, int& C) { const int st = b / 1024, sb = b % 1024, swz = sb ^ (((sb >> 9) & 1) << 5); R = (st >> 1) * 16 + swz / 64; C = (st & 1) * 32 + (swz % 64) / 2; }
__device__ __forceinline__ int perm32(int rho) { const int n = rho >> 4, i = rho & 15; return 8 * (i >> 2) + 4 * n + (i & 3); }
struct Unit { int pm, pn, ks; };
struct StaticOrder {
  int nM, nN, nwg, G, c;
  __device__ void init(int M, int N, int G_, int c_) { nM = M / BM; nN = N / BM; nwg = nM * nN; G = G_; c = c_; }
  __device__ bool next(int i, Unit& u) const {
    const long L = (long)i * G + c; if (L >= nwg) return false;
    int wgid = (int)L; { const int q = nwg / NXCD, r = nwg % NXCD, xcd = wgid % NXCD, off = wgid / NXCD; wgid = (xcd < r ? xcd * (q + 1) : r * (q + 1) + (xcd - r) * q) + off; }
    const int nig = WGM * nN, gid = wgid / nig, fm = gid * WGM, gsz = (nM - fm) < WGM ? (nM - fm) : WGM;
    u.pm = fm + ((wgid % nig) % gsz); u.pn = (wgid % nig) / gsz; return true;
  }
};
struct SchedStatic {
  StaticOrder S; int pm0;
  __device__ void init(int M, int N, int G, int c, int pm0_) { S.init(M, N, G, c); pm0 = pm0_; }
  __device__ bool next(int i, Unit& u) const { if (S.c >= S.G || !S.next(i, u)) return false; u.pm += pm0; u.ks = 0; return true; }
};
struct SchedSplit {
  int nN, nS, pm0, G, c, total;
  __device__ void init(int nM, int nN_, int nS_, int G_, int c_, int pm0_) { nN = nN_; nS = nS_; pm0 = pm0_; G = G_; c = c_; total = nM * nN_ * nS_; }
  __device__ bool next(int i, Unit& u) const {
    const int L = i * G + c; if (c >= G || L >= total) return false;
    u.ks = L % nS; const int t = L / nS; u.pn = t % nN; u.pm = pm0 + t / nN; return true;
  }
};
}

__device__ __forceinline__ float dpp_ror1(float v) { return __int_as_float(__builtin_amdgcn_update_dpp(0, __float_as_int(v), 0x121, 0xf, 0xf, false)); }
__device__ __forceinline__ float dpp_ror2(float v) { return __int_as_float(__builtin_amdgcn_update_dpp(0, __float_as_int(v), 0x122, 0xf, 0xf, false)); }

template <int MODE>
__device__ __forceinline__ void gemm_epilogue(const Params& p, f32x4 (&acc)[2][2][4][2], const pg8::Unit& u, int wr, int wc, int fr, int fq) {
  const int row0 = u.pm * 256 + wr * 64 + fr, col0 = u.pn * 256 + wc * 32 + 8 * fq;
  if constexpr (MODE == EPI_Z1 || MODE == EPI_Z2) {
#pragma unroll
    for (int ai = 0; ai < 2; ++ai)
#pragma unroll
      for (int m = 0; m < 4; ++m) {
        const int row = row0 + ai * 128 + m * 16;
        u16* rowp = (MODE == EPI_Z1 ? reinterpret_cast<u16*>(p.ws + Z1) + (size_t)row * 3072 : const_cast<u16*>(z2row(p, row))) + col0;
#pragma unroll
        for (int bj = 0; bj < 2; ++bj) {
          const f32x4 v0 = acc[ai][bj][m][0], v1 = acc[ai][bj][m][1];
          *reinterpret_cast<uint4*>(rowp + bj * 128) = make_uint4(pack2(v0[0], v0[1]), pack2(v0[2], v0[3]), pack2(v1[0], v1[1]), pack2(v1[2], v1[3]));
        }
        if (MODE == EPI_Z1 && u.pn < 6) {
          float* dst = nullptr;
          if (row < TP) {
            int pos = row & 2047;
            if (pos >= 2045) dst = p.out + O_CONVP + (size_t)((row >> 11) * 3 + pos - 2045) * 1536 + col0;
          } else {
            int pos = (row - TP) & 3;
            if (pos >= 1) dst = p.out + O_CONVS + (size_t)(((row - TP) >> 2) * 3 + pos - 1) * 1536 + col0;
          }
          if (dst) {
#pragma unroll
            for (int bj = 0; bj < 2; ++bj) {
              const f32x4 v0 = acc[ai][bj][m][0], v1 = acc[ai][bj][m][1];
              *reinterpret_cast<float4*>(dst + bj * 128) = make_float4(v0[0], v0[1], v0[2], v0[3]);
              *reinterpret_cast<float4*>(dst + bj * 128 + 4) = make_float4(v1[0], v1[1], v1[2], v1[3]);
            }
          }
        }
      }
  } else if constexpr (MODE == EPI_MIXA || MODE == EPI_MIXB) {
    u16* Mx = reinterpret_cast<u16*>(p.ws + MIX);
#pragma unroll
    for (int ai = 0; ai < 2; ++ai)
#pragma unroll
      for (int m = 0; m < 4; ++m) {
        const int row = row0 + ai * 128 + m * 16;
#pragma unroll
        for (int bj = 0; bj < 2; ++bj) {
          const int col = col0 + bj * 128;
          const uint4 gv = *reinterpret_cast<const uint4*>(z2row(p, row) + (MODE == EPI_MIXB ? 1024 : 0) + col);
          u16* mp = Mx + (size_t)row * 1024 + col;
          const f32x4 v0 = acc[ai][bj][m][0], v1 = acc[ai][bj][m][1];
          float r0 = v0[0] * sigmoid_f(lo2f(gv.x)), r1 = v0[1] * sigmoid_f(hi2f(gv.x));
          float r2 = v0[2] * sigmoid_f(lo2f(gv.y)), r3 = v0[3] * sigmoid_f(hi2f(gv.y));
          float r4 = v1[0] * sigmoid_f(lo2f(gv.z)), r5 = v1[1] * sigmoid_f(hi2f(gv.z));
          float r6 = v1[2] * sigmoid_f(lo2f(gv.w)), r7 = v1[3] * sigmoid_f(hi2f(gv.w));
          if (MODE == EPI_MIXB) {
            const uint4 mv = *reinterpret_cast<const uint4*>(mp);
            r0 += lo2f(mv.x); r1 += hi2f(mv.x); r2 += lo2f(mv.y); r3 += hi2f(mv.y);
            r4 += lo2f(mv.z); r5 += hi2f(mv.z); r6 += lo2f(mv.w); r7 += hi2f(mv.w);
          }
          *reinterpret_cast<uint4*>(mp) = make_uint4(pack2(r0, r1), pack2(r2, r3), pack2(r4, r5), pack2(r6, r7));
        }
        asm volatile("" ::: "memory");
      }
  } else if constexpr (MODE == EPI_WOUT) {
    float* rowss = reinterpret_cast<float*>(p.ws + SM_ROWSS);
    u16* XB = reinterpret_cast<u16*>(p.ws + X1B);
#pragma unroll
    for (int ai = 0; ai < 2; ++ai)
#pragma unroll
      for (int m = 0; m < 4; ++m) {
        const int row = row0 + ai * 128 + m * 16;
        const float* x = (row < TP ? p.x_prompt + (size_t)row * DM : p.x_sample + (size_t)(row - TP) * DM) + col0;
        float* y = p.out + O_YP + (size_t)row * DM + col0;
        float ss = 0.f;
#pragma unroll
        for (int bj = 0; bj < 2; ++bj) {
          const float4 x0 = *reinterpret_cast<const float4*>(x + bj * 128), x1 = *reinterpret_cast<const float4*>(x + bj * 128 + 4);
          const f32x4 a0 = acc[ai][bj][m][0], a1 = acc[ai][bj][m][1];
          const float4 v0 = make_float4(a0[0] + x0.x, a0[1] + x0.y, a0[2] + x0.z, a0[3] + x0.w);
          const float4 v1 = make_float4(a1[0] + x1.x, a1[1] + x1.y, a1[2] + x1.z, a1[3] + x1.w);
          *reinterpret_cast<float4*>(y + bj * 128) = v0;
          *reinterpret_cast<float4*>(y + bj * 128 + 4) = v1;
          *reinterpret_cast<uint4*>(XB + (size_t)row * DM + col0 + bj * 128) =
              make_uint4(pack2(v0.x, v0.y), pack2(v0.z, v0.w), pack2(v1.x, v1.y), pack2(v1.z, v1.w));
          ss += v0.x * v0.x + v0.y * v0.y + v0.z * v0.z + v0.w * v0.w + v1.x * v1.x + v1.y * v1.y + v1.z * v1.z + v1.w * v1.w;
        }
        ss += __shfl_xor(ss, 16, 64);
        ss += __shfl_xor(ss, 32, 64);
        if (fq == 0) atomicAdd(rowss + row, ss);
        asm volatile("" ::: "memory");
      }
  } else if constexpr (MODE == EPI_FFN2) {
#pragma unroll
    for (int ai = 0; ai < 2; ++ai)
#pragma unroll
      for (int m = 0; m < 4; ++m) {
        float* y = p.out + O_YP + (size_t)(row0 + ai * 128 + m * 16) * DM + col0;
#pragma unroll
        for (int bj = 0; bj < 2; ++bj) {
          float4 y0 = *reinterpret_cast<const float4*>(y + bj * 128), y1 = *reinterpret_cast<const float4*>(y + bj * 128 + 4);
          const f32x4 a0 = acc[ai][bj][m][0], a1 = acc[ai][bj][m][1];
          y0.x += a0[0]; y0.y += a0[1]; y0.z += a0[2]; y0.w += a0[3];
          y1.x += a1[0]; y1.y += a1[1]; y1.z += a1[2]; y1.w += a1[3];
          *reinterpret_cast<float4*>(y + bj * 128) = y0;
          *reinterpret_cast<float4*>(y + bj * 128 + 4) = y1;
        }
        asm volatile("" ::: "memory");
      }
  } else if constexpr (MODE == EPI_FFN2S) {
    float* part = reinterpret_cast<float*>(p.ws + PART) + (size_t)u.ks * TS * 1024;
#pragma unroll
    for (int ai = 0; ai < 2; ++ai)
#pragma unroll
      for (int m = 0; m < 4; ++m) {
        float* y = part + (size_t)(row0 + ai * 128 + m * 16 - TP) * 1024 + col0;
#pragma unroll
        for (int bj = 0; bj < 2; ++bj) {
          const f32x4 a0 = acc[ai][bj][m][0], a1 = acc[ai][bj][m][1];
          *reinterpret_cast<float4*>(y + bj * 128) = make_float4(a0[0], a0[1], a0[2], a0[3]);
          *reinterpret_cast<float4*>(y + bj * 128 + 4) = make_float4(a1[0], a1[1], a1[2], a1[3]);
        }
      }
  } else if constexpr (MODE == EPI_FFN1 || MODE == EPI_FFN1S) {
    const float* rowss = reinterpret_cast<const float*>(p.ws + SM_ROWSS);
    u16* ACTp = reinterpret_cast<u16*>(p.ws + ACT);
    float* haloG = reinterpret_cast<float*>(p.ws + HALO_G);
    float* headG = reinterpret_cast<float*>(p.ws + HEAD_G);
    float* headU = reinterpret_cast<float*>(p.ws + HEAD_U);
    const int ch = u.pn * 128 + wc * 32 + 8 * fq;
    float w0[8], w1[8], w2[8];
#pragma unroll
    for (int c = 0; c < 8; ++c) { w0[c] = p.w_ffn_conv[ch + c]; w1[c] = p.w_ffn_conv[DFF + ch + c]; w2[c] = p.w_ffn_conv[2 * DFF + ch + c]; }
    if constexpr (MODE == EPI_FFN1) {
#pragma unroll
      for (int ai = 0; ai < 2; ++ai) {
        const int blk = u.pm * 4 + ai * 2 + wr;
        const bool seqstart = (blk & 31) == 0, seqend = (blk & 31) == 31;
        float gprev[8];
#pragma unroll
        for (int c = 0; c < 8; ++c) gprev[c] = 0.f;
#pragma unroll
        for (int m = 0; m < 4; ++m) {
          const int row = row0 + ai * 128 + m * 16;
          const float rs = rsqrtf(rowss[row] * (1.f / DM) + EPS);
          float g0[8], uu[8];
#pragma unroll
          for (int c = 0; c < 4; ++c) {
            g0[c] = acc[ai][0][m][0][c] * rs; g0[4 + c] = acc[ai][0][m][1][c] * rs;
            uu[c] = acc[ai][1][m][0][c] * rs; uu[4 + c] = acc[ai][1][m][1][c] * rs;
          }
          float r[8];
#pragma unroll
          for (int c = 0; c < 8; ++c) {
            float gm1 = __int_as_float(__builtin_amdgcn_update_dpp(__float_as_int(dpp_ror1(gprev[c])), __float_as_int(g0[c]), 0x111, 0xf, 0xf, false));
            float gm2 = __int_as_float(__builtin_amdgcn_update_dpp(__float_as_int(dpp_ror2(gprev[c])), __float_as_int(g0[c]), 0x112, 0xf, 0xf, false));
            r[c] = silu_f(w0[c] * gm2 + w1[c] * gm1 + w2[c] * g0[c]) * uu[c];
          }
          bool defer = false;
          if (m == 0) {
            defer = !seqstart && fr < 2;
            if (defer) {
              float* dg = headG + (size_t)(blk * 2 + fr) * DFF + ch;
              float* du = headU + (size_t)(blk * 2 + fr) * DFF + ch;
              *reinterpret_cast<float4*>(dg) = make_float4(g0[0], g0[1], g0[2], g0[3]);
              *reinterpret_cast<float4*>(dg + 4) = make_float4(g0[4], g0[5], g0[6], g0[7]);
              *reinterpret_cast<float4*>(du) = make_float4(uu[0], uu[1], uu[2], uu[3]);
              *reinterpret_cast<float4*>(du + 4) = make_float4(uu[4], uu[5], uu[6], uu[7]);
            }
          }
          if (m == 3) {
            if (fr >= 14) {
              float* d = haloG + (size_t)(blk * 2 + fr - 14) * DFF + ch;
              *reinterpret_cast<float4*>(d) = make_float4(g0[0], g0[1], g0[2], g0[3]);
              *reinterpret_cast<float4*>(d + 4) = make_float4(g0[4], g0[5], g0[6], g0[7]);
              if (seqend) {
                float* o = p.out + O_FFNP + (size_t)((row >> 11) * 2 + fr - 14) * DFF + ch;
                *reinterpret_cast<float4*>(o) = make_float4(g0[0], g0[1], g0[2], g0[3]);
                *reinterpret_cast<float4*>(o + 4) = make_float4(g0[4], g0[5], g0[6], g0[7]);
              }
            }
          }
          if (!defer)
            *reinterpret_cast<uint4*>(ACTp + (size_t)row * DFF + ch) = make_uint4(pack2(r[0], r[1]), pack2(r[2], r[3]), pack2(r[4], r[5]), pack2(r[6], r[7]));
#pragma unroll
          for (int c = 0; c < 8; ++c) gprev[c] = g0[c];
          asm volatile("" ::: "memory");
        }
      }
    } else {
#pragma unroll
    for (int ai = 0; ai < 2; ++ai) {
      const int blk = u.pm * 4 + ai * 2 + wr;
      float gprev[8];
#pragma unroll
      for (int c = 0; c < 8; ++c) gprev[c] = 0.f;
#pragma unroll
      for (int m = 0; m < 4; ++m) {
        const int row = row0 + ai * 128 + m * 16;
        const int r64 = m * 16 + fr;
        const float rs = rsqrtf(rowss[row] * (1.f / DM) + EPS);
        float g0[8], uu[8];
#pragma unroll
        for (int c = 0; c < 4; ++c) {
          g0[c] = acc[ai][0][m][0][c] * rs; g0[4 + c] = acc[ai][0][m][1][c] * rs;
          uu[c] = acc[ai][1][m][0][c] * rs; uu[4 + c] = acc[ai][1][m][1][c] * rs;
        }
        const bool prompt = row < TP;
        int pos, b;
        if (prompt) { pos = row & 2047; b = row >> 11; } else { pos = (row - TP) & 3; b = (row - TP) >> 2; }
        const bool defer = (pos >= 1 && r64 < 1) || (pos >= 2 && r64 < 2);
        float gm1[8], gm2[8];
#pragma unroll
        for (int c = 0; c < 8; ++c) {
          gm1[c] = __int_as_float(__builtin_amdgcn_update_dpp(__float_as_int(dpp_ror1(gprev[c])), __float_as_int(g0[c]), 0x111, 0xf, 0xf, false));
          gm2[c] = __int_as_float(__builtin_amdgcn_update_dpp(__float_as_int(dpp_ror2(gprev[c])), __float_as_int(g0[c]), 0x112, 0xf, 0xf, false));
        }
        if (pos < 1) {
#pragma unroll
          for (int c = 0; c < 8; ++c) gm1[c] = prompt ? 0.f : p.cache_ffn[(size_t)(b * 2 + 1) * DFF + ch + c];
        }
        if (pos < 2) {
#pragma unroll
          for (int c = 0; c < 8; ++c) gm2[c] = prompt ? 0.f : p.cache_ffn[(size_t)(b * 2 + pos) * DFF + ch + c];
        }
        if (r64 >= 62) {
          float* d = haloG + (size_t)(blk * 2 + r64 - 62) * DFF + ch;
          *reinterpret_cast<float4*>(d) = make_float4(g0[0], g0[1], g0[2], g0[3]);
          *reinterpret_cast<float4*>(d + 4) = make_float4(g0[4], g0[5], g0[6], g0[7]);
        }
        {
          float* d = nullptr;
          if (prompt) { if (pos >= 2046) d = p.out + O_FFNP + (size_t)(b * 2 + pos - 2046) * DFF + ch; }
          else { if (pos >= 2) d = p.out + O_FFNS + (size_t)(b * 2 + pos - 2) * DFF + ch; }
          if (d) {
            *reinterpret_cast<float4*>(d) = make_float4(g0[0], g0[1], g0[2], g0[3]);
            *reinterpret_cast<float4*>(d + 4) = make_float4(g0[4], g0[5], g0[6], g0[7]);
          }
        }
        if (defer) {
          float* dg = headG + (size_t)(blk * 2 + r64) * DFF + ch;
          float* du = headU + (size_t)(blk * 2 + r64) * DFF + ch;
          *reinterpret_cast<float4*>(dg) = make_float4(g0[0], g0[1], g0[2], g0[3]);
          *reinterpret_cast<float4*>(dg + 4) = make_float4(g0[4], g0[5], g0[6], g0[7]);
          *reinterpret_cast<float4*>(du) = make_float4(uu[0], uu[1], uu[2], uu[3]);
          *reinterpret_cast<float4*>(du + 4) = make_float4(uu[4], uu[5], uu[6], uu[7]);
        } else {
          float r[8];
#pragma unroll
          for (int c = 0; c < 8; ++c) r[c] = silu_f(w0[c] * gm2[c] + w1[c] * gm1[c] + w2[c] * g0[c]) * uu[c];
          *reinterpret_cast<uint4*>(ACTp + (size_t)row * DFF + ch) = make_uint4(pack2(r[0], r[1]), pack2(r[2], r[3]), pack2(r[4], r[5]), pack2(r[6], r[7]));
        }
#pragma unroll
        for (int c = 0; c < 8; ++c) gprev[c] = g0[c];
        asm volatile("" ::: "memory");
      }
    }
    }
  }
}

template <int MODE, class Sched>
__device__ __forceinline__ void gemm_phase8(const Params& p, const u16* Ag, const u16* Btg, int ld, int Kunit, LAS unsigned char* lds, const Sched& S) {
  using namespace pg8;
  const int tid = threadIdx.x, wid = __builtin_amdgcn_readfirstlane(tid >> 6), lane = tid & 63, wr = wid >> 2, wc = wid & 3, fr = lane & 15, fq = lane >> 4;
  const int nt = Kunit / BK;
  unsigned voffA[2], voffB[2];
#pragma unroll
  for (int i = 0; i < 2; ++i) { int R, C; stage_rc(tid * 16 + i * 8192, R, C); const int Rb = (R & ~31) + perm32(R & 31);
    voffA[i] = (unsigned)(R * ld + C) * 2u; voffB[i] = (unsigned)(Rb * ld + C) * 2u; }
  const size_t kstep = (size_t)(BK * 2);
  const size_t hstep = (size_t)HALF * ld * 2;
  const size_t tstep = 2 * hstep;
  const size_t kub = (size_t)Kunit * 2;
  const unsigned ldsw = (unsigned)wid * 1024u;
  const int aoff = lds_byte(wr * 64 + fr, fq * 8), boff = lds_byte(wc * 32 + fr, fq * 8);
#define PG8_SA(b, h) (((b) * 2 + (h)) * HTB)
#define PG8_SB(b, h) ((4 + (b) * 2 + (h)) * HTB)
#define PG8_STAGE(bufoff, gbase, voff) do { _Pragma("unroll") for (int _i = 0; _i < 2; ++_i) \
    __builtin_amdgcn_global_load_lds((const unsigned*)((const char*)(gbase) + (voff)[_i]), (LAS unsigned*)(lds + (bufoff) + ldsw + _i * 8192), 16, 0, 0); } while (0)
#define PG8_LDA(dst, b, h) do { _Pragma("unroll") for (int m = 0; m < 4; ++m) _Pragma("unroll") for (int k = 0; k < 2; ++k) dst[m][k] = *(const LAS bf16x8*)(lds + PG8_SA(b, h) + aoff + m * 2048 + k * 1024); } while (0)
#define PG8_LDB(dst, b, h) do { _Pragma("unroll") for (int n = 0; n < 2; ++n) _Pragma("unroll") for (int k = 0; k < 2; ++k) dst[n][k] = *(const LAS bf16x8*)(lds + PG8_SB(b, h) + boff + n * 2048 + k * 1024); } while (0)
#define PG8_MMA(ai, bj, At, Bt) do { __builtin_amdgcn_s_setprio(1); _Pragma("unroll") for (int m = 0; m < 4; ++m) _Pragma("unroll") for (int n = 0; n < 2; ++n) _Pragma("unroll") for (int k = 0; k < 2; ++k) \
    acc[ai][bj][m][n] = __builtin_amdgcn_mfma_f32_16x16x32_bf16(Bt[n][k], At[m][k], acc[ai][bj][m][n], 0, 0, 0); __builtin_amdgcn_s_setprio(0); } while (0)
#define PG8_WAIT_V(n) asm volatile("s_waitcnt vmcnt(" #n ")" ::: "memory")
#define PG8_WAIT_L(n) asm volatile("s_waitcnt lgkmcnt(" #n ")" ::: "memory")
#define PG8_BAR __builtin_amdgcn_s_barrier()
#define PG8_SCHED __builtin_amdgcn_sched_barrier(0)
  Unit cur, nxt; int ui = 0;
  if (!S.next(0, cur)) return;
  f32x4 acc[2][2][4][2];
#pragma unroll
  for (int a = 0; a < 2; ++a)
#pragma unroll
    for (int b = 0; b < 2; ++b)
#pragma unroll
      for (int m = 0; m < 4; ++m)
#pragma unroll
        for (int n = 0; n < 2; ++n) acc[a][b][m][n] = (f32x4){0.f, 0.f, 0.f, 0.f};
  bf16x8 At[4][2], B0[2][2], B1[2][2];
  const char* cA = (const char*)Ag + (size_t)cur.pm * tstep + cur.ks * kub; const char* cB = (const char*)Btg + (size_t)cur.pn * tstep + cur.ks * kub;
  PG8_STAGE(PG8_SB(0, 0), cB, voffB); PG8_STAGE(PG8_SA(0, 0), cA, voffA); PG8_STAGE(PG8_SB(0, 1), cB + hstep, voffB); PG8_STAGE(PG8_SA(0, 1), cA + hstep, voffA);
  if (wr == 1) PG8_BAR;
  PG8_WAIT_V(4); PG8_BAR;
  PG8_STAGE(PG8_SB(1, 0), cB + kstep, voffB); PG8_STAGE(PG8_SA(1, 0), cA + kstep, voffA); PG8_STAGE(PG8_SB(1, 1), cB + hstep + kstep, voffB);
  PG8_WAIT_V(6); PG8_BAR;
  for (;;) {
    const bool has_next = S.next(ui + 1, nxt);
    const char* nA = has_next ? (const char*)Ag + (size_t)nxt.pm * tstep + nxt.ks * kub : cA; const char* nB = has_next ? (const char*)Btg + (size_t)nxt.pn * tstep + nxt.ks * kub : cB;
    for (int t = 0; t < nt; t += 2) {
      const bool last = (t == nt - 2);
      const char* a1 = cA + (size_t)(t + 1) * kstep;
      const char* a2 = last ? nA : cA + (size_t)(t + 2) * kstep; const char* b2 = last ? nB : cB + (size_t)(t + 2) * kstep;
      const char* a3 = a2 + kstep; const char* b3 = b2 + kstep;
      PG8_LDB(B0, 0, 0); PG8_SCHED; PG8_LDA(At, 0, 0); PG8_STAGE(PG8_SA(1, 1), a1 + hstep, voffA);
      PG8_WAIT_L(8); PG8_BAR; PG8_WAIT_L(0); PG8_MMA(0, 0, At, B0); PG8_BAR; PG8_SCHED;
      PG8_LDB(B1, 0, 1); PG8_STAGE(PG8_SB(0, 0), b2, voffB);
      PG8_BAR; PG8_WAIT_L(0); PG8_MMA(0, 1, At, B1); PG8_BAR;
      PG8_LDA(At, 0, 1); PG8_STAGE(PG8_SA(0, 0), a2, voffA);
      PG8_BAR; PG8_WAIT_L(0); PG8_MMA(1, 0, At, B0); PG8_BAR; PG8_SCHED;
      PG8_STAGE(PG8_SB(0, 1), b2 + hstep, voffB);
      PG8_WAIT_V(6); PG8_BAR; PG8_MMA(1, 1, At, B1); PG8_BAR;
      PG8_LDB(B0, 1, 0); PG8_SCHED; PG8_LDA(At, 1, 0); PG8_STAGE(PG8_SA(0, 1), a2 + hstep, voffA);
      PG8_WAIT_L(8); PG8_BAR; PG8_WAIT_L(0); PG8_MMA(0, 0, At, B0); PG8_BAR; PG8_SCHED;
      PG8_LDB(B1, 1, 1); PG8_STAGE(PG8_SB(1, 0), b3, voffB);
      PG8_BAR; PG8_WAIT_L(0); PG8_MMA(0, 1, At, B1); PG8_BAR;
      PG8_LDA(At, 1, 1); PG8_STAGE(PG8_SA(1, 0), a3, voffA);
      PG8_BAR; PG8_WAIT_L(0); PG8_MMA(1, 0, At, B0); PG8_BAR; PG8_SCHED;
      PG8_STAGE(PG8_SB(1, 1), b3 + hstep, voffB);
      PG8_WAIT_V(6); PG8_BAR; PG8_MMA(1, 1, At, B1); PG8_BAR;
    }
    gemm_epilogue<MODE>(p, acc, cur, wr, wc, fr, fq);
    if (!has_next) break;
#pragma unroll
    for (int a = 0; a < 2; ++a)
#pragma unroll
      for (int b = 0; b < 2; ++b)
#pragma unroll
        for (int m = 0; m < 4; ++m)
#pragma unroll
          for (int n = 0; n < 2; ++n) acc[a][b][m][n] = (f32x4){0.f, 0.f, 0.f, 0.f};
    cur = nxt; cA = nA; cB = nB; ++ui;
  }
  PG8_WAIT_V(0);
  if (wr == 0) PG8_BAR;
  PG8_BAR;
#undef PG8_SA
#undef PG8_SB
#undef PG8_STAGE
#undef PG8_LDA
#undef PG8_LDB
#undef PG8_MMA
#undef PG8_WAIT_V
#undef PG8_WAIT_L
#undef PG8_BAR
#undef PG8_SCHED
}


template <int PASS>
__device__ __forceinline__ void delta_rowpass(const Params& p, int t0, int n, int h, int w, int lane, float Gv, u16* RA, u16* RBk,
                                              u16* RC) {
  const u16* Zp = reinterpret_cast<const u16*>(p.ws + Z1);
  const float* betap = reinterpret_cast<const float*>(p.ws + SM_BETA);
  const int c1 = (PASS == 0 ? 0 : 512) + h * 128 + 2 * lane;
  const int c2 = (PASS == 0 ? 512 : 1024) + h * 128 + 2 * lane;
  float w1[4][2], w2[4][2];
#pragma unroll
  for (int j = 0; j < 4; ++j) {
    w1[j][0] = p.w_conv_a[j * 1536 + c1]; w1[j][1] = p.w_conv_a[j * 1536 + c1 + 1];
    w2[j][0] = p.w_conv_a[j * 1536 + c2]; w2[j][1] = p.w_conv_a[j * 1536 + c2 + 1];
  }
  const int r0 = 16 * w;
  const u16* zbase = Zp + (size_t)(t0 + r0) * 3072;
  float h1[3][2], h2[3][2];
#pragma unroll
  for (int j = 0; j < 3; ++j) {
    unsigned ua = 0u, ub = 0u;
    if (n * 64 + r0 + j - 3 >= 0) {
      ua = *reinterpret_cast<const unsigned*>(zbase + (ptrdiff_t)(j - 3) * 3072 + c1);
      ub = *reinterpret_cast<const unsigned*>(zbase + (ptrdiff_t)(j - 3) * 3072 + c2);
    }
    h1[j][0] = lo2f(ua); h1[j][1] = hi2f(ua); h2[j][0] = lo2f(ub); h2[j][1] = hi2f(ub);
  }
  unsigned qa0, qa1, qa2, qa3, qa4, qa5, qb0, qb1, qb2, qb3, qb4, qb5;
#define RLOAD(i, A_, B_) A_ = *reinterpret_cast<const unsigned*>(zbase + (size_t)(i) * 3072 + c1); B_ = *reinterpret_cast<const unsigned*>(zbase + (size_t)(i) * 3072 + c2);
  RLOAD(0, qa0, qb0) RLOAD(1, qa1, qb1) RLOAD(2, qa2, qb2) RLOAD(3, qa3, qb3) RLOAD(4, qa4, qb4) RLOAD(5, qa5, qb5)
#pragma unroll 1
  for (int rr = 0; rr < 16; ++rr) {
    const int r = r0 + rr;
    const unsigned ua = qa0, ub = qb0;
    qa0 = qa1; qa1 = qa2; qa2 = qa3; qa3 = qa4; qa4 = qa5;
    qb0 = qb1; qb1 = qb2; qb2 = qb3; qb3 = qb4; qb4 = qb5;
    if (rr + 6 < 16) { RLOAD(rr + 6, qa5, qb5) }
    const float a0 = lo2f(ua), a1 = hi2f(ua), b0 = lo2f(ub), b1 = hi2f(ub);
    float y10 = silu_f(w1[0][0] * h1[0][0] + w1[1][0] * h1[1][0] + w1[2][0] * h1[2][0] + w1[3][0] * a0);
    float y11 = silu_f(w1[0][1] * h1[0][1] + w1[1][1] * h1[1][1] + w1[2][1] * h1[2][1] + w1[3][1] * a1);
    float y20 = silu_f(w2[0][0] * h2[0][0] + w2[1][0] * h2[1][0] + w2[2][0] * h2[2][0] + w2[3][0] * b0);
    float y21 = silu_f(w2[0][1] * h2[0][1] + w2[1][1] * h2[1][1] + w2[2][1] * h2[2][1] + w2[3][1] * b1);
    const float bt = betap[(size_t)(t0 + r) * 4 + h];
    if (PASS == 0) {
      float qs = wave_sum(y10 * y10 + y11 * y11), ks = wave_sum(y20 * y20 + y21 * y21);
      float qn = rsqrtf(qs + EPS) * 0.08838834764831845f, kn = rsqrtf(ks + EPS);
      float k0 = y20 * kn, k1 = y21 * kn;
      *reinterpret_cast<unsigned*>(RA + r * 136 + 2 * lane) = pack2(k0, k1);
      *reinterpret_cast<unsigned*>(RBk + r * 136 + 2 * lane) = pack2(k0 * bt, k1 * bt);
      *reinterpret_cast<unsigned*>(RC + r * 136 + 2 * lane) = pack2(y10 * qn, y11 * qn);
    } else {
      float ks = wave_sum(y10 * y10 + y11 * y11);
      float sc = rsqrtf(ks + EPS) * bt * __expf(__shfl(Gv, r, 64));
      RA[(2 * lane) * 72 + r] = f2bf(y10 * sc);
      RA[(2 * lane + 1) * 72 + r] = f2bf(y11 * sc);
      RC[(2 * lane) * 72 + r] = f2bf(y20 * bt);
      RC[(2 * lane + 1) * 72 + r] = f2bf(y21 * bt);
    }
#pragma unroll
    for (int c = 0; c < 2; ++c) {
      h1[0][c] = h1[1][c]; h1[1][c] = h1[2][c];
      h2[0][c] = h2[1][c]; h2[1][c] = h2[2][c];
    }
    h1[2][0] = a0; h1[2][1] = a1; h2[2][0] = b0; h2[2][1] = b1;
  }
#undef RLOAD
}

__device__ __forceinline__ void m1_delta_item(const Params& p, int item, char* smem) {
  const int tid = VTID, lane = tid & 63, w = tid >> 6, lr = lane & 15, lq = lane >> 4;
  const int h = item & 3, n = (item >> 2) & 31, b = item >> 7;
  const int t0 = b * 2048 + n * 64;
  u16* RA = reinterpret_cast<u16*>(smem);
  u16* RBk = reinterpret_cast<u16*>(smem + 18432);
  u16* RC = reinterpret_cast<u16*>(smem + 36864);
  u16* RD = reinterpret_cast<u16*>(smem + 55296);
  float* Gs = reinterpret_cast<float*>(smem + 73728);
  const float* gdec = reinterpret_cast<const float*>(p.ws + SM_GDEC);

  float Gv = gdec[(size_t)(t0 + lane) * 4 + h];
#pragma unroll
  for (int o = 1; o < 64; o <<= 1) {
    float tv = __shfl_up(Gv, o, 64);
    if (lane >= o) Gv += tv;
  }
  if (w == 0) {
    Gs[lane] = Gv;
    reinterpret_cast<float*>(p.ws + D_GC)[(size_t)item * 64 + lane] = Gv;
  }
  delta_rowpass<0>(p, t0, n, h, w, lane, Gv, RA, RBk, RC);
  __syncthreads();
  {
    f32x4 accL[4], accA[4];
#pragma unroll
    for (int jb = 0; jb < 4; ++jb) { accL[jb] = (f32x4){0.f, 0.f, 0.f, 0.f}; accA[jb] = (f32x4){0.f, 0.f, 0.f, 0.f}; }
#pragma unroll
    for (int ks = 0; ks < 4; ++ks) {
      bf16x8 a1 = lds_frag(RBk, 136, 16 * w, ks * 32, lane);
      bf16x8 a2 = lds_frag(RC, 136, 16 * w, ks * 32, lane);
#pragma unroll
      for (int jb = 0; jb < 4; ++jb) {
        if (jb <= w) {
          bf16x8 bb = lds_frag(RA, 136, 16 * jb, ks * 32, lane);
          accL[jb] = mfma16(a1, bb, accL[jb]);
          accA[jb] = mfma16(a2, bb, accA[jb]);
        }
      }
    }
    __syncthreads();
    float* Lm = reinterpret_cast<float*>(RBk);
#pragma unroll
    for (int jb = 0; jb < 4; ++jb)
#pragma unroll
      for (int j = 0; j < 4; ++j) {
        int i = 16 * w + 4 * lq + j, jj = jb * 16 + lr;
        float dec = __expf(fminf(Gs[i] - Gs[jj], 0.f));
        float lv = (i > jj) ? accL[jb][j] * dec : 0.f;
        float av = (i >= jj) ? accA[jb][j] * dec : 0.f;
        Lm[i * 64 + jj] = lv;
        RD[i * 72 + jj] = f2bf(av);
      }
  }
  __syncthreads();
  store_frags(RC, 136, 64, 128, reinterpret_cast<u16*>(p.ws + D_QF) + (size_t)item * 8192, tid, NTHR);
  store_frags(RD, 72, 64, 64, reinterpret_cast<u16*>(p.ws + D_ATT) + (size_t)item * 4096, tid, NTHR);
  store_frags_T(RA, 136, 128, 64, reinterpret_cast<u16*>(p.ws + D_KNT) + (size_t)item * 8192, tid, NTHR);
  __syncthreads();
  {
    const float* Lm = reinterpret_cast<const float*>(RBk);
    float* Tm = reinterpret_cast<float*>(RA);
    float* Ms = reinterpret_cast<float*>(RC) + w * 256;
    {
      const int c = lane & 15, i0 = 16 * w;
      float tc[16];
#pragma unroll
      for (int r = 0; r < 16; ++r) {
        float a = (r == c) ? 1.f : 0.f;
#pragma unroll
        for (int k = 0; k < r; ++k) a -= Lm[(i0 + r) * 64 + i0 + k] * tc[k];
        tc[r] = a;
      }
      if (lane < 16) {
#pragma unroll
        for (int r = 0; r < 16; ++r) Tm[(i0 + r) * 64 + i0 + c] = tc[r];
      }
    }
    __syncthreads();
    {
      const int j = w;
      for (int i = j + 1; i < 4; ++i) {
        f32x4 macc = (f32x4){0.f, 0.f, 0.f, 0.f};
        for (int k = j; k < i; ++k) {
#pragma unroll
          for (int ks = 0; ks < 4; ++ks) {
            float av = Lm[(16 * i + lr) * 64 + 16 * k + 4 * ks + lq];
            float bv = Tm[(16 * k + 4 * ks + lq) * 64 + 16 * j + lr];
            macc = __builtin_amdgcn_mfma_f32_16x16x4f32(av, bv, macc, 0, 0, 0);
          }
        }
#pragma unroll
        for (int r = 0; r < 4; ++r) Ms[(4 * lq + r) * 16 + lr] = macc[r];
        __builtin_amdgcn_wave_barrier();
        f32x4 tacc = (f32x4){0.f, 0.f, 0.f, 0.f};
#pragma unroll
        for (int ks = 0; ks < 4; ++ks) {
          float av = Tm[(16 * i + lr) * 64 + 16 * i + 4 * ks + lq];
          float bv = Ms[(4 * ks + lq) * 16 + lr];
          tacc = __builtin_amdgcn_mfma_f32_16x16x4f32(av, bv, tacc, 0, 0, 0);
        }
#pragma unroll
        for (int r = 0; r < 4; ++r) Tm[(16 * i + 4 * lq + r) * 64 + 16 * j + lr] = -tacc[r];
        __builtin_amdgcn_wave_barrier();
      }
    }
    __syncthreads();
    {
      u16* Tb = RD + 64 * 72;
      for (int idx = tid; idx < 4096; idx += NTHR) {
        int r = idx >> 6, c = idx & 63;
        float v = ((c >> 4) <= (r >> 4)) ? Tm[idx] : 0.f;
        Tb[r * 72 + c] = f2bf(v);
      }
    }
    __syncthreads();
  }
  delta_rowpass<1>(p, t0, n, h, w, lane, Gv, RA, RBk, RC);
  __syncthreads();
  {
    const u16* Tm = RD + 64 * 72;
    bf16x8 tf[4][2];
#pragma unroll
    for (int cb = 0; cb < 4; ++cb)
#pragma unroll
      for (int ks = 0; ks < 2; ++ks) tf[cb][ks] = lds_frag(Tm, 72, cb * 16, ks * 32, lane);
    u16* valt = reinterpret_cast<u16*>(p.ws + D_VALT) + (size_t)item * 8192;
#pragma unroll
    for (int ee = 0; ee < 2; ++ee) {
      int eb = 2 * w + ee;
      bf16x8 a0 = lds_frag(RC, 72, eb * 16, 0, lane), a1 = lds_frag(RC, 72, eb * 16, 32, lane);
#pragma unroll
      for (int cb = 0; cb < 4; ++cb) {
        f32x4 c = (f32x4){0.f, 0.f, 0.f, 0.f};
        c = mfma16(a0, tf[cb][0], c);
        c = mfma16(a1, tf[cb][1], c);
        *reinterpret_cast<uint2*>(valt + ((size_t)(eb * 4 + cb) * 64 + lane) * 4) = make_uint2(pack2(c[0], c[1]), pack2(c[2], c[3]));
      }
    }
#pragma unroll
    for (int dd = 0; dd < 2; ++dd) {
      int db = 2 * w + dd;
      bf16x8 b0 = lds_frag(RA, 72, db * 16, 0, lane), b1 = lds_frag(RA, 72, db * 16, 32, lane);
#pragma unroll
      for (int cb = 0; cb < 4; ++cb) {
        f32x4 c = (f32x4){0.f, 0.f, 0.f, 0.f};
        c = mfma16(tf[cb][0], b0, c);
        c = mfma16(tf[cb][1], b1, c);
#pragma unroll
        for (int j = 0; j < 4; ++j) RBk[(cb * 16 + 4 * lq + j) * 136 + db * 16 + lr] = f2bf(c[j]);
      }
    }
  }
  __syncthreads();
  store_frags(RBk, 136, 64, 128, reinterpret_cast<u16*>(p.ws + D_KCD) + (size_t)item * 8192, tid, NTHR);
  __syncthreads();
}

__device__ __forceinline__ void m1_hgrn_item(const Params& p, int item, char* smem) {
  const int tid = VTID, lane = tid & 63, w = tid >> 6, lr = lane & 15, lq = lane >> 4;
  const int h = item & 3, n = (item >> 2) & 63, b = item >> 8;
  const int t0 = b * 2048 + n * 32;
  u16* QG = reinterpret_cast<u16*>(smem);
  u16* QR = reinterpret_cast<u16*>(smem + 8704);
  u16* KR = reinterpret_cast<u16*>(smem + 17408);
  u16* KGT = reinterpret_cast<u16*>(smem + 26112);
  u16* VT = reinterpret_cast<u16*>(smem + 36352);
  float* tot = reinterpret_cast<float*>(smem + 46592);
  float* bls = tot + 128;
  const u16* Zp = reinterpret_cast<const u16*>(p.ws + Z1);
  const int e = tid & 127, half = tid >> 7;
  const int he = h * 128 + e;
  const float lb = sigmoid_f(p.lb_logits[he] - p.lb_logits[512 + he]);
  float q[16], k[16], bc[16];
  float run = 0.f;
#pragma unroll
  for (int i = 0; i < 16; ++i) {
    const u16* zr = Zp + (size_t)(t0 + half * 16 + i) * 3072;
    float qb = bf2f(zr[1536 + he]), fb = bf2f(zr[2048 + he]);
    float f = lb + (1.f - lb) * sigmoid_f(fb);
    run += __logf(f);
    q[i] = silu_f(qb); k[i] = 1.f - f; bc[i] = run;
    VT[e * 40 + half * 16 + i] = zr[2560 + he];
  }
  if (half == 0) tot[e] = run;
  __syncthreads();
  const float bref = tot[e];
  if (half == 1) {
#pragma unroll
    for (int i = 0; i < 16; ++i) bc[i] += bref;
    bls[e] = bc[15];
  }
  __syncthreads();
  const float bl = bls[e];
  if (half == 0) reinterpret_cast<float*>(p.ws + H_EBL)[(size_t)item * 128 + e] = __expf(bl);
#pragma unroll
  for (int i = 0; i < 16; ++i) {
    int r = half * 16 + i;
    QG[r * 136 + e] = f2bf(q[i] * __expf(bc[i]));
    QR[r * 136 + e] = f2bf(q[i] * __expf(bc[i] - bref));
    KR[r * 136 + e] = f2bf(k[i] * __expf(bref - bc[i]));
    KGT[e * 40 + r] = f2bf(k[i] * __expf(bl - bc[i]));
  }
  __syncthreads();
  {
    const int ib = w >> 1, jb = w & 1;
    f32x4 c = (f32x4){0.f, 0.f, 0.f, 0.f};
    if (jb <= ib) {
#pragma unroll
      for (int ks = 0; ks < 4; ++ks) c = mfma16(lds_frag(QR, 136, ib * 16, ks * 32, lane), lds_frag(KR, 136, jb * 16, ks * 32, lane), c);
    }
    u16* att = reinterpret_cast<u16*>(p.ws + H_ATT) + (size_t)item * 1024;
#pragma unroll
    for (int j = 0; j < 4; ++j) {
      int i = ib * 16 + 4 * lq + j, jj = jb * 16 + lr;
      float v = (i >= jj) ? c[j] : 0.f;
      att[(ib * 64 + (i & 15) + 16 * (jj >> 3)) * 8 + (jj & 7)] = f2bf(v);
    }
  }
  store_frags(QG, 136, 32, 128, reinterpret_cast<u16*>(p.ws + H_QG) + (size_t)item * 4096, tid, NTHR);
  store_frags(KGT, 40, 128, 32, reinterpret_cast<u16*>(p.ws + H_KGT) + (size_t)item * 4096, tid, NTHR);
  store_frags(VT, 40, 128, 32, reinterpret_cast<u16*>(p.ws + H_VT) + (size_t)item * 4096, tid, NTHR);
  __syncthreads();
}

struct DPre {
  bf16x8 kcd[4], q[4], att[2], knt[2][2];
  uint2 val[2];
  float gc, gl;
  float4 gi;
};
__device__ __forceinline__ void m2d_loadA(const Params& p, int base, int es, int w, int lane, DPre& d) {
  const int lr = lane & 15, lq = lane >> 4;
  const bf16x8* kcd = reinterpret_cast<const bf16x8*>(p.ws + D_KCD + (size_t)base * 16384);
  const uint2* val = reinterpret_cast<const uint2*>(p.ws + D_VALT + (size_t)base * 16384);
  const float* gc = reinterpret_cast<const float*>(p.ws + D_GC) + (size_t)base * 64;
#pragma unroll
  for (int ks = 0; ks < 4; ++ks) d.kcd[ks] = kcd[(w * 4 + ks) * 64 + lane];
#pragma unroll
  for (int eb = 0; eb < 2; ++eb) d.val[eb] = val[((es * 2 + eb) * 4 + w) * 64 + lane];
  d.gc = gc[w * 16 + lr];
  d.gl = gc[63];
  d.gi = *reinterpret_cast<const float4*>(gc + 16 * w + 4 * lq);
}
__device__ __forceinline__ void m2d_loadB(const Params& p, int base, int w, int lane, DPre& d) {
  const bf16x8* qf = reinterpret_cast<const bf16x8*>(p.ws + D_QF + (size_t)base * 16384);
  const bf16x8* att = reinterpret_cast<const bf16x8*>(p.ws + D_ATT + (size_t)base * 8192);
#pragma unroll
  for (int ks = 0; ks < 4; ++ks) d.q[ks] = qf[(w * 4 + ks) * 64 + lane];
#pragma unroll
  for (int ks = 0; ks < 2; ++ks) d.att[ks] = att[(w * 2 + ks) * 64 + lane];
}
__device__ __forceinline__ void m2d_loadC(const Params& p, int base, int w, int lane, DPre& d) {
  const bf16x8* knt = reinterpret_cast<const bf16x8*>(p.ws + D_KNT + (size_t)base * 16384);
#pragma unroll
  for (int ks = 0; ks < 2; ++ks) {
    d.knt[0][ks] = knt[((2 * w) * 2 + ks) * 64 + lane];
    d.knt[1][ks] = knt[((2 * w + 1) * 2 + ks) * 64 + lane];
  }
}

__device__ __forceinline__ void m2_delta_item(const Params& p, int item, char* smem) {
  const int tid = VTID, lane = tid & 63, w = tid >> 6, lr = lane & 15, lq = lane >> 4;
  const int es = item & 3, h = (item >> 2) & 3, b = item >> 4;
  u16* Sb = reinterpret_cast<u16*>(smem);
  u16* Ub = reinterpret_cast<u16*>(smem + 17408);
  u16* Usb = reinterpret_cast<u16*>(smem + 22016);
  for (int i = tid; i < 32 * 136; i += NTHR) Sb[i] = 0;
  f32x4 accS[2][2];
#pragma unroll
  for (int i = 0; i < 2; ++i)
#pragma unroll
    for (int j = 0; j < 2; ++j) accS[i][j] = (f32x4){0.f, 0.f, 0.f, 0.f};
  u16* OA = reinterpret_cast<u16*>(reinterpret_cast<char*>(p.out) + YB_OA);
  DPre cur;
  m2d_loadA(p, (b * 32 + 0) * 4 + h, es, w, lane, cur);
  m2d_loadB(p, (b * 32 + 0) * 4 + h, w, lane, cur);
  m2d_loadC(p, (b * 32 + 0) * 4 + h, w, lane, cur);
  __syncthreads();
  for (int n = 0; n < 32; ++n) {
    const int nbase = (b * 32 + (n + 1 < 32 ? n + 1 : n)) * 4 + h;
    const u16* Sc = Sb + (n & 1) * (32 * 136);
    u16* Sn = Sb + ((n + 1) & 1) * (32 * 136);
    f32x4 accP[2];
    accP[0] = (f32x4){0.f, 0.f, 0.f, 0.f}; accP[1] = accP[0];
#pragma unroll
    for (int ks = 0; ks < 4; ++ks) {
      accP[0] = mfma16(lds_frag(Sc, 136, 0, ks * 32, lane), cur.kcd[ks], accP[0]);
      accP[1] = mfma16(lds_frag(Sc, 136, 16, ks * 32, lane), cur.kcd[ks], accP[1]);
    }
    const float egc = __expf(cur.gl - cur.gc);
    const float egl = __expf(cur.gl);
    const float egi[4] = {__expf(cur.gi.x), __expf(cur.gi.y), __expf(cur.gi.z), __expf(cur.gi.w)};
    float vv[2][4];
#pragma unroll
    for (int eb = 0; eb < 2; ++eb) { vv[eb][0] = lo2f(cur.val[eb].x); vv[eb][1] = hi2f(cur.val[eb].x); vv[eb][2] = lo2f(cur.val[eb].y); vv[eb][3] = hi2f(cur.val[eb].y); }
    m2d_loadA(p, nbase, es, w, lane, cur);
#pragma unroll
    for (int eb = 0; eb < 2; ++eb) {
#pragma unroll
      for (int j = 0; j < 4; ++j) {
        float u = vv[eb][j] - accP[eb][j];
        int e = eb * 16 + 4 * lq + j, c = 16 * w + lr;
        Ub[e * 72 + c] = f2bf(u);
        Usb[e * 72 + c] = f2bf(u * egc);
      }
    }
    lds_barrier();
    {
      f32x4 accO[2];
      accO[0] = (f32x4){0.f, 0.f, 0.f, 0.f}; accO[1] = accO[0];
#pragma unroll
      for (int ks = 0; ks < 4; ++ks) {
        accO[0] = mfma16(cur.q[ks], lds_frag(Sc, 136, 0, ks * 32, lane), accO[0]);
        accO[1] = mfma16(cur.q[ks], lds_frag(Sc, 136, 16, ks * 32, lane), accO[1]);
      }
#pragma unroll
      for (int eb = 0; eb < 2; ++eb)
#pragma unroll
        for (int j = 0; j < 4; ++j) accO[eb][j] *= egi[j];
#pragma unroll
      for (int ks = 0; ks < 2; ++ks) {
        accO[0] = mfma16(cur.att[ks], lds_frag(Ub, 72, 0, ks * 32, lane), accO[0]);
        accO[1] = mfma16(cur.att[ks], lds_frag(Ub, 72, 16, ks * 32, lane), accO[1]);
      }
      m2d_loadB(p, nbase, w, lane, cur);
#pragma unroll
      for (int eb = 0; eb < 2; ++eb)
#pragma unroll
        for (int j = 0; j < 4; ++j) {
          int tok = b * 2048 + n * 64 + 16 * w + 4 * lq + j;
          OA[(size_t)tok * 512 + h * 128 + es * 32 + eb * 16 + lr] = f2bf(accO[eb][j]);
        }
    }
    {
#pragma unroll
      for (int eb = 0; eb < 2; ++eb) {
        bf16x8 a0 = lds_frag(Usb, 72, eb * 16, 0, lane), a1 = lds_frag(Usb, 72, eb * 16, 32, lane);
#pragma unroll
        for (int dd = 0; dd < 2; ++dd) {
#pragma unroll
          for (int j = 0; j < 4; ++j) accS[eb][dd][j] *= egl;
          accS[eb][dd] = mfma16(a0, cur.knt[dd][0], accS[eb][dd]);
          accS[eb][dd] = mfma16(a1, cur.knt[dd][1], accS[eb][dd]);
#pragma unroll
          for (int j = 0; j < 4; ++j) Sn[(eb * 16 + 4 * lq + j) * 136 + (2 * w + dd) * 16 + lr] = f2bf(accS[eb][dd][j]);
        }
      }
    }
    m2d_loadC(p, nbase, w, lane, cur);
    lds_barrier();
  }
  float* outp = p.out + O_DELTAP + (size_t)(b * 4 + h) * 16384;
#pragma unroll
  for (int eb = 0; eb < 2; ++eb)
#pragma unroll
    for (int dd = 0; dd < 2; ++dd) {
      int d = (2 * w + dd) * 16 + lr, e0 = es * 32 + eb * 16 + 4 * lq;
      *reinterpret_cast<float4*>(outp + (size_t)d * 128 + e0) =
          make_float4(accS[eb][dd][0], accS[eb][dd][1], accS[eb][dd][2], accS[eb][dd][3]);
    }
  __syncthreads();
}

struct HPre {
  bf16x8 qg[4], att, vt[2], kgt[2];
  float ebl[2];
};
__device__ __forceinline__ HPre m2h_load(const Params& p, int base, int vs, int w, int lane) {
  HPre d;
  const int lr = lane & 15;
  const bf16x8* qg = reinterpret_cast<const bf16x8*>(p.ws + H_QG + (size_t)base * 8192);
  const bf16x8* att = reinterpret_cast<const bf16x8*>(p.ws + H_ATT + (size_t)base * 2048);
  const bf16x8* vt = reinterpret_cast<const bf16x8*>(p.ws + H_VT + (size_t)base * 8192);
  const bf16x8* kgt = reinterpret_cast<const bf16x8*>(p.ws + H_KGT + (size_t)base * 8192);
  const float* ebl = reinterpret_cast<const float*>(p.ws + H_EBL) + (size_t)base * 128;
  const int ib = w >> 1;
#pragma unroll
  for (int ks = 0; ks < 4; ++ks) d.qg[ks] = qg[(ib * 4 + ks) * 64 + lane];
  d.att = att[ib * 64 + lane];
  d.vt[0] = vt[(vs * 2 + 0) * 64 + lane];
  d.vt[1] = vt[(vs * 2 + 1) * 64 + lane];
  d.kgt[0] = kgt[(2 * w) * 64 + lane];
  d.kgt[1] = kgt[(2 * w + 1) * 64 + lane];
  d.ebl[0] = ebl[(2 * w) * 16 + lr];
  d.ebl[1] = ebl[(2 * w + 1) * 16 + lr];
  return d;
}

__device__ __forceinline__ void m2_hgrn_item(const Params& p, int item, char* smem) {
  const int tid = VTID, lane = tid & 63, w = tid >> 6, lr = lane & 15, lq = lane >> 4;
  const int vs = item & 3, h = (item >> 2) & 3, b = item >> 4;
  u16* Sb = reinterpret_cast<u16*>(smem);
  for (int i = tid; i < 32 * 136; i += NTHR) Sb[i] = 0;
  f32x4 accS[2][2];
#pragma unroll
  for (int i = 0; i < 2; ++i)
#pragma unroll
    for (int j = 0; j < 2; ++j) accS[i][j] = (f32x4){0.f, 0.f, 0.f, 0.f};
  u16* OB = reinterpret_cast<u16*>(reinterpret_cast<char*>(p.out) + YB_OB);
  const int ib = w >> 1, vb = w & 1;
  HPre cur = m2h_load(p, (b * 64 + 0) * 4 + h, vs, w, lane), nxt = cur;
  __syncthreads();
  for (int n = 0; n < 64; ++n) {
    if (n + 1 < 64) nxt = m2h_load(p, (b * 64 + n + 1) * 4 + h, vs, w, lane);
    const u16* Sc = Sb + (n & 1) * (32 * 136);
    u16* Sn = Sb + ((n + 1) & 1) * (32 * 136);
    {
      f32x4 o = (f32x4){0.f, 0.f, 0.f, 0.f};
#pragma unroll
      for (int ks = 0; ks < 4; ++ks) o = mfma16(cur.qg[ks], lds_frag(Sc, 136, vb * 16, ks * 32, lane), o);
      o = mfma16(cur.att, vb ? cur.vt[1] : cur.vt[0], o);
#pragma unroll
      for (int j = 0; j < 4; ++j) {
        int tok = b * 2048 + n * 32 + ib * 16 + 4 * lq + j;
        OB[(size_t)tok * 512 + h * 128 + vs * 32 + vb * 16 + lr] = f2bf(o[j]);
      }
    }
#pragma unroll
    for (int v2 = 0; v2 < 2; ++v2)
#pragma unroll
      for (int dd = 0; dd < 2; ++dd) {
#pragma unroll
        for (int j = 0; j < 4; ++j) accS[v2][dd][j] *= cur.ebl[dd];
        accS[v2][dd] = mfma16(cur.vt[v2], cur.kgt[dd], accS[v2][dd]);
#pragma unroll
        for (int j = 0; j < 4; ++j) Sn[(v2 * 16 + 4 * lq + j) * 136 + (2 * w + dd) * 16 + lr] = f2bf(accS[v2][dd][j]);
      }
    lds_barrier();
    cur = nxt;
  }
  float* outp = p.out + O_HGRNP + (size_t)(b * 4 + h) * 16384;
#pragma unroll
  for (int v2 = 0; v2 < 2; ++v2)
#pragma unroll
    for (int dd = 0; dd < 2; ++dd) {
      int e = (2 * w + dd) * 16 + lr, v0 = vs * 32 + v2 * 16 + 4 * lq;
      *reinterpret_cast<float4*>(outp + (size_t)e * 128 + v0) =
          make_float4(accS[v2][dd][0], accS[v2][dd][1], accS[v2][dd][2], accS[v2][dd][3]);
    }
  __syncthreads();
}

__device__ __forceinline__ void ms_delta_item(const Params& p, int item, char* smem) {
  const int tid = VTID, lane = tid & 63, w = tid >> 6;
  const int h = item & 3, b = item >> 2;
  const int R0 = TP + b * 4;
  float* qkv = reinterpret_cast<float*>(smem);
  float* red = reinterpret_cast<float*>(smem + 6144);
  const u16* Zp = reinterpret_cast<const u16*>(p.ws + Z1);
  for (int c = tid; c < 384; c += NTHR) {
    int col = c < 128 ? h * 128 + c : (c < 256 ? 512 + h * 128 + c - 128 : 1024 + h * 128 + c - 256);
    float xs[7];
#pragma unroll
    for (int j = 0; j < 3; ++j) xs[j] = p.cache_conv[(size_t)(b * 3 + j) * 1536 + col];
#pragma unroll
    for (int t = 0; t < 4; ++t) xs[3 + t] = bf2f(Zp[(size_t)(R0 + t) * 3072 + col]);
    float wc[4];
#pragma unroll
    for (int j = 0; j < 4; ++j) wc[j] = p.w_conv_a[j * 1536 + col];
#pragma unroll
    for (int t = 0; t < 4; ++t) {
      float y = xs[t] * wc[0] + xs[t + 1] * wc[1] + xs[t + 2] * wc[2] + xs[t + 3] * wc[3];
      qkv[t * 384 + c] = silu_f(y);
    }
  }
  __syncthreads();
  {
    const int t = w;
    float q0 = qkv[t * 384 + lane], q1 = qkv[t * 384 + 64 + lane];
    float k0 = qkv[t * 384 + 128 + lane], k1 = qkv[t * 384 + 192 + lane];
    float qs = wave_sum(q0 * q0 + q1 * q1), ks = wave_sum(k0 * k0 + k1 * k1);
    float qn = rsqrtf(qs + EPS) * 0.08838834764831845f, kn = rsqrtf(ks + EPS);
    qkv[t * 384 + lane] = q0 * qn; qkv[t * 384 + 64 + lane] = q1 * qn;
    qkv[t * 384 + 128 + lane] = k0 * kn; qkv[t * 384 + 192 + lane] = k1 * kn;
  }
  __syncthreads();
  const int e = tid & 127, dh = tid >> 7;
  float S[64];
  const float* s0 = p.state_delta + (size_t)(b * 4 + h) * 16384 + (size_t)(dh * 64) * 128 + e;
#pragma unroll
  for (int dd = 0; dd < 64; ++dd) S[dd] = s0[(size_t)dd * 128];
  const float* gdec = reinterpret_cast<const float*>(p.ws + SM_GDEC);
  const float* betap = reinterpret_cast<const float*>(p.ws + SM_BETA);
  u16* OA = reinterpret_cast<u16*>(reinterpret_cast<char*>(p.out) + YB_OA);
  for (int t = 0; t < 4; ++t) {
    const float a = __expf(gdec[(size_t)(R0 + t) * 4 + h]), bt = betap[(size_t)(R0 + t) * 4 + h];
    const float* qv = qkv + t * 384 + dh * 64;
    const float* kv = qkv + t * 384 + 128 + dh * 64;
    float rp = 0.f;
#pragma unroll
    for (int dd = 0; dd < 64; ++dd) rp += S[dd] * kv[dd];
    red[((t * 2 + 0) * 2 + dh) * 128 + e] = rp;
    __syncthreads();
    float r = a * (red[((t * 2 + 0) * 2 + 0) * 128 + e] + red[((t * 2 + 0) * 2 + 1) * 128 + e]);
    float u = bt * (qkv[t * 384 + 256 + e] - r);
    float op = 0.f;
#pragma unroll
    for (int dd = 0; dd < 64; ++dd) {
      S[dd] = a * S[dd] + kv[dd] * u;
      op += S[dd] * qv[dd];
    }
    red[((t * 2 + 1) * 2 + dh) * 128 + e] = op;
    __syncthreads();
    if (dh == 0) {
      float o = red[((t * 2 + 1) * 2 + 0) * 128 + e] + red[((t * 2 + 1) * 2 + 1) * 128 + e];
      OA[(size_t)(R0 + t) * 512 + h * 128 + e] = f2bf(o);
    }
  }
  float* so = p.out + O_DELTAS + (size_t)(b * 4 + h) * 16384 + (size_t)(dh * 64) * 128 + e;
#pragma unroll
  for (int dd = 0; dd < 64; ++dd) so[(size_t)dd * 128] = S[dd];
  __syncthreads();
}

__device__ __forceinline__ void ms_hgrn_item(const Params& p, int item, char* smem) {
  const int tid = VTID;
  const int h = item & 3, b = item >> 2;
  const int R0 = TP + b * 4;
  float* qs = reinterpret_cast<float*>(smem);
  float* fs = qs + 512;
  float* vsm = fs + 512;
  float* red = vsm + 512;
  const u16* Zp = reinterpret_cast<const u16*>(p.ws + Z1);
  for (int i = tid; i < 512; i += NTHR) {
    int t = i >> 7, e = i & 127, he = h * 128 + e;
    const u16* zr = Zp + (size_t)(R0 + t) * 3072;
    float lb = sigmoid_f(p.lb_logits[he] - p.lb_logits[512 + he]);
    qs[i] = silu_f(bf2f(zr[1536 + he]));
    fs[i] = lb + (1.f - lb) * sigmoid_f(bf2f(zr[2048 + he]));
    vsm[i] = bf2f(zr[2560 + he]);
  }
  __syncthreads();
  const int v = tid & 127, eh = tid >> 7;
  float S[64];
  const float* s0 = p.state_hgrn + (size_t)(b * 4 + h) * 16384 + (size_t)(eh * 64) * 128 + v;
#pragma unroll
  for (int ee = 0; ee < 64; ++ee) S[ee] = s0[(size_t)ee * 128];
  u16* OB = reinterpret_cast<u16*>(reinterpret_cast<char*>(p.out) + YB_OB);
  for (int t = 0; t < 4; ++t) {
    const float vv = vsm[t * 128 + v];
    const float* ft = fs + t * 128 + eh * 64;
    const float* qt = qs + t * 128 + eh * 64;
    float op = 0.f;
#pragma unroll
    for (int ee = 0; ee < 64; ++ee) {
      float f = ft[ee];
      S[ee] = f * S[ee] + (1.f - f) * vv;
      op += S[ee] * qt[ee];
    }
    red[(t * 2 + eh) * 128 + v] = op;
    __syncthreads();
    if (eh == 0) OB[(size_t)(R0 + t) * 512 + h * 128 + v] = f2bf(red[(t * 2) * 128 + v] + red[(t * 2 + 1) * 128 + v]);
  }
  float* so = p.out + O_HGRNS + (size_t)(b * 4 + h) * 16384 + (size_t)(eh * 64) * 128 + v;
#pragma unroll
  for (int ee = 0; ee < 64; ++ee) so[(size_t)ee * 128] = S[ee];
  __syncthreads();
}

__device__ __forceinline__ void phase_m3(const Params& p, char* smem, int bid, int nb) {
  const int tid = VTID, lane = tid & 63, w = tid >> 6;
  float* tl = reinterpret_cast<float*>(smem);
  const int NWT = 704 + 352;
  const int NTASK = (2 * TT) / 4;
  for (int item = bid; item < NWT + NTASK; item += nb) {
    if (item < NWT) {
      if (item < 704) {
        int blk = item >> 2, k0 = (item & 3) * 256;
        int grp = blk >> 3, sub = blk & 7, up = sub >> 2;
        wt_chunk((up ? p.w_ffn_up : p.w_ffn_gate) + grp * 128 + (sub & 3) * 32, DFF, 1024,
                 reinterpret_cast<u16*>(p.ws + W_GU) + (size_t)blk * 32 * 1024, p.g_ffn, tl, k0);
      } else {
        int q = item - 704;
        int n = (q / 11) * 32, k0 = (q % 11) * 256;
        wt_chunk(p.w_ffn_down + n, 1024, DFF, reinterpret_cast<u16*>(p.ws + W_DOWN) + (size_t)n * DFF, nullptr, tl, k0);
      }
    } else {
      int task = (item - NWT) * 4 + w;
      int tok = task >> 1, br = task & 1;
      u16* o = reinterpret_cast<u16*>(reinterpret_cast<char*>(p.out) + (br ? YB_OB : YB_OA)) + (size_t)tok * 512 + lane * 8;
      const u16* og = z2row(p, tok) + 2048 + br * 512 + lane * 8;
      const float* g = (br ? p.g_out_b : p.g_out_a) + (lane & 15) * 8;
      uint4 ov = *reinterpret_cast<const uint4*>(o), gv = *reinterpret_cast<const uint4*>(og);
      unsigned oo[4] = {ov.x, ov.y, ov.z, ov.w}, gg[4] = {gv.x, gv.y, gv.z, gv.w};
      float x[8], y[8];
#pragma unroll
      for (int j = 0; j < 4; ++j) { x[2 * j] = lo2f(oo[j]); x[2 * j + 1] = hi2f(oo[j]); y[2 * j] = lo2f(gg[j]); y[2 * j + 1] = hi2f(gg[j]); }
      float ss = 0.f;
#pragma unroll
      for (int j = 0; j < 8; ++j) ss += x[j] * x[j];
      ss += __shfl_xor(ss, 1, 64); ss += __shfl_xor(ss, 2, 64); ss += __shfl_xor(ss, 4, 64); ss += __shfl_xor(ss, 8, 64);
      float rstd = rsqrtf(ss * (1.f / 128.f) + EPS);
      unsigned r[4];
#pragma unroll
      for (int j = 0; j < 4; ++j)
        r[j] = pack2(x[2 * j] * rstd * g[2 * j] * silu_f(y[2 * j]), x[2 * j + 1] * rstd * g[2 * j + 1] * silu_f(y[2 * j + 1]));
      *reinterpret_cast<uint4*>(o) = make_uint4(r[0], r[1], r[2], r[3]);
    }
  }
}

__device__ __forceinline__ void phase_fixup(const Params& p, int bid, int nb) {
  const float* haloG = reinterpret_cast<const float*>(p.ws + HALO_G);
  const float* headG = reinterpret_cast<const float*>(p.ws + HEAD_G);
  const float* headU = reinterpret_cast<const float*>(p.ws + HEAD_U);
  u16* ACTp = reinterpret_cast<u16*>(p.ws + ACT);
  const int total = 256 * 2 * DFF;
  for (int i = bid * NTHR + VTID; i < total; i += nb * NTHR) {
    int ch = i % DFF, rr = (i / DFF) & 1, blk = i / (2 * DFF);
    if ((blk & 31) == 0) continue;
    float g0 = headG[(size_t)(blk * 2 + rr) * DFF + ch], u = headU[(size_t)(blk * 2 + rr) * DFF + ch];
    float gm1, gm2;
    if (rr == 0) { gm1 = haloG[(size_t)((blk - 1) * 2 + 1) * DFF + ch]; gm2 = haloG[(size_t)((blk - 1) * 2 + 0) * DFF + ch]; }
    else { gm1 = headG[(size_t)(blk * 2 + 0) * DFF + ch]; gm2 = haloG[(size_t)((blk - 1) * 2 + 1) * DFF + ch]; }
    float gc = p.w_ffn_conv[ch] * gm2 + p.w_ffn_conv[DFF + ch] * gm1 + p.w_ffn_conv[2 * DFF + ch] * g0;
    ACTp[(size_t)(blk * 64 + rr) * DFF + ch] = f2bf(silu_f(gc) * u);
  }
}

__device__ __forceinline__ void phase_final(const Params& p, int bid, int nb) {
  const int tid = VTID, lane = tid & 63, w = tid >> 6;
  for (int row = bid * 4 + w; row < TP; row += nb * 8) {
    const int rowB = row + nb * 4;
    const bool hasB = rowB < TP;
    float* ya = p.out + O_YP + (size_t)row * DM;
    float* yb = p.out + O_YP + (size_t)(hasB ? rowB : row) * DM;
    float4 xa[4], xb[4];
#pragma unroll
    for (int i = 0; i < 4; ++i) xa[i] = *reinterpret_cast<const float4*>(ya + i * 256 + lane * 4);
#pragma unroll
    for (int i = 0; i < 4; ++i) xb[i] = *reinterpret_cast<const float4*>(yb + i * 256 + lane * 4);
    float sa = 0.f, sb = 0.f;
#pragma unroll
    for (int i = 0; i < 4; ++i) {
      sa += xa[i].x * xa[i].x + xa[i].y * xa[i].y + xa[i].z * xa[i].z + xa[i].w * xa[i].w;
      sb += xb[i].x * xb[i].x + xb[i].y * xb[i].y + xb[i].z * xb[i].z + xb[i].w * xb[i].w;
    }
    sa = wave_sum(sa); sb = wave_sum(sb);
    const float ra = rsqrtf(sa * (1.f / DM) + EPS), rb = rsqrtf(sb * (1.f / DM) + EPS);
#pragma unroll
    for (int i = 0; i < 4; ++i) {
      float4 g = *reinterpret_cast<const float4*>(p.g_final + i * 256 + lane * 4);
      *reinterpret_cast<float4*>(ya + i * 256 + lane * 4) = make_float4(xa[i].x * ra * g.x, xa[i].y * ra * g.y, xa[i].z * ra * g.z, xa[i].w * ra * g.w);
      if (hasB) *reinterpret_cast<float4*>(yb + i * 256 + lane * 4) = make_float4(xb[i].x * rb * g.x, xb[i].y * rb * g.y, xb[i].z * rb * g.z, xb[i].w * rb * g.w);
    }
  }
  for (int row = TP + bid * 4 + w; row < TT; row += nb * 4) {
    float* y = p.out + O_YP + (size_t)row * DM;
    float4 xv[4];
    float ss = 0.f;
    const float* part = reinterpret_cast<const float*>(p.ws + PART) + (size_t)(row - TP) * 1024;
#pragma unroll
    for (int i = 0; i < 4; ++i) {
      xv[i] = *reinterpret_cast<const float4*>(y + i * 256 + lane * 4);
      for (int ks = 0; ks < 11; ++ks) {
        float4 pv = *reinterpret_cast<const float4*>(part + (size_t)ks * TS * 1024 + i * 256 + lane * 4);
        xv[i].x += pv.x; xv[i].y += pv.y; xv[i].z += pv.z; xv[i].w += pv.w;
      }
      ss += xv[i].x * xv[i].x + xv[i].y * xv[i].y + xv[i].z * xv[i].z + xv[i].w * xv[i].w;
    }
    ss = wave_sum(ss);
    float rstd = rsqrtf(ss * (1.f / DM) + EPS);
#pragma unroll
    for (int i = 0; i < 4; ++i) {
      float4 g = *reinterpret_cast<const float4*>(p.g_final + i * 256 + lane * 4);
      *reinterpret_cast<float4*>(y + i * 256 + lane * 4) =
          make_float4(xv[i].x * rstd * g.x, xv[i].y * rstd * g.y, xv[i].z * rstd * g.z, xv[i].w * rstd * g.w);
    }
  }
}

constexpr int NPHASE = 13;
__device__ __forceinline__ void run_phase(const Params& p, int ph, char* smem_all) {
  int half = threadIdx.x >> 8;
  asm volatile("" : "+v"(half));
  const int bid = blockIdx.x * 2 + half, nb = gridDim.x * 2;
  char* smem = smem_all + half * SMEM_HALF;
  LAS unsigned char* lds = (LAS unsigned char*)smem_all;
  const u16* HB = reinterpret_cast<const u16*>(reinterpret_cast<const char*>(p.out) + YB_H);
  switch (ph) {
    case 0: phase_prep(p, smem, bid, nb, 0); break;
    case 1: {
      { pg8::SchedStatic S; S.init(TS, 3072, 24, (int)blockIdx.x, 64);
        gemm_phase8<EPI_Z1>(p, HB, reinterpret_cast<const u16*>(p.ws + W_MAIN), 1024, 1024, lds, S); }
      phase_prep(p, smem, bid, nb, 1);
    } break;
    case 2: { pg8::SchedStatic S; S.init(TP, 3072, (int)gridDim.x, (int)blockIdx.x, 0); gemm_phase8<EPI_Z1>(p, HB, reinterpret_cast<const u16*>(p.ws + W_MAIN), 1024, 1024, lds, S); } break;
    case 3:
      for (int it = bid; it < 1024; it += nb) m1_delta_item(p, it, smem);
      for (int it = bid; it < 2048; it += nb) m1_hgrn_item(p, it, smem);
      break;
    case 4: {
      const int g = blockIdx.x;
      if (g < 128) {
        const int gg = g & 63, xcd = gg & 7, j = gg >> 3;
        const int q = xcd + 8 * (j >> 1), es = 2 * (j & 1) + half;
        if (g < 64) m2_delta_item(p, q * 4 + es, smem); else m2_hgrn_item(p, q * 4 + es, smem);
      } else {
        const int nrest = (gridDim.x - 128) * 2, v0 = (g - 128) * 2 + half;
        for (int it = v0; it < 1024; it += nrest) {
          if (it < 512) ms_delta_item(p, it, smem); else ms_hgrn_item(p, it - 512, smem);
        }
        __syncthreads();
        { pg8::SchedStatic S; S.init(TS, 3072, 24, g - 128, 64);
          gemm_phase8<EPI_Z2>(p, HB, reinterpret_cast<const u16*>(p.ws + W_G2), 1024, 1024, lds, S); }
      }
    } break;
    case 5: { pg8::SchedStatic S; S.init(TP, 3072, (int)gridDim.x, (int)blockIdx.x, 0); gemm_phase8<EPI_Z2>(p, HB, reinterpret_cast<const u16*>(p.ws + W_G2), 1024, 1024, lds, S); } break;
    case 6: phase_m3(p, smem, bid, nb); break;
    case 7: {
      const u16* OA = reinterpret_cast<const u16*>(reinterpret_cast<const char*>(p.out) + YB_OA);
      const u16* OB = reinterpret_cast<const u16*>(reinterpret_cast<const char*>(p.out) + YB_OB);
      { pg8::SchedStatic S; S.init(TT, 1024, (int)gridDim.x, (int)blockIdx.x, 0); gemm_phase8<EPI_MIXA>(p, OA, reinterpret_cast<const u16*>(p.ws + W_A), 512, 512, lds, S);
      gemm_phase8<EPI_MIXB>(p, OB, reinterpret_cast<const u16*>(p.ws + W_B), 512, 512, lds, S); }
    } break;
    case 8: { pg8::SchedStatic S; S.init(TT, 1024, (int)gridDim.x, (int)blockIdx.x, 0); gemm_phase8<EPI_WOUT>(p, reinterpret_cast<const u16*>(p.ws + MIX), reinterpret_cast<const u16*>(p.ws + W_OUT), 1024, 1024, lds, S); } break;
    case 9: {
      { pg8::SchedStatic S; S.init(TP, 5632, (int)gridDim.x, (int)blockIdx.x, 0);
        gemm_phase8<EPI_FFN1>(p, reinterpret_cast<const u16*>(p.ws + X1B), reinterpret_cast<const u16*>(p.ws + W_GU), 1024, 1024, lds, S); }
      { pg8::SchedStatic S; S.init(TS, 5632, (int)gridDim.x, (int)gridDim.x - 1 - (int)blockIdx.x, 64);
        gemm_phase8<EPI_FFN1S>(p, reinterpret_cast<const u16*>(p.ws + X1B), reinterpret_cast<const u16*>(p.ws + W_GU), 1024, 1024, lds, S); }
    } break;
    case 10: phase_fixup(p, bid, nb); break;
    case 11: {
      { pg8::SchedStatic S; S.init(TP, 1024, (int)gridDim.x, (int)blockIdx.x, 0);
        gemm_phase8<EPI_FFN2>(p, reinterpret_cast<const u16*>(p.ws + ACT), reinterpret_cast<const u16*>(p.ws + W_DOWN), DFF, DFF, lds, S); }
      { pg8::SchedSplit S; S.init(2, 4, 11, (int)gridDim.x, (int)blockIdx.x, 64);
        gemm_phase8<EPI_FFN2S>(p, reinterpret_cast<const u16*>(p.ws + ACT), reinterpret_cast<const u16*>(p.ws + W_DOWN), DFF, 256, lds, S); }
    } break;
    case 12: phase_final(p, bid, nb); break;
  }
}

__global__ void __launch_bounds__(512, 2) k_main(Params p, int ph0, int ph1) {
  extern __shared__ __attribute__((aligned(16))) char smem[];
  volatile LAS unsigned* xst = (volatile LAS unsigned*)(smem + 2 * SMEM_HALF);
  if (threadIdx.x == 0) { xst[0] = 0u; xst[1] = 0u; }
  __syncthreads();
  XcdBarrier xb = xcd_barrier_post(reinterpret_cast<unsigned*>(p.ws + BAR_OFF), xst);
  if (ph1 < 0) cg::this_grid().sync();
#define PHASE_STEP(N)                                        \
  if (ph0 <= N && N < ph1) run_phase(p, N, smem);            \
  if (ph0 <= N && N + 1 < ph1) xcd_barrier(xb);
  PHASE_STEP(0) PHASE_STEP(1) PHASE_STEP(2) PHASE_STEP(3) PHASE_STEP(4) PHASE_STEP(5)
  PHASE_STEP(6) PHASE_STEP(7) PHASE_STEP(8) PHASE_STEP(9) PHASE_STEP(10) PHASE_STEP(11) PHASE_STEP(12)
#undef PHASE_STEP
}

extern "C" void kernel_launch(void* const* d_in, const int* in_sizes, int n_in, void* d_out, int out_size, void* d_ws,
                              size_t ws_size, hipStream_t stream) {
  static int grid_blocks = 0;
  if (!grid_blocks) {
    hipFuncSetAttribute((const void*)k_main, hipFuncAttributeMaxDynamicSharedMemorySize, SMEM_BYTES);
    int dev = 0, cus = 0, per_cu = 0;
    hipGetDevice(&dev);
    hipDeviceGetAttribute(&cus, hipDeviceAttributeMultiprocessorCount, dev);
    hipOccupancyMaxActiveBlocksPerMultiprocessor(&per_cu, k_main, 512, SMEM_BYTES);
    if (per_cu > 1) per_cu = 1;
    if (per_cu < 1) per_cu = 1;
    grid_blocks = cus * per_cu;
  }
  Params p{};
  const float** f = reinterpret_cast<const float**>(&p);
  for (int i = 0; i < 23; ++i) f[i] = reinterpret_cast<const float*>(d_in[i]);
  p.out = reinterpret_cast<float*>(d_out);
  p.ws = reinterpret_cast<char*>(d_ws);
  if (ws_size < WS_NEED) fprintf(stderr, "workspace too small: %zu < %zu\n", ws_size, (size_t)WS_NEED);
  hipMemsetAsync(p.ws + BAR_OFF, 0, 16384, stream);
#if MULTI_LAUNCH
  for (int ph = 0; ph < NPHASE; ++ph) {
    hipLaunchKernelGGL(k_main, dim3(grid_blocks), dim3(512), SMEM_BYTES, stream, p, ph, ph + 1);
  }
#else
  int ph0 = 0, ph1 = NPHASE;
  void* args[] = {&p, &ph0, &ph1};
  hipError_t e = hipLaunchCooperativeKernel((void*)k_main, dim3(grid_blocks), dim3(512), args, SMEM_BYTES, stream);
  if (e != hipSuccess) fprintf(stderr, "cooperative launch failed: %s (grid %d)\n", hipGetErrorString(e), grid_blocks);
#endif
}
```

```cpp
#include <hip/hip_runtime.h>
#include <hip/hip_cooperative_groups.h>
#include <cstdio>
#include <cstdint>
namespace cg = cooperative_groups;

#ifndef MULTI_LAUNCH
#define MULTI_LAUNCH 0
#endif

typedef unsigned short u16;
typedef __attribute__((ext_vector_type(8))) short bf16x8;
typedef __attribute__((ext_vector_type(4))) float f32x4;

constexpr int TP = 16384, TS = 512, TT = TP + TS;
constexpr int DM = 1024, NIN = 6152, DFF = 2816;
constexpr float EPS = 1e-6f;
constexpr int NTHR = 256;
#define VTID (threadIdx.x & 255)
constexpr int SMEM_HALF = 77824;
constexpr int SMEM_BYTES = 2 * SMEM_HALF + 16;

constexpr size_t O_YP = 0;
constexpr size_t O_YS = O_YP + (size_t)TP * DM;
constexpr size_t O_CONVP = O_YS + (size_t)TS * DM;
constexpr size_t O_DELTAP = O_CONVP + 8 * 3 * 1536;
constexpr size_t O_HGRNP = O_DELTAP + 8 * 4 * 128 * 128;
constexpr size_t O_FFNP = O_HGRNP + 8 * 4 * 128 * 128;
constexpr size_t O_CONVS = O_FFNP + 8 * 2 * DFF;
constexpr size_t O_DELTAS = O_CONVS + 128 * 3 * 1536;
constexpr size_t O_HGRNS = O_DELTAS + (size_t)128 * 4 * 128 * 128;
constexpr size_t O_FFNS = O_HGRNS + (size_t)128 * 4 * 128 * 128;

constexpr size_t al(size_t x) { return (x + 255) & ~(size_t)255; }
constexpr size_t W_MAIN = 0;
constexpr size_t W_G2 = W_MAIN + (size_t)3072 * 1024 * 2;
constexpr size_t W_A = W_G2 + (size_t)3072 * 1024 * 2;
constexpr size_t W_B = W_A + (size_t)1024 * 512 * 2;
constexpr size_t W_OUT = W_B + (size_t)1024 * 512 * 2;
constexpr size_t SM_GDEC = W_OUT + (size_t)1024 * 1024 * 2;
constexpr size_t SM_BETA = al(SM_GDEC + (size_t)TT * 16);
constexpr size_t SM_ROWSS = al(SM_BETA + (size_t)TT * 16);
constexpr size_t Z1 = al(SM_ROWSS + (size_t)TT * 4);
constexpr size_t Z1_SIZE = (size_t)TT * 3072 * 2;
constexpr size_t RB = al(Z1 + Z1_SIZE);
constexpr size_t D_QF = RB;
constexpr size_t D_KCD = D_QF + (size_t)1024 * 16384;
constexpr size_t D_KNT = D_KCD + (size_t)1024 * 16384;
constexpr size_t D_VALT = D_KNT + (size_t)1024 * 16384;
constexpr size_t D_ATT = D_VALT + (size_t)1024 * 16384;
constexpr size_t D_GC = D_ATT + (size_t)1024 * 8192;
constexpr size_t H_QG = D_GC + (size_t)1024 * 256;
constexpr size_t H_KGT = H_QG + (size_t)2048 * 8192;
constexpr size_t H_VT = H_KGT + (size_t)2048 * 8192;
constexpr size_t H_ATT = H_VT + (size_t)2048 * 8192;
constexpr size_t H_EBL = H_ATT + (size_t)2048 * 2048;
constexpr size_t RB_END1 = H_EBL + (size_t)2048 * 512;
constexpr size_t Z2 = RB;
constexpr size_t X1B = RB;
constexpr size_t ACT = RB + (size_t)TT * 1024 * 2;
constexpr size_t RB_END2 = ACT + (size_t)TT * DFF * 2;
constexpr size_t WS_NEED = (RB_END1 > RB_END2 ? RB_END1 : RB_END2);
constexpr size_t BAR_OFF = al(WS_NEED);
constexpr size_t Z2S = BAR_OFF + 16384;
static_assert(Z2S + (size_t)TS * 3072 * 2 <= (size_t)268435456, "workspace too large");
constexpr size_t W_GU = Z1;
constexpr size_t W_DOWN = W_GU + (size_t)5632 * 1024 * 2;
constexpr size_t MIX = W_DOWN + (size_t)1024 * DFF * 2;
constexpr size_t HALO_G = MIX + (size_t)TT * 1024 * 2;
constexpr size_t HEAD_G = HALO_G + (size_t)264 * 2 * DFF * 4;
constexpr size_t HEAD_U = HEAD_G + (size_t)264 * 2 * DFF * 4;
constexpr size_t PART = HEAD_U + (size_t)264 * 2 * DFF * 4;
static_assert(PART + (size_t)11 * TS * 1024 * 4 <= Z1 + Z1_SIZE, "z1 reuse overflow");
constexpr size_t YB_H = 0;
constexpr size_t YB_OA = (size_t)TT * 1024 * 2;
constexpr size_t YB_OB = YB_OA + (size_t)TT * 512 * 2;

struct Params {
  const float *x_prompt, *x_sample, *cache_conv, *state_delta, *state_hgrn, *cache_ffn;
  const float *g_attn, *w_in, *w_conv_a, *a_log, *dt_bias, *g_out_a, *w_branch_a, *lb_logits, *g_out_b,
      *w_branch_b, *w_out, *g_ffn, *w_ffn_gate, *w_ffn_up, *w_ffn_conv, *w_ffn_down, *g_final;
  float* out;
  char* ws;
};

__device__ __forceinline__ const unsigned short* z2row(const Params& p, int row) {
  return row < TP ? reinterpret_cast<const unsigned short*>(p.ws + Z2) + (size_t)row * 3072
                  : reinterpret_cast<const unsigned short*>(p.ws + Z2S) + (size_t)(row - TP) * 3072;
}
typedef __bf16 bf16x2_t __attribute__((ext_vector_type(2)));
typedef float f32x2_t __attribute__((ext_vector_type(2)));
__device__ __forceinline__ unsigned pack2(float a, float b) {
  f32x2_t v = {a, b};
  bf16x2_t r = __builtin_convertvector(v, bf16x2_t);
  return __builtin_bit_cast(unsigned, r);
}
__device__ __forceinline__ u16 f2bf(float f) { return (u16)(pack2(f, 0.f) & 0xffffu); }
__device__ __forceinline__ float bf2f(u16 h) { return __uint_as_float(((unsigned)h) << 16); }
__device__ __forceinline__ float lo2f(unsigned u) { return __uint_as_float(u << 16); }
__device__ __forceinline__ float hi2f(unsigned u) { return __uint_as_float(u & 0xffff0000u); }
__device__ __forceinline__ float silu_f(float x) { return x * __builtin_amdgcn_rcpf(1.f + __expf(-x)); }
__device__ __forceinline__ float sigmoid_f(float x) { return __builtin_amdgcn_rcpf(1.f + __expf(-x)); }
#define DPP_ADD(v, ctrl, rmask) v += __int_as_float(__builtin_amdgcn_update_dpp(0, __float_as_int(v), ctrl, rmask, 0xf, false))
__device__ __forceinline__ float wave_sum(float v) {
  DPP_ADD(v, 0xB1, 0xf);
  DPP_ADD(v, 0x4E, 0xf);
  DPP_ADD(v, 0x141, 0xf);
  DPP_ADD(v, 0x140, 0xf);
  DPP_ADD(v, 0x142, 0xa);
  DPP_ADD(v, 0x143, 0xc);
  return __int_as_float(__builtin_amdgcn_readlane(__float_as_int(v), 63));
}
__device__ __forceinline__ void lds_barrier() {
  __builtin_amdgcn_fence(__ATOMIC_RELEASE, "workgroup", "local");
  __builtin_amdgcn_s_barrier();
  __builtin_amdgcn_fence(__ATOMIC_ACQUIRE, "workgroup", "local");
}
__device__ __forceinline__ f32x4 mfma16(bf16x8 a, bf16x8 b, f32x4 c) {
  return __builtin_amdgcn_mfma_f32_16x16x32_bf16(a, b, c, 0, 0, 0);
}
__device__ __forceinline__ bf16x8 lds_frag(const u16* base, int ld, int row0, int k0, int lane) {
  return *reinterpret_cast<const bf16x8*>(base + (row0 + (lane & 15)) * ld + k0 + 8 * (lane >> 4));
}
__device__ __forceinline__ void store_frags(const u16* lds, int ld, int R, int K, u16* dst, int t, int nt) {
  const int nkb = K >> 5, total = (R >> 4) * nkb * 64;
  for (int idx = t; idx < total; idx += nt) {
    int f = idx >> 6, pl = idx & 63, rb = f / nkb, kb = f - rb * nkb;
    uint4 v = *reinterpret_cast<const uint4*>(lds + (rb * 16 + (pl & 15)) * ld + kb * 32 + 8 * (pl >> 4));
    *reinterpret_cast<uint4*>(dst + (size_t)idx * 8) = v;
  }
}
__device__ __forceinline__ void store_frags_T(const u16* lds, int ld, int R2, int K2, u16* dst, int t, int nt) {
  const int nkb = K2 >> 5, total = (R2 >> 4) * nkb * 64;
  for (int idx = t; idx < total; idx += nt) {
    int f = idx >> 6, pl = idx & 63, rb = f / nkb, kb = f - rb * nkb;
    int d = rb * 16 + (pl & 15), c0 = kb * 32 + 8 * (pl >> 4);
    unsigned r[4];
#pragma unroll
    for (int j = 0; j < 4; ++j) {
      unsigned a = lds[(c0 + 2 * j) * ld + d], b = lds[(c0 + 2 * j + 1) * ld + d];
      r[j] = a | (b << 16);
    }
    *reinterpret_cast<uint4*>(dst + (size_t)idx * 8) = make_uint4(r[0], r[1], r[2], r[3]);
  }
}

#define XB_TMO 128
#define XB_XCNT(j) (256 + 64 * (j))
#define XB_XSUB(j) (1280 + 64 * (j))
#define XB_XGEN(j) (2304 + 64 * (j))
#define XB_TOP 3328
#define XB_TOPGEN 3392
#define XCD_BAR_WORDS 3456
#define XB_SPIN_CAP (1u << 18)
#define LAS __attribute__((address_space(3)))
__device__ __forceinline__ unsigned xb_ld(unsigned* p) { return __hip_atomic_load(p, __ATOMIC_RELAXED, __HIP_MEMORY_SCOPE_AGENT); }
__device__ __forceinline__ unsigned xb_add(unsigned* p, unsigned v) { return __hip_atomic_fetch_add(p, v, __ATOMIC_RELAXED, __HIP_MEMORY_SCOPE_AGENT); }
__device__ __forceinline__ unsigned xb_xcc_id() { return (unsigned)__builtin_amdgcn_s_getreg((3 << 11) | 20) & 0xFu; }
#define XB_SPIN(cond, bar) do { unsigned _sp = 0; while (cond) { __builtin_amdgcn_s_sleep(1); \
    if ((++_sp & 255u) == 0u) { if (xb_ld(&(bar)[XB_TMO])) break; if (_sp > XB_SPIN_CAP) { atomicAdd(&(bar)[XB_TMO], 1u); break; } } } } while (0)
struct XcdBarrier { unsigned* bar; unsigned x; volatile LAS unsigned* st; };
__device__ __forceinline__ XcdBarrier xcd_barrier_post(unsigned* bar, volatile LAS unsigned* st) {
  XcdBarrier b; b.bar = bar; b.x = xb_xcc_id(); b.st = st;
  if (threadIdx.x == 0) (void)xb_add(&bar[XB_XCNT(b.x)], 1u);
  return b;
}
__device__ __forceinline__ void xcd_barrier_complete(unsigned* bar, unsigned x, unsigned& nloc, unsigned& nx) {
  const unsigned G = gridDim.x * gridDim.y * gridDim.z;
  unsigned sum, cnt, mine, sp = 0u;
  for (;;) {
    sum = 0u; cnt = 0u; mine = 0u;
#pragma unroll
    for (unsigned j = 0; j < 16; ++j) { const unsigned c = xb_ld(&bar[XB_XCNT(j)]); sum += c; cnt += (c > 0u) ? 1u : 0u; mine = (j == x) ? c : mine; }
    if (sum == G) break;
    __builtin_amdgcn_s_sleep(1);
    if ((++sp & 255u) == 0u) { if (xb_ld(&bar[XB_TMO])) break; if (sp > XB_SPIN_CAP) { atomicAdd(&bar[XB_TMO], 1u); break; } }
  }
  nloc = mine > 0u ? mine : 1u; nx = cnt > 0u ? cnt : 1u;
}
__device__ __forceinline__ void xcd_barrier(const XcdBarrier& b) {
  asm volatile("s_waitcnt vmcnt(0)" ::: "memory");
  __syncthreads();
  if (threadIdx.x == 0) {
    unsigned* bar = b.bar;
    __builtin_amdgcn_s_waitcnt(0);
    unsigned nloc = b.st[0], nx = b.st[1];
    if (nloc == 0u) { xcd_barrier_complete(bar, b.x, nloc, nx); b.st[0] = nloc; b.st[1] = nx; }
    const unsigned old = xb_add(&bar[XB_XSUB(b.x)], 1u);
    const unsigned gen = old / nloc;
    if (old + 1u == (gen + 1u) * nloc) {
      __builtin_amdgcn_fence(__ATOMIC_RELEASE, "agent");
      asm volatile("s_waitcnt vmcnt(0)" ::: "memory");
      const unsigned og = xb_add(&bar[XB_TOP], 1u);
      const unsigned tg = og / nx;
      if (og + 1u == (tg + 1u) * nx) xb_add(&bar[XB_TOPGEN], 1u);
      else XB_SPIN(xb_ld(&bar[XB_TOPGEN]) == tg, bar);
      __builtin_amdgcn_fence(__ATOMIC_ACQUIRE, "agent");
      xb_add(&bar[XB_XGEN(b.x)], 1u);
      asm volatile("s_waitcnt vmcnt(0)" ::: "memory");
    } else {
      XB_SPIN(xb_ld(&bar[XB_XGEN(b.x)]) == gen, bar);
      __builtin_amdgcn_fence(__ATOMIC_ACQUIRE, "agent");
      asm volatile("s_waitcnt vmcnt(0)" ::: "memory");
    }
  }
  __syncthreads();
}

__device__ __forceinline__ void wt_block(const float* __restrict__ src, int ld, int K, u16* __restrict__ dst, const float* __restrict__ kscale,
                         float* lds) {
  const int t = VTID;
  for (int k0 = 0; k0 < K; k0 += 64) {
    {
      int n = t & 31, kk = t >> 5;
#pragma unroll
      for (int i = 0; i < 8; ++i) {
        int k = kk + 8 * i;
        float v = src[(size_t)(k0 + k) * ld + n];
        if (kscale) v *= kscale[k0 + k];
        lds[k * 33 + n] = v;
      }
    }
    __syncthreads();
    {
      int kp = t & 31, nn = t >> 5;
#pragma unroll
      for (int i = 0; i < 4; ++i) {
        int n = nn + 8 * i;
        unsigned v = pack2(lds[(2 * kp) * 33 + n], lds[(2 * kp + 1) * 33 + n]);
        *reinterpret_cast<unsigned*>(dst + (size_t)n * K + k0 + 2 * kp) = v;
      }
    }
    __syncthreads();
  }
}

__device__ __forceinline__ void wt_chunk(const float* __restrict__ src, int ld, int K, u16* __restrict__ dst, const float* __restrict__ kscale, float* lds, int k0) {
  const int t = VTID;
  {
    const int n = t & 31, kk = t >> 5;
    float v[32];
#pragma unroll
    for (int i = 0; i < 32; ++i) v[i] = src[(size_t)(k0 + kk + 8 * i) * ld + n];
    if (kscale) {
#pragma unroll
      for (int i = 0; i < 32; ++i) v[i] *= kscale[k0 + kk + 8 * i];
    }
#pragma unroll
    for (int i = 0; i < 32; ++i) lds[(kk + 8 * i) * 33 + n] = v[i];
  }
  __syncthreads();
  {
    const int kp = t & 127, nn = t >> 7;
#pragma unroll
    for (int i = 0; i < 16; ++i) {
      const int n = nn + 2 * i;
      *reinterpret_cast<unsigned*>(dst + (size_t)n * K + k0 + 2 * kp) = pack2(lds[(2 * kp) * 33 + n], lds[(2 * kp + 1) * 33 + n]);
    }
  }
  __syncthreads();
}

__device__ __forceinline__ void phase_prep(const Params& p, char* smem, int bid, int nb, int part) {
  float* wab = reinterpret_cast<float*>(smem);
  float* tl = reinterpret_cast<float*>(smem + 32768);
  const int t = VTID, lane = t & 63, w = t >> 6;
  for (int i = t; i < 8192; i += NTHR) wab[i] = p.w_in[(size_t)(i >> 3) * NIN + 1536 + (i & 7)];
  if (part == 0) { for (int i = bid * NTHR + t; i < TT; i += nb * NTHR) reinterpret_cast<float*>(p.ws + SM_ROWSS)[i] = 0.f; }
  __syncthreads();
  const int NWT = 384 + 384 + 64 + 64 + 128;
  const int NL = part == 0 ? 384 + 128 : 640 + 4096;
  const int lb = part == 0 ? bid : bid - 48, ln = part == 0 ? nb : nb - 48;
  for (int li = lb; li >= 0 && li < NL; li += ln) {
    const int item = part == 0 ? (li < 384 ? li : NWT + 4096 + (li - 384)) : (li < 640 ? 384 + li : NWT + (li - 640));
    if (item < NWT) {
      if (item < 384) {
        int n = (item >> 2) * 32, k0 = (item & 3) * 256;
        int col = n < 1536 ? n : 2056 + (n - 1536);
        wt_chunk(p.w_in + col, NIN, 1024, reinterpret_cast<u16*>(p.ws + W_MAIN) + (size_t)n * 1024, nullptr, tl, k0);
      } else if (item < 768) {
        int n = ((item - 384) >> 2) * 32, k0 = (item & 3) * 256;
        int col = n < 2048 ? 4104 + n : (n < 2560 ? 1544 + (n - 2048) : 3592 + (n - 2560));
        wt_chunk(p.w_in + col, NIN, 1024, reinterpret_cast<u16*>(p.ws + W_G2) + (size_t)n * 1024, nullptr, tl, k0);
      } else if (item < 832) {
        int n = ((item - 768) >> 1) * 32, k0 = (item & 1) * 256;
        wt_chunk(p.w_branch_a + n, 1024, 512, reinterpret_cast<u16*>(p.ws + W_A) + (size_t)n * 512, nullptr, tl, k0);
      } else if (item < 896) {
        int n = ((item - 832) >> 1) * 32, k0 = (item & 1) * 256;
        wt_chunk(p.w_branch_b + n, 1024, 512, reinterpret_cast<u16*>(p.ws + W_B) + (size_t)n * 512, nullptr, tl, k0);
      } else {
        int n = ((item - 896) >> 2) * 32, k0 = (item & 3) * 256;
        wt_chunk(p.w_out + n, 1024, 1024, reinterpret_cast<u16*>(p.ws + W_OUT) + (size_t)n * 1024, nullptr, tl, k0);
      }
    } else {
      int row = (item - NWT) * 4 + w;
      const float* x = row < TP ? p.x_prompt + (size_t)row * DM : p.x_sample + (size_t)(row - TP) * DM;
      float4 xv[4];
      float ss = 0.f;
#pragma unroll
      for (int i = 0; i < 4; ++i) {
        xv[i] = *reinterpret_cast<const float4*>(x + i * 256 + lane * 4);
        ss += xv[i].x * xv[i].x + xv[i].y * xv[i].y + xv[i].z * xv[i].z + xv[i].w * xv[i].w;
      }
      ss = wave_sum(ss);
      float rstd = rsqrtf(ss * (1.f / DM) + EPS);
      float dot[8];
#pragma unroll
      for (int c = 0; c < 8; ++c) dot[c] = 0.f;
      u16* hrow = reinterpret_cast<u16*>(reinterpret_cast<char*>(p.out) + YB_H) + (size_t)row * DM;
#pragma unroll
      for (int i = 0; i < 4; ++i) {
        int k = i * 256 + lane * 4;
        float4 g = *reinterpret_cast<const float4*>(p.g_attn + k);
        float h0 = xv[i].x * rstd * g.x, h1 = xv[i].y * rstd * g.y, h2 = xv[i].z * rstd * g.z, h3 = xv[i].w * rstd * g.w;
        *reinterpret_cast<uint2*>(hrow + k) = make_uint2(pack2(h0, h1), pack2(h2, h3));
        float hh[4] = {h0, h1, h2, h3};
#pragma unroll
        for (int j = 0; j < 4; ++j) {
          float4 wa = *reinterpret_cast<const float4*>(wab + (k + j) * 8);
          float4 wb = *reinterpret_cast<const float4*>(wab + (k + j) * 8 + 4);
          dot[0] += hh[j] * wa.x; dot[1] += hh[j] * wa.y; dot[2] += hh[j] * wa.z; dot[3] += hh[j] * wa.w;
          dot[4] += hh[j] * wb.x; dot[5] += hh[j] * wb.y; dot[6] += hh[j] * wb.z; dot[7] += hh[j] * wb.w;
        }
      }
#pragma unroll
      for (int c = 0; c < 8; ++c) dot[c] = wave_sum(dot[c]);
      if (lane < 4) {
        float aa = lane == 0 ? dot[0] : lane == 1 ? dot[1] : lane == 2 ? dot[2] : dot[3];
        float xx = aa + p.dt_bias[lane];
        float sp = xx > 20.f ? xx : log1pf(__expf(xx));
        reinterpret_cast<float*>(p.ws + SM_GDEC)[(size_t)row * 4 + lane] = -__expf(p.a_log[lane]) * sp;
      } else if (lane < 8) {
        float ba = lane == 4 ? dot[4] : lane == 5 ? dot[5] : lane == 6 ? dot[6] : dot[7];
        reinterpret_cast<float*>(p.ws + SM_BETA)[(size_t)row * 4 + lane - 4] = sigmoid_f(ba);
      }
    }
  }
}

enum { EPI_Z1 = 0, EPI_Z2 = 1, EPI_MIXA = 2, EPI_MIXB = 3, EPI_WOUT = 4, EPI_FFN1 = 5, EPI_FFN2 = 6, EPI_FFN2S = 7, EPI_FFN1S = 8 };
namespace pg8 {
constexpr int BM = 256, BK = 64, HALF = 128, HTB = HALF * BK * 2, STAGE_BYTES = 8 * HTB, NXCD = 8, WGM = 8;
__device__ __forceinline__ int lds_byte(int r, int c) { const int st = (r >> 4) * 2 + (c >> 5), rr = r & 15, cc = c & 31, ob = rr * 64 + cc * 2; return st * 1024 + (ob ^ (((ob >> 9) & 1) << 5)); }
__device__ __forceinline__ void stage_rc(int b, int& R, int& C) { const int st = b / 1024, sb = b % 1024, swz = sb ^ (((sb >> 9) & 1) << 5); R = (st >> 1) * 16 + swz / 64; C = (st & 1) * 32 + (swz % 64) / 2; }
__device__ __forceinline__ int perm32(int rho) { const int n = rho >> 4, i = rho & 15; return 8 * (i >> 2) + 4 * n + (i & 3); }
struct Unit { int pm, pn, ks; };
struct StaticOrder {
  int nM, nN, nwg, G, c;
  __device__ void init(int M, int N, int G_, int c_) { nM = M / BM; nN = N / BM; nwg = nM * nN; G = G_; c = c_; }
  __device__ bool next(int i, Unit& u) const {
    const long L = (long)i * G + c; if (L >= nwg) return false;
    int wgid = (int)L; { const int q = nwg / NXCD, r = nwg % NXCD, xcd = wgid % NXCD, off = wgid / NXCD; wgid = (xcd < r ? xcd * (q + 1) : r * (q + 1) + (xcd - r) * q) + off; }
    const int nig = WGM * nN, gid = wgid / nig, fm = gid * WGM, gsz = (nM - fm) < WGM ? (nM - fm) : WGM;
    u.pm = fm + ((wgid % nig) % gsz); u.pn = (wgid % nig) / gsz; return true;
  }
};
struct SchedStatic {
  StaticOrder S; int pm0;
  __device__ void init(int M, int N, int G, int c, int pm0_) { S.init(M, N, G, c); pm0 = pm0_; }
  __device__ bool next(int i, Unit& u) const { if (S.c >= S.G || !S.next(i, u)) return false; u.pm += pm0; u.ks = 0; return true; }
};
struct SchedSplit {
  int nN, nS, pm0, G, c, total;
  __device__ void init(int nM, int nN_, int nS_, int G_, int c_, int pm0_) { nN = nN_; nS = nS_; pm0 = pm0_; G = G_; c = c_; total = nM * nN_ * nS_; }
  __device__ bool next(int i, Unit& u) const {
    const int L = i * G + c; if (c >= G || L >= total) return false;
    u.ks = L % nS; const int t = L / nS; u.pn = t % nN; u.pm = pm0 + t / nN; return true;
  }
};
}

__device__ __forceinline__ float dpp_ror1(float v) { return __int_as_float(__builtin_amdgcn_update_dpp(0, __float_as_int(v), 0x121, 0xf, 0xf, false)); }
__device__ __forceinline__ float dpp_ror2(float v) { return __int_as_float(__builtin_amdgcn_update_dpp(0, __float_as_int(v), 0x122, 0xf, 0xf, false)); }

template <int MODE>
__device__ __forceinline__ void gemm_epilogue(const Params& p, f32x4 (&acc)[2][2][4][2], const pg8::Unit& u, int wr, int wc, int fr, int fq) {
  const int row0 = u.pm * 256 + wr * 64 + fr, col0 = u.pn * 256 + wc * 32 + 8 * fq;
  if constexpr (MODE == EPI_Z1 || MODE == EPI_Z2) {
#pragma unroll
    for (int ai = 0; ai < 2; ++ai)
#pragma unroll
      for (int m = 0; m < 4; ++m) {
        const int row = row0 + ai * 128 + m * 16;
        u16* rowp = (MODE == EPI_Z1 ? reinterpret_cast<u16*>(p.ws + Z1) + (size_t)row * 3072 : const_cast<u16*>(z2row(p, row))) + col0;
#pragma unroll
        for (int bj = 0; bj < 2; ++bj) {
          const f32x4 v0 = acc[ai][bj][m][0], v1 = acc[ai][bj][m][1];
          *reinterpret_cast<uint4*>(rowp + bj * 128) = make_uint4(pack2(v0[0], v0[1]), pack2(v0[2], v0[3]), pack2(v1[0], v1[1]), pack2(v1[2], v1[3]));
        }
        if (MODE == EPI_Z1 && u.pn < 6) {
          float* dst = nullptr;
          if (row < TP) {
            int pos = row & 2047;
            if (pos >= 2045) dst = p.out + O_CONVP + (size_t)((row >> 11) * 3 + pos - 2045) * 1536 + col0;
          } else {
            int pos = (row - TP) & 3;
            if (pos >= 1) dst = p.out + O_CONVS + (size_t)(((row - TP) >> 2) * 3 + pos - 1) * 1536 + col0;
          }
          if (dst) {
#pragma unroll
            for (int bj = 0; bj < 2; ++bj) {
              const f32x4 v0 = acc[ai][bj][m][0], v1 = acc[ai][bj][m][1];
              *reinterpret_cast<float4*>(dst + bj * 128) = make_float4(v0[0], v0[1], v0[2], v0[3]);
              *reinterpret_cast<float4*>(dst + bj * 128 + 4) = make_float4(v1[0], v1[1], v1[2], v1[3]);
            }
          }
        }
      }
  } else if constexpr (MODE == EPI_MIXA || MODE == EPI_MIXB) {
    u16* Mx = reinterpret_cast<u16*>(p.ws + MIX);
#pragma unroll
    for (int ai = 0; ai < 2; ++ai)
#pragma unroll
      for (int m = 0; m < 4; ++m) {
        const int row = row0 + ai * 128 + m * 16;
#pragma unroll
        for (int bj = 0; bj < 2; ++bj) {
          const int col = col0 + bj * 128;
          const uint4 gv = *reinterpret_cast<const uint4*>(z2row(p, row) + (MODE == EPI_MIXB ? 1024 : 0) + col);
          u16* mp = Mx + (size_t)row * 1024 + col;
          const f32x4 v0 = acc[ai][bj][m][0], v1 = acc[ai][bj][m][1];
          float r0 = v0[0] * sigmoid_f(lo2f(gv.x)), r1 = v0[1] * sigmoid_f(hi2f(gv.x));
          float r2 = v0[2] * sigmoid_f(lo2f(gv.y)), r3 = v0[3] * sigmoid_f(hi2f(gv.y));
          float r4 = v1[0] * sigmoid_f(lo2f(gv.z)), r5 = v1[1] * sigmoid_f(hi2f(gv.z));
          float r6 = v1[2] * sigmoid_f(lo2f(gv.w)), r7 = v1[3] * sigmoid_f(hi2f(gv.w));
          if (MODE == EPI_MIXB) {
            const uint4 mv = *reinterpret_cast<const uint4*>(mp);
            r0 += lo2f(mv.x); r1 += hi2f(mv.x); r2 += lo2f(mv.y); r3 += hi2f(mv.y);
            r4 += lo2f(mv.z); r5 += hi2f(mv.z); r6 += lo2f(mv.w); r7 += hi2f(mv.w);
          }
          *reinterpret_cast<uint4*>(mp) = make_uint4(pack2(r0, r1), pack2(r2, r3), pack2(r4, r5), pack2(r6, r7));
        }
        asm volatile("" ::: "memory");
      }
  } else if constexpr (MODE == EPI_WOUT) {
    float* rowss = reinterpret_cast<float*>(p.ws + SM_ROWSS);
    u16* XB = reinterpret_cast<u16*>(p.ws + X1B);
#pragma unroll
    for (int ai = 0; ai < 2; ++ai)
#pragma unroll
      for (int m = 0; m < 4; ++m) {
        const int row = row0 + ai * 128 + m * 16;
        const float* x = (row < TP ? p.x_prompt + (size_t)row * DM : p.x_sample + (size_t)(row - TP) * DM) + col0;
        float* y = p.out + O_YP + (size_t)row * DM + col0;
        float ss = 0.f;
#pragma unroll
        for (int bj = 0; bj < 2; ++bj) {
          const float4 x0 = *reinterpret_cast<const float4*>(x + bj * 128), x1 = *reinterpret_cast<const float4*>(x + bj * 128 + 4);
          const f32x4 a0 = acc[ai][bj][m][0], a1 = acc[ai][bj][m][1];
          const float4 v0 = make_float4(a0[0] + x0.x, a0[1] + x0.y, a0[2] + x0.z, a0[3] + x0.w);
          const float4 v1 = make_float4(a1[0] + x1.x, a1[1] + x1.y, a1[2] + x1.z, a1[3] + x1.w);
          *reinterpret_cast<float4*>(y + bj * 128) = v0;
          *reinterpret_cast<float4*>(y + bj * 128 + 4) = v1;
          *reinterpret_cast<uint4*>(XB + (size_t)row * DM + col0 + bj * 128) =
              make_uint4(pack2(v0.x, v0.y), pack2(v0.z, v0.w), pack2(v1.x, v1.y), pack2(v1.z, v1.w));
          ss += v0.x * v0.x + v0.y * v0.y + v0.z * v0.z + v0.w * v0.w + v1.x * v1.x + v1.y * v1.y + v1.z * v1.z + v1.w * v1.w;
        }
        ss += __shfl_xor(ss, 16, 64);
        ss += __shfl_xor(ss, 32, 64);
        if (fq == 0) atomicAdd(rowss + row, ss);
        asm volatile("" ::: "memory");
      }
  } else if constexpr (MODE == EPI_FFN2) {
#pragma unroll
    for (int ai = 0; ai < 2; ++ai)
#pragma unroll
      for (int m = 0; m < 4; ++m) {
        float* y = p.out + O_YP + (size_t)(row0 + ai * 128 + m * 16) * DM + col0;
#pragma unroll
        for (int bj = 0; bj < 2; ++bj) {
          float4 y0 = *reinterpret_cast<const float4*>(y + bj * 128), y1 = *reinterpret_cast<const float4*>(y + bj * 128 + 4);
          const f32x4 a0 = acc[ai][bj][m][0], a1 = acc[ai][bj][m][1];
          y0.x += a0[0]; y0.y += a0[1]; y0.z += a0[2]; y0.w += a0[3];
          y1.x += a1[0]; y1.y += a1[1]; y1.z += a1[2]; y1.w += a1[3];
          *reinterpret_cast<float4*>(y + bj * 128) = y0;
          *reinterpret_cast<float4*>(y + bj * 128 + 4) = y1;
        }
        asm volatile("" ::: "memory");
      }
  } else if constexpr (MODE == EPI_FFN2S) {
    float* part = reinterpret_cast<float*>(p.ws + PART) + (size_t)u.ks * TS * 1024;
#pragma unroll
    for (int ai = 0; ai < 2; ++ai)
#pragma unroll
      for (int m = 0; m < 4; ++m) {
        float* y = part + (size_t)(row0 + ai * 128 + m * 16 - TP) * 1024 + col0;
#pragma unroll
        for (int bj = 0; bj < 2; ++bj) {
          const f32x4 a0 = acc[ai][bj][m][0], a1 = acc[ai][bj][m][1];
          *reinterpret_cast<float4*>(y + bj * 128) = make_float4(a0[0], a0[1], a0[2], a0[3]);
          *reinterpret_cast<float4*>(y + bj * 128 + 4) = make_float4(a1[0], a1[1], a1[2], a1[3]);
        }
      }
  } else if constexpr (MODE == EPI_FFN1 || MODE == EPI_FFN1S) {
    const float* rowss = reinterpret_cast<const float*>(p.ws + SM_ROWSS);
    u16* ACTp = reinterpret_cast<u16*>(p.ws + ACT);
    float* haloG = reinterpret_cast<float*>(p.ws + HALO_G);
    float* headG = reinterpret_cast<float*>(p.ws + HEAD_G);
    float* headU = reinterpret_cast<float*>(p.ws + HEAD_U);
    const int ch = u.pn * 128 + wc * 32 + 8 * fq;
    float w0[8], w1[8], w2[8];
#pragma unroll
    for (int c = 0; c < 8; ++c) { w0[c] = p.w_ffn_conv[ch + c]; w1[c] = p.w_ffn_conv[DFF + ch + c]; w2[c] = p.w_ffn_conv[2 * DFF + ch + c]; }
    if constexpr (MODE == EPI_FFN1) {
#pragma unroll
      for (int ai = 0; ai < 2; ++ai) {
        const int blk = u.pm * 4 + ai * 2 + wr;
        const bool seqstart = (blk & 31) == 0, seqend = (blk & 31) == 31;
        float gprev[8];
#pragma unroll
        for (int c = 0; c < 8; ++c) gprev[c] = 0.f;
#pragma unroll
        for (int m = 0; m < 4; ++m) {
          const int row = row0 + ai * 128 + m * 16;
          const float rs = rsqrtf(rowss[row] * (1.f / DM) + EPS);
          float g0[8], uu[8];
#pragma unroll
          for (int c = 0; c < 4; ++c) {
            g0[c] = acc[ai][0][m][0][c] * rs; g0[4 + c] = acc[ai][0][m][1][c] * rs;
            uu[c] = acc[ai][1][m][0][c] * rs; uu[4 + c] = acc[ai][1][m][1][c] * rs;
          }
          float r[8];
#pragma unroll
          for (int c = 0; c < 8; ++c) {
            float gm1 = __int_as_float(__builtin_amdgcn_update_dpp(__float_as_int(dpp_ror1(gprev[c])), __float_as_int(g0[c]), 0x111, 0xf, 0xf, false));
            float gm2 = __int_as_float(__builtin_amdgcn_update_dpp(__float_as_int(dpp_ror2(gprev[c])), __float_as_int(g0[c]), 0x112, 0xf, 0xf, false));
            r[c] = silu_f(w0[c] * gm2 + w1[c] * gm1 + w2[c] * g0[c]) * uu[c];
          }
          bool defer = false;
          if (m == 0) {
            defer = !seqstart && fr < 2;
            if (defer) {
              float* dg = headG + (size_t)(blk * 2 + fr) * DFF + ch;
              float* du = headU + (size_t)(blk * 2 + fr) * DFF + ch;
              *reinterpret_cast<float4*>(dg) = make_float4(g0[0], g0[1], g0[2], g0[3]);
              *reinterpret_cast<float4*>(dg + 4) = make_float4(g0[4], g0[5], g0[6], g0[7]);
              *reinterpret_cast<float4*>(du) = make_float4(uu[0], uu[1], uu[2], uu[3]);
              *reinterpret_cast<float4*>(du + 4) = make_float4(uu[4], uu[5], uu[6], uu[7]);
            }
          }
          if (m == 3) {
            if (fr >= 14) {
              float* d = haloG + (size_t)(blk * 2 + fr - 14) * DFF + ch;
              *reinterpret_cast<float4*>(d) = make_float4(g0[0], g0[1], g0[2], g0[3]);
              *reinterpret_cast<float4*>(d + 4) = make_float4(g0[4], g0[5], g0[6], g0[7]);
              if (seqend) {
                float* o = p.out + O_FFNP + (size_t)((row >> 11) * 2 + fr - 14) * DFF + ch;
                *reinterpret_cast<float4*>(o) = make_float4(g0[0], g0[1], g0[2], g0[3]);
                *reinterpret_cast<float4*>(o + 4) = make_float4(g0[4], g0[5], g0[6], g0[7]);
              }
            }
          }
          if (!defer)
            *reinterpret_cast<uint4*>(ACTp + (size_t)row * DFF + ch) = make_uint4(pack2(r[0], r[1]), pack2(r[2], r[3]), pack2(r[4], r[5]), pack2(r[6], r[7]));
#pragma unroll
          for (int c = 0; c < 8; ++c) gprev[c] = g0[c];
          asm volatile("" ::: "memory");
        }
      }
    } else {
#pragma unroll
    for (int ai = 0; ai < 2; ++ai) {
      const int blk = u.pm * 4 + ai * 2 + wr;
      float gprev[8];
#pragma unroll
      for (int c = 0; c < 8; ++c) gprev[c] = 0.f;
#pragma unroll
      for (int m = 0; m < 4; ++m) {
        const int row = row0 + ai * 128 + m * 16;
        const int r64 = m * 16 + fr;
        const float rs = rsqrtf(rowss[row] * (1.f / DM) + EPS);
        float g0[8], uu[8];
#pragma unroll
        for (int c = 0; c < 4; ++c) {
          g0[c] = acc[ai][0][m][0][c] * rs; g0[4 + c] = acc[ai][0][m][1][c] * rs;
          uu[c] = acc[ai][1][m][0][c] * rs; uu[4 + c] = acc[ai][1][m][1][c] * rs;
        }
        const bool prompt = row < TP;
        int pos, b;
        if (prompt) { pos = row & 2047; b = row >> 11; } else { pos = (row - TP) & 3; b = (row - TP) >> 2; }
        const bool defer = (pos >= 1 && r64 < 1) || (pos >= 2 && r64 < 2);
        float gm1[8], gm2[8];
#pragma unroll
        for (int c = 0; c < 8; ++c) {
          gm1[c] = __int_as_float(__builtin_amdgcn_update_dpp(__float_as_int(dpp_ror1(gprev[c])), __float_as_int(g0[c]), 0x111, 0xf, 0xf, false));
          gm2[c] = __int_as_float(__builtin_amdgcn_update_dpp(__float_as_int(dpp_ror2(gprev[c])), __float_as_int(g0[c]), 0x112, 0xf, 0xf, false));
        }
        if (pos < 1) {
#pragma unroll
          for (int c = 0; c < 8; ++c) gm1[c] = prompt ? 0.f : p.cache_ffn[(size_t)(b * 2 + 1) * DFF + ch + c];
        }
        if (pos < 2) {
#pragma unroll
          for (int c = 0; c < 8; ++c) gm2[c] = prompt ? 0.f : p.cache_ffn[(size_t)(b * 2 + pos) * DFF + ch + c];
        }
        if (r64 >= 62) {
          float* d = haloG + (size_t)(blk * 2 + r64 - 62) * DFF + ch;
          *reinterpret_cast<float4*>(d) = make_float4(g0[0], g0[1], g0[2], g0[3]);
          *reinterpret_cast<float4*>(d + 4) = make_float4(g0[4], g0[5], g0[6], g0[7]);
        }
        {
          float* d = nullptr;
          if (prompt) { if (pos >= 2046) d = p.out + O_FFNP + (size_t)(b * 2 + pos - 2046) * DFF + ch; }
          else { if (pos >= 2) d = p.out + O_FFNS + (size_t)(b * 2 + pos - 2) * DFF + ch; }
          if (d) {
            *reinterpret_cast<float4*>(d) = make_float4(g0[0], g0[1], g0[2], g0[3]);
            *reinterpret_cast<float4*>(d + 4) = make_float4(g0[4], g0[5], g0[6], g0[7]);
          }
        }
        if (defer) {
          float* dg = headG + (size_t)(blk * 2 + r64) * DFF + ch;
          float* du = headU + (size_t)(blk * 2 + r64) * DFF + ch;
          *reinterpret_cast<float4*>(dg) = make_float4(g0[0], g0[1], g0[2], g0[3]);
          *reinterpret_cast<float4*>(dg + 4) = make_float4(g0[4], g0[5], g0[6], g0[7]);
          *reinterpret_cast<float4*>(du) = make_float4(uu[0], uu[1], uu[2], uu[3]);
          *reinterpret_cast<float4*>(du + 4) = make_float4(uu[4], uu[5], uu[6], uu[7]);
        } else {
          float r[8];
#pragma unroll
          for (int c = 0; c < 8; ++c) r[c] = silu_f(w0[c] * gm2[c] + w1[c] * gm1[c] + w2[c] * g0[c]) * uu[c];
          *reinterpret_cast<uint4*>(ACTp + (size_t)row * DFF + ch) = make_uint4(pack2(r[0], r[1]), pack2(r[2], r[3]), pack2(r[4], r[5]), pack2(r[6], r[7]));
        }
#pragma unroll
        for (int c = 0; c < 8; ++c) gprev[c] = g0[c];
        asm volatile("" ::: "memory");
      }
    }
    }
  }
}

template <int MODE, class Sched>
__device__ __forceinline__ void gemm_phase8(const Params& p, const u16* Ag, const u16* Btg, int ld, int Kunit, LAS unsigned char* lds, const Sched& S) {
  using namespace pg8;
  const int tid = threadIdx.x, wid = __builtin_amdgcn_readfirstlane(tid >> 6), lane = tid & 63, wr = wid >> 2, wc = wid & 3, fr = lane & 15, fq = lane >> 4;
  const int nt = Kunit / BK;
  unsigned voffA[2], voffB[2];
#pragma unroll
  for (int i = 0; i < 2; ++i) { int R, C; stage_rc(tid * 16 + i * 8192, R, C); const int Rb = (R & ~31) + perm32(R & 31);
    voffA[i] = (unsigned)(R * ld + C) * 2u; voffB[i] = (unsigned)(Rb * ld + C) * 2u; }
  const size_t kstep = (size_t)(BK * 2);
  const size_t hstep = (size_t)HALF * ld * 2;
  const size_t tstep = 2 * hstep;
  const size_t kub = (size_t)Kunit * 2;
  const unsigned ldsw = (unsigned)wid * 1024u;
  const int aoff = lds_byte(wr * 64 + fr, fq * 8), boff = lds_byte(wc * 32 + fr, fq * 8);
#define PG8_SA(b, h) (((b) * 2 + (h)) * HTB)
#define PG8_SB(b, h) ((4 + (b) * 2 + (h)) * HTB)
#define PG8_STAGE(bufoff, gbase, voff) do { _Pragma("unroll") for (int _i = 0; _i < 2; ++_i) \
    __builtin_amdgcn_global_load_lds((const unsigned*)((const char*)(gbase) + (voff)[_i]), (LAS unsigned*)(lds + (bufoff) + ldsw + _i * 8192), 16, 0, 0); } while (0)
#define PG8_LDA(dst, b, h) do { _Pragma("unroll") for (int m = 0; m < 4; ++m) _Pragma("unroll") for (int k = 0; k < 2; ++k) dst[m][k] = *(const LAS bf16x8*)(lds + PG8_SA(b, h) + aoff + m * 2048 + k * 1024); } while (0)
#define PG8_LDB(dst, b, h) do { _Pragma("unroll") for (int n = 0; n < 2; ++n) _Pragma("unroll") for (int k = 0; k < 2; ++k) dst[n][k] = *(const LAS bf16x8*)(lds + PG8_SB(b, h) + boff + n * 2048 + k * 1024); } while (0)
#define PG8_MMA(ai, bj, At, Bt) do { __builtin_amdgcn_s_setprio(1); _Pragma("unroll") for (int m = 0; m < 4; ++m) _Pragma("unroll") for (int n = 0; n < 2; ++n) _Pragma("unroll") for (int k = 0; k < 2; ++k) \
    acc[ai][bj][m][n] = __builtin_amdgcn_mfma_f32_16x16x32_bf16(Bt[n][k], At[m][k], acc[ai][bj][m][n], 0, 0, 0); __builtin_amdgcn_s_setprio(0); } while (0)
#define PG8_WAIT_V(n) asm volatile("s_waitcnt vmcnt(" #n ")" ::: "memory")
#define PG8_WAIT_L(n) asm volatile("s_waitcnt lgkmcnt(" #n ")" ::: "memory")
#define PG8_BAR __builtin_amdgcn_s_barrier()
#define PG8_SCHED __builtin_amdgcn_sched_barrier(0)
  Unit cur, nxt; int ui = 0;
  if (!S.next(0, cur)) return;
  f32x4 acc[2][2][4][2];
#pragma unroll
  for (int a = 0; a < 2; ++a)
#pragma unroll
    for (int b = 0; b < 2; ++b)
#pragma unroll
      for (int m = 0; m < 4; ++m)
#pragma unroll
        for (int n = 0; n < 2; ++n) acc[a][b][m][n] = (f32x4){0.f, 0.f, 0.f, 0.f};
  bf16x8 At[4][2], B0[2][2], B1[2][2];
  const char* cA = (const char*)Ag + (size_t)cur.pm * tstep + cur.ks * kub; const char* cB = (const char*)Btg + (size_t)cur.pn * tstep + cur.ks * kub;
  PG8_STAGE(PG8_SB(0, 0), cB, voffB); PG8_STAGE(PG8_SA(0, 0), cA, voffA); PG8_STAGE(PG8_SB(0, 1), cB + hstep, voffB); PG8_STAGE(PG8_SA(0, 1), cA + hstep, voffA);
  if (wr == 1) PG8_BAR;
  PG8_WAIT_V(4); PG8_BAR;
  PG8_STAGE(PG8_SB(1, 0), cB + kstep, voffB); PG8_STAGE(PG8_SA(1, 0), cA + kstep, voffA); PG8_STAGE(PG8_SB(1, 1), cB + hstep + kstep, voffB);
  PG8_WAIT_V(6); PG8_BAR;
  for (;;) {
    const bool has_next = S.next(ui + 1, nxt);
    const char* nA = has_next ? (const char*)Ag + (size_t)nxt.pm * tstep + nxt.ks * kub : cA; const char* nB = has_next ? (const char*)Btg + (size_t)nxt.pn * tstep + nxt.ks * kub : cB;
    for (int t = 0; t < nt; t += 2) {
      const bool last = (t == nt - 2);
      const char* a1 = cA + (size_t)(t + 1) * kstep;
      const char* a2 = last ? nA : cA + (size_t)(t + 2) * kstep; const char* b2 = last ? nB : cB + (size_t)(t + 2) * kstep;
      const char* a3 = a2 + kstep; const char* b3 = b2 + kstep;
      PG8_LDB(B0, 0, 0); PG8_SCHED; PG8_LDA(At, 0, 0); PG8_STAGE(PG8_SA(1, 1), a1 + hstep, voffA);
      PG8_WAIT_L(8); PG8_BAR; PG8_WAIT_L(0); PG8_MMA(0, 0, At, B0); PG8_BAR; PG8_SCHED;
      PG8_LDB(B1, 0, 1); PG8_STAGE(PG8_SB(0, 0), b2, voffB);
      PG8_BAR; PG8_WAIT_L(0); PG8_MMA(0, 1, At, B1); PG8_BAR;
      PG8_LDA(At, 0, 1); PG8_STAGE(PG8_SA(0, 0), a2, voffA);
      PG8_BAR; PG8_WAIT_L(0); PG8_MMA(1, 0, At, B0); PG8_BAR; PG8_SCHED;
      PG8_STAGE(PG8_SB(0, 1), b2 + hstep, voffB);
      PG8_WAIT_V(6); PG8_BAR; PG8_MMA(1, 1, At, B1); PG8_BAR;
      PG8_LDB(B0, 1, 0); PG8_SCHED; PG8_LDA(At, 1, 0); PG8_STAGE(PG8_SA(0, 1), a2 + hstep, voffA);
      PG8_WAIT_L(8); PG8_BAR; PG8_WAIT_L(0); PG8_MMA(0, 0, At, B0); PG8_BAR; PG8_SCHED;
      PG8_LDB(B1, 1, 1); PG8_STAGE(PG8_SB(1, 0), b3, voffB);
      PG8_BAR; PG8_WAIT_L(0); PG8_MMA(0, 1, At, B1); PG8_BAR;
      PG8_LDA(At, 1, 1); PG8_STAGE(PG8_SA(1, 0), a3, voffA);
      PG8_BAR; PG8_WAIT_L(0); PG8_MMA(1, 0, At, B0); PG8_BAR; PG8_SCHED;
      PG8_STAGE(PG8_SB(1, 1), b3 + hstep, voffB);
      PG8_WAIT_V(6); PG8_BAR; PG8_MMA(1, 1, At, B1); PG8_BAR;
    }
    gemm_epilogue<MODE>(p, acc, cur, wr, wc, fr, fq);
    if (!has_next) break;
#pragma unroll
    for (int a = 0; a < 2; ++a)
#pragma unroll
      for (int b = 0; b < 2; ++b)
#pragma unroll
        for (int m = 0; m < 4; ++m)
#pragma unroll
          for (int n = 0; n < 2; ++n) acc[a][b][m][n] = (f32x4){0.f, 0.f, 0.f, 0.f};
    cur = nxt; cA = nA; cB = nB; ++ui;
  }
  PG8_WAIT_V(0);
  if (wr == 0) PG8_BAR;
  PG8_BAR;
#undef PG8_SA
#undef PG8_SB
#undef PG8_STAGE
#undef PG8_LDA
#undef PG8_LDB
#undef PG8_MMA
#undef PG8_WAIT_V
#undef PG8_WAIT_L
#undef PG8_BAR
#undef PG8_SCHED
}


template <int PASS>
__device__ __forceinline__ void delta_rowpass(const Params& p, int t0, int n, int h, int w, int lane, float Gv, u16* RA, u16* RBk,
                                              u16* RC) {
  const u16* Zp = reinterpret_cast<const u16*>(p.ws + Z1);
  const float* betap = reinterpret_cast<const float*>(p.ws + SM_BETA);
  const int c1 = (PASS == 0 ? 0 : 512) + h * 128 + 2 * lane;
  const int c2 = (PASS == 0 ? 512 : 1024) + h * 128 + 2 * lane;
  float w1[4][2], w2[4][2];
#pragma unroll
  for (int j = 0; j < 4; ++j) {
    w1[j][0] = p.w_conv_a[j * 1536 + c1]; w1[j][1] = p.w_conv_a[j * 1536 + c1 + 1];
    w2[j][0] = p.w_conv_a[j * 1536 + c2]; w2[j][1] = p.w_conv_a[j * 1536 + c2 + 1];
  }
  const int r0 = 16 * w;
  const u16* zbase = Zp + (size_t)(t0 + r0) * 3072;
  float h1[3][2], h2[3][2];
#pragma unroll
  for (int j = 0; j < 3; ++j) {
    unsigned ua = 0u, ub = 0u;
    if (n * 64 + r0 + j - 3 >= 0) {
      ua = *reinterpret_cast<const unsigned*>(zbase + (ptrdiff_t)(j - 3) * 3072 + c1);
      ub = *reinterpret_cast<const unsigned*>(zbase + (ptrdiff_t)(j - 3) * 3072 + c2);
    }
    h1[j][0] = lo2f(ua); h1[j][1] = hi2f(ua); h2[j][0] = lo2f(ub); h2[j][1] = hi2f(ub);
  }
  unsigned qa0, qa1, qa2, qa3, qa4, qa5, qb0, qb1, qb2, qb3, qb4, qb5;
#define RLOAD(i, A_, B_) A_ = *reinterpret_cast<const unsigned*>(zbase + (size_t)(i) * 3072 + c1); B_ = *reinterpret_cast<const unsigned*>(zbase + (size_t)(i) * 3072 + c2);
  RLOAD(0, qa0, qb0) RLOAD(1, qa1, qb1) RLOAD(2, qa2, qb2) RLOAD(3, qa3, qb3) RLOAD(4, qa4, qb4) RLOAD(5, qa5, qb5)
#pragma unroll 1
  for (int rr = 0; rr < 16; ++rr) {
    const int r = r0 + rr;
    const unsigned ua = qa0, ub = qb0;
    qa0 = qa1; qa1 = qa2; qa2 = qa3; qa3 = qa4; qa4 = qa5;
    qb0 = qb1; qb1 = qb2; qb2 = qb3; qb3 = qb4; qb4 = qb5;
    if (rr + 6 < 16) { RLOAD(rr + 6, qa5, qb5) }
    const float a0 = lo2f(ua), a1 = hi2f(ua), b0 = lo2f(ub), b1 = hi2f(ub);
    float y10 = silu_f(w1[0][0] * h1[0][0] + w1[1][0] * h1[1][0] + w1[2][0] * h1[2][0] + w1[3][0] * a0);
    float y11 = silu_f(w1[0][1] * h1[0][1] + w1[1][1] * h1[1][1] + w1[2][1] * h1[2][1] + w1[3][1] * a1);
    float y20 = silu_f(w2[0][0] * h2[0][0] + w2[1][0] * h2[1][0] + w2[2][0] * h2[2][0] + w2[3][0] * b0);
    float y21 = silu_f(w2[0][1] * h2[0][1] + w2[1][1] * h2[1][1] + w2[2][1] * h2[2][1] + w2[3][1] * b1);
    const float bt = betap[(size_t)(t0 + r) * 4 + h];
    if (PASS == 0) {
      float qs = wave_sum(y10 * y10 + y11 * y11), ks = wave_sum(y20 * y20 + y21 * y21);
      float qn = rsqrtf(qs + EPS) * 0.08838834764831845f, kn = rsqrtf(ks + EPS);
      float k0 = y20 * kn, k1 = y21 * kn;
      *reinterpret_cast<unsigned*>(RA + r * 136 + 2 * lane) = pack2(k0, k1);
      *reinterpret_cast<unsigned*>(RBk + r * 136 + 2 * lane) = pack2(k0 * bt, k1 * bt);
      *reinterpret_cast<unsigned*>(RC + r * 136 + 2 * lane) = pack2(y10 * qn, y11 * qn);
    } else {
      float ks = wave_sum(y10 * y10 + y11 * y11);
      float sc = rsqrtf(ks + EPS) * bt * __expf(__shfl(Gv, r, 64));
      RA[(2 * lane) * 72 + r] = f2bf(y10 * sc);
      RA[(2 * lane + 1) * 72 + r] = f2bf(y11 * sc);
      RC[(2 * lane) * 72 + r] = f2bf(y20 * bt);
      RC[(2 * lane + 1) * 72 + r] = f2bf(y21 * bt);
    }
#pragma unroll
    for (int c = 0; c < 2; ++c) {
      h1[0][c] = h1[1][c]; h1[1][c] = h1[2][c];
      h2[0][c] = h2[1][c]; h2[1][c] = h2[2][c];
    }
    h1[2][0] = a0; h1[2][1] = a1; h2[2][0] = b0; h2[2][1] = b1;
  }
#undef RLOAD
}

__device__ __forceinline__ void m1_delta_item(const Params& p, int item, char* smem) {
  const int tid = VTID, lane = tid & 63, w = tid >> 6, lr = lane & 15, lq = lane >> 4;
  const int h = item & 3, n = (item >> 2) & 31, b = item >> 7;
  const int t0 = b * 2048 + n * 64;
  u16* RA = reinterpret_cast<u16*>(smem);
  u16* RBk = reinterpret_cast<u16*>(smem + 18432);
  u16* RC = reinterpret_cast<u16*>(smem + 36864);
  u16* RD = reinterpret_cast<u16*>(smem + 55296);
  float* Gs = reinterpret_cast<float*>(smem + 73728);
  const float* gdec = reinterpret_cast<const float*>(p.ws + SM_GDEC);

  float Gv = gdec[(size_t)(t0 + lane) * 4 + h];
#pragma unroll
  for (int o = 1; o < 64; o <<= 1) {
    float tv = __shfl_up(Gv, o, 64);
    if (lane >= o) Gv += tv;
  }
  if (w == 0) {
    Gs[lane] = Gv;
    reinterpret_cast<float*>(p.ws + D_GC)[(size_t)item * 64 + lane] = Gv;
  }
  delta_rowpass<0>(p, t0, n, h, w, lane, Gv, RA, RBk, RC);
  __syncthreads();
  {
    f32x4 accL[4], accA[4];
#pragma unroll
    for (int jb = 0; jb < 4; ++jb) { accL[jb] = (f32x4){0.f, 0.f, 0.f, 0.f}; accA[jb] = (f32x4){0.f, 0.f, 0.f, 0.f}; }
#pragma unroll
    for (int ks = 0; ks < 4; ++ks) {
      bf16x8 a1 = lds_frag(RBk, 136, 16 * w, ks * 32, lane);
      bf16x8 a2 = lds_frag(RC, 136, 16 * w, ks * 32, lane);
#pragma unroll
      for (int jb = 0; jb < 4; ++jb) {
        if (jb <= w) {
          bf16x8 bb = lds_frag(RA, 136, 16 * jb, ks * 32, lane);
          accL[jb] = mfma16(a1, bb, accL[jb]);
          accA[jb] = mfma16(a2, bb, accA[jb]);
        }
      }
    }
    __syncthreads();
    float* Lm = reinterpret_cast<float*>(RBk);
#pragma unroll
    for (int jb = 0; jb < 4; ++jb)
#pragma unroll
      for (int j = 0; j < 4; ++j) {
        int i = 16 * w + 4 * lq + j, jj = jb * 16 + lr;
        float dec = __expf(fminf(Gs[i] - Gs[jj], 0.f));
        float lv = (i > jj) ? accL[jb][j] * dec : 0.f;
        float av = (i >= jj) ? accA[jb][j] * dec : 0.f;
        Lm[i * 64 + jj] = lv;
        RD[i * 72 + jj] = f2bf(av);
      }
  }
  __syncthreads();
  store_frags(RC, 136, 64, 128, reinterpret_cast<u16*>(p.ws + D_QF) + (size_t)item * 8192, tid, NTHR);
  store_frags(RD, 72, 64, 64, reinterpret_cast<u16*>(p.ws + D_ATT) + (size_t)item * 4096, tid, NTHR);
  store_frags_T(RA, 136, 128, 64, reinterpret_cast<u16*>(p.ws + D_KNT) + (size_t)item * 8192, tid, NTHR);
  __syncthreads();
  {
    const float* Lm = reinterpret_cast<const float*>(RBk);
    float* Tm = reinterpret_cast<float*>(RA);
    float* Ms = reinterpret_cast<float*>(RC) + w * 256;
    {
      const int c = lane & 15, i0 = 16 * w;
      float tc[16];
#pragma unroll
      for (int r = 0; r < 16; ++r) {
        float a = (r == c) ? 1.f : 0.f;
#pragma unroll
        for (int k = 0; k < r; ++k) a -= Lm[(i0 + r) * 64 + i0 + k] * tc[k];
        tc[r] = a;
      }
      if (lane < 16) {
#pragma unroll
        for (int r = 0; r < 16; ++r) Tm[(i0 + r) * 64 + i0 + c] = tc[r];
      }
    }
    __syncthreads();
    {
      const int j = w;
      for (int i = j + 1; i < 4; ++i) {
        f32x4 macc = (f32x4){0.f, 0.f, 0.f, 0.f};
        for (int k = j; k < i; ++k) {
#pragma unroll
          for (int ks = 0; ks < 4; ++ks) {
            float av = Lm[(16 * i + lr) * 64 + 16 * k + 4 * ks + lq];
            float bv = Tm[(16 * k + 4 * ks + lq) * 64 + 16 * j + lr];
            macc = __builtin_amdgcn_mfma_f32_16x16x4f32(av, bv, macc, 0, 0, 0);
          }
        }
#pragma unroll
        for (int r = 0; r < 4; ++r) Ms[(4 * lq + r) * 16 + lr] = macc[r];
        __builtin_amdgcn_wave_barrier();
        f32x4 tacc = (f32x4){0.f, 0.f, 0.f, 0.f};
#pragma unroll
        for (int ks = 0; ks < 4; ++ks) {
          float av = Tm[(16 * i + lr) * 64 + 16 * i + 4 * ks + lq];
          float bv = Ms[(4 * ks + lq) * 16 + lr];
          tacc = __builtin_amdgcn_mfma_f32_16x16x4f32(av, bv, tacc, 0, 0, 0);
        }
#pragma unroll
        for (int r = 0; r < 4; ++r) Tm[(16 * i + 4 * lq + r) * 64 + 16 * j + lr] = -tacc[r];
        __builtin_amdgcn_wave_barrier();
      }
    }
    __syncthreads();
    {
      u16* Tb = RD + 64 * 72;
      for (int idx = tid; idx < 4096; idx += NTHR) {
        int r = idx >> 6, c = idx & 63;
        float v = ((c >> 4) <= (r >> 4)) ? Tm[idx] : 0.f;
        Tb[r * 72 + c] = f2bf(v);
      }
    }
    __syncthreads();
  }
  delta_rowpass<1>(p, t0, n, h, w, lane, Gv, RA, RBk, RC);
  __syncthreads();
  {
    const u16* Tm = RD + 64 * 72;
    bf16x8 tf[4][2];
#pragma unroll
    for (int cb = 0; cb < 4; ++cb)
#pragma unroll
      for (int ks = 0; ks < 2; ++ks) tf[cb][ks] = lds_frag(Tm, 72, cb * 16, ks * 32, lane);
    u16* valt = reinterpret_cast<u16*>(p.ws + D_VALT) + (size_t)item * 8192;
#pragma unroll
    for (int ee = 0; ee < 2; ++ee) {
      int eb = 2 * w + ee;
      bf16x8 a0 = lds_frag(RC, 72, eb * 16, 0, lane), a1 = lds_frag(RC, 72, eb * 16, 32, lane);
#pragma unroll
      for (int cb = 0; cb < 4; ++cb) {
        f32x4 c = (f32x4){0.f, 0.f, 0.f, 0.f};
        c = mfma16(a0, tf[cb][0], c);
        c = mfma16(a1, tf[cb][1], c);
        *reinterpret_cast<uint2*>(valt + ((size_t)(eb * 4 + cb) * 64 + lane) * 4) = make_uint2(pack2(c[0], c[1]), pack2(c[2], c[3]));
      }
    }
#pragma unroll
    for (int dd = 0; dd < 2; ++dd) {
      int db = 2 * w + dd;
      bf16x8 b0 = lds_frag(RA, 72, db * 16, 0, lane), b1 = lds_frag(RA, 72, db * 16, 32, lane);
#pragma unroll
      for (int cb = 0; cb < 4; ++cb) {
        f32x4 c = (f32x4){0.f, 0.f, 0.f, 0.f};
        c = mfma16(tf[cb][0], b0, c);
        c = mfma16(tf[cb][1], b1, c);
#pragma unroll
        for (int j = 0; j < 4; ++j) RBk[(cb * 16 + 4 * lq + j) * 136 + db * 16 + lr] = f2bf(c[j]);
      }
    }
  }
  __syncthreads();
  store_frags(RBk, 136, 64, 128, reinterpret_cast<u16*>(p.ws + D_KCD) + (size_t)item * 8192, tid, NTHR);
  __syncthreads();
}

__device__ __forceinline__ void m1_hgrn_item(const Params& p, int item, char* smem) {
  const int tid = VTID, lane = tid & 63, w = tid >> 6, lr = lane & 15, lq = lane >> 4;
  const int h = item & 3, n = (item >> 2) & 63, b = item >> 8;
  const int t0 = b * 2048 + n * 32;
  u16* QG = reinterpret_cast<u16*>(smem);
  u16* QR = reinterpret_cast<u16*>(smem + 8704);
  u16* KR = reinterpret_cast<u16*>(smem + 17408);
  u16* KGT = reinterpret_cast<u16*>(smem + 26112);
  u16* VT = reinterpret_cast<u16*>(smem + 36352);
  float* tot = reinterpret_cast<float*>(smem + 46592);
  float* bls = tot + 128;
  const u16* Zp = reinterpret_cast<const u16*>(p.ws + Z1);
  const int e = tid & 127, half = tid >> 7;
  const int he = h * 128 + e;
  const float lb = sigmoid_f(p.lb_logits[he] - p.lb_logits[512 + he]);
  float q[16], k[16], bc[16];
  float run = 0.f;
#pragma unroll
  for (int i = 0; i < 16; ++i) {
    const u16* zr = Zp + (size_t)(t0 + half * 16 + i) * 3072;
    float qb = bf2f(zr[1536 + he]), fb = bf2f(zr[2048 + he]);
    float f = lb + (1.f - lb) * sigmoid_f(fb);
    run += __logf(f);
    q[i] = silu_f(qb); k[i] = 1.f - f; bc[i] = run;
    VT[e * 40 + half * 16 + i] = zr[2560 + he];
  }
  if (half == 0) tot[e] = run;
  __syncthreads();
  const float bref = tot[e];
  if (half == 1) {
#pragma unroll
    for (int i = 0; i < 16; ++i) bc[i] += bref;
    bls[e] = bc[15];
  }
  __syncthreads();
  const float bl = bls[e];
  if (half == 0) reinterpret_cast<float*>(p.ws + H_EBL)[(size_t)item * 128 + e] = __expf(bl);
#pragma unroll
  for (int i = 0; i < 16; ++i) {
    int r = half * 16 + i;
    QG[r * 136 + e] = f2bf(q[i] * __expf(bc[i]));
    QR[r * 136 + e] = f2bf(q[i] * __expf(bc[i] - bref));
    KR[r * 136 + e] = f2bf(k[i] * __expf(bref - bc[i]));
    KGT[e * 40 + r] = f2bf(k[i] * __expf(bl - bc[i]));
  }
  __syncthreads();
  {
    const int ib = w >> 1, jb = w & 1;
    f32x4 c = (f32x4){0.f, 0.f, 0.f, 0.f};
    if (jb <= ib) {
#pragma unroll
      for (int ks = 0; ks < 4; ++ks) c = mfma16(lds_frag(QR, 136, ib * 16, ks * 32, lane), lds_frag(KR, 136, jb * 16, ks * 32, lane), c);
    }
    u16* att = reinterpret_cast<u16*>(p.ws + H_ATT) + (size_t)item * 1024;
#pragma unroll
    for (int j = 0; j < 4; ++j) {
      int i = ib * 16 + 4 * lq + j, jj = jb * 16 + lr;
      float v = (i >= jj) ? c[j] : 0.f;
      att[(ib * 64 + (i & 15) + 16 * (jj >> 3)) * 8 + (jj & 7)] = f2bf(v);
    }
  }
  store_frags(QG, 136, 32, 128, reinterpret_cast<u16*>(p.ws + H_QG) + (size_t)item * 4096, tid, NTHR);
  store_frags(KGT, 40, 128, 32, reinterpret_cast<u16*>(p.ws + H_KGT) + (size_t)item * 4096, tid, NTHR);
  store_frags(VT, 40, 128, 32, reinterpret_cast<u16*>(p.ws + H_VT) + (size_t)item * 4096, tid, NTHR);
  __syncthreads();
}

struct DPre {
  bf16x8 kcd[4], q[4], att[2], knt[2][2];
  uint2 val[2];
  float gc, gl;
  float4 gi;
};
__device__ __forceinline__ void m2d_loadA(const Params& p, int base, int es, int w, int lane, DPre& d) {
  const int lr = lane & 15, lq = lane >> 4;
  const bf16x8* kcd = reinterpret_cast<const bf16x8*>(p.ws + D_KCD + (size_t)base * 16384);
  const uint2* val = reinterpret_cast<const uint2*>(p.ws + D_VALT + (size_t)base * 16384);
  const float* gc = reinterpret_cast<const float*>(p.ws + D_GC) + (size_t)base * 64;
#pragma unroll
  for (int ks = 0; ks < 4; ++ks) d.kcd[ks] = kcd[(w * 4 + ks) * 64 + lane];
#pragma unroll
  for (int eb = 0; eb < 2; ++eb) d.val[eb] = val[((es * 2 + eb) * 4 + w) * 64 + lane];
  d.gc = gc[w * 16 + lr];
  d.gl = gc[63];
  d.gi = *reinterpret_cast<const float4*>(gc + 16 * w + 4 * lq);
}
__device__ __forceinline__ void m2d_loadB(const Params& p, int base, int w, int lane, DPre& d) {
  const bf16x8* qf = reinterpret_cast<const bf16x8*>(p.ws + D_QF + (size_t)base * 16384);
  const bf16x8* att = reinterpret_cast<const bf16x8*>(p.ws + D_ATT + (size_t)base * 8192);
#pragma unroll
  for (int ks = 0; ks < 4; ++ks) d.q[ks] = qf[(w * 4 + ks) * 64 + lane];
#pragma unroll
  for (int ks = 0; ks < 2; ++ks) d.att[ks] = att[(w * 2 + ks) * 64 + lane];
}
__device__ __forceinline__ void m2d_loadC(const Params& p, int base, int w, int lane, DPre& d) {
  const bf16x8* knt = reinterpret_cast<const bf16x8*>(p.ws + D_KNT + (size_t)base * 16384);
#pragma unroll
  for (int ks = 0; ks < 2; ++ks) {
    d.knt[0][ks] = knt[((2 * w) * 2 + ks) * 64 + lane];
    d.knt[1][ks] = knt[((2 * w + 1) * 2 + ks) * 64 + lane];
  }
}

__device__ __forceinline__ void m2_delta_item(const Params& p, int item, char* smem) {
  const int tid = VTID, lane = tid & 63, w = tid >> 6, lr = lane & 15, lq = lane >> 4;
  const int es = item & 3, h = (item >> 2) & 3, b = item >> 4;
  u16* Sb = reinterpret_cast<u16*>(smem);
  u16* Ub = reinterpret_cast<u16*>(smem + 17408);
  u16* Usb = reinterpret_cast<u16*>(smem + 22016);
  for (int i = tid; i < 32 * 136; i += NTHR) Sb[i] = 0;
  f32x4 accS[2][2];
#pragma unroll
  for (int i = 0; i < 2; ++i)
#pragma unroll
    for (int j = 0; j < 2; ++j) accS[i][j] = (f32x4){0.f, 0.f, 0.f, 0.f};
  u16* OA = reinterpret_cast<u16*>(reinterpret_cast<char*>(p.out) + YB_OA);
  DPre cur;
  m2d_loadA(p, (b * 32 + 0) * 4 + h, es, w, lane, cur);
  m2d_loadB(p, (b * 32 + 0) * 4 + h, w, lane, cur);
  m2d_loadC(p, (b * 32 + 0) * 4 + h, w, lane, cur);
  __syncthreads();
  for (int n = 0; n < 32; ++n) {
    const int nbase = (b * 32 + (n + 1 < 32 ? n + 1 : n)) * 4 + h;
    const u16* Sc = Sb + (n & 1) * (32 * 136);
    u16* Sn = Sb + ((n + 1) & 1) * (32 * 136);
    f32x4 accP[2];
    accP[0] = (f32x4){0.f, 0.f, 0.f, 0.f}; accP[1] = accP[0];
#pragma unroll
    for (int ks = 0; ks < 4; ++ks) {
      accP[0] = mfma16(lds_frag(Sc, 136, 0, ks * 32, lane), cur.kcd[ks], accP[0]);
      accP[1] = mfma16(lds_frag(Sc, 136, 16, ks * 32, lane), cur.kcd[ks], accP[1]);
    }
    const float egc = __expf(cur.gl - cur.gc);
    const float egl = __expf(cur.gl);
    const float egi[4] = {__expf(cur.gi.x), __expf(cur.gi.y), __expf(cur.gi.z), __expf(cur.gi.w)};
    float vv[2][4];
#pragma unroll
    for (int eb = 0; eb < 2; ++eb) { vv[eb][0] = lo2f(cur.val[eb].x); vv[eb][1] = hi2f(cur.val[eb].x); vv[eb][2] = lo2f(cur.val[eb].y); vv[eb][3] = hi2f(cur.val[eb].y); }
    m2d_loadA(p, nbase, es, w, lane, cur);
#pragma unroll
    for (int eb = 0; eb < 2; ++eb) {
#pragma unroll
      for (int j = 0; j < 4; ++j) {
        float u = vv[eb][j] - accP[eb][j];
        int e = eb * 16 + 4 * lq + j, c = 16 * w + lr;
        Ub[e * 72 + c] = f2bf(u);
        Usb[e * 72 + c] = f2bf(u * egc);
      }
    }
    lds_barrier();
    {
      f32x4 accO[2];
      accO[0] = (f32x4){0.f, 0.f, 0.f, 0.f}; accO[1] = accO[0];
#pragma unroll
      for (int ks = 0; ks < 4; ++ks) {
        accO[0] = mfma16(cur.q[ks], lds_frag(Sc, 136, 0, ks * 32, lane), accO[0]);
        accO[1] = mfma16(cur.q[ks], lds_frag(Sc, 136, 16, ks * 32, lane), accO[1]);
      }
#pragma unroll
      for (int eb = 0; eb < 2; ++eb)
#pragma unroll
        for (int j = 0; j < 4; ++j) accO[eb][j] *= egi[j];
#pragma unroll
      for (int ks = 0; ks < 2; ++ks) {
        accO[0] = mfma16(cur.att[ks], lds_frag(Ub, 72, 0, ks * 32, lane), accO[0]);
        accO[1] = mfma16(cur.att[ks], lds_frag(Ub, 72, 16, ks * 32, lane), accO[1]);
      }
      m2d_loadB(p, nbase, w, lane, cur);
#pragma unroll
      for (int eb = 0; eb < 2; ++eb)
#pragma unroll
        for (int j = 0; j < 4; ++j) {
          int tok = b * 2048 + n * 64 + 16 * w + 4 * lq + j;
          OA[(size_t)tok * 512 + h * 128 + es * 32 + eb * 16 + lr] = f2bf(accO[eb][j]);
        }
    }
    {
#pragma unroll
      for (int eb = 0; eb < 2; ++eb) {
        bf16x8 a0 = lds_frag(Usb, 72, eb * 16, 0, lane), a1 = lds_frag(Usb, 72, eb * 16, 32, lane);
#pragma unroll
        for (int dd = 0; dd < 2; ++dd) {
#pragma unroll
          for (int j = 0; j < 4; ++j) accS[eb][dd][j] *= egl;
          accS[eb][dd] = mfma16(a0, cur.knt[dd][0], accS[eb][dd]);
          accS[eb][dd] = mfma16(a1, cur.knt[dd][1], accS[eb][dd]);
#pragma unroll
          for (int j = 0; j < 4; ++j) Sn[(eb * 16 + 4 * lq + j) * 136 + (2 * w + dd) * 16 + lr] = f2bf(accS[eb][dd][j]);
        }
      }
    }
    m2d_loadC(p, nbase, w, lane, cur);
    lds_barrier();
  }
  float* outp = p.out + O_DELTAP + (size_t)(b * 4 + h) * 16384;
#pragma unroll
  for (int eb = 0; eb < 2; ++eb)
#pragma unroll
    for (int dd = 0; dd < 2; ++dd) {
      int d = (2 * w + dd) * 16 + lr, e0 = es * 32 + eb * 16 + 4 * lq;
      *reinterpret_cast<float4*>(outp + (size_t)d * 128 + e0) =
          make_float4(accS[eb][dd][0], accS[eb][dd][1], accS[eb][dd][2], accS[eb][dd][3]);
    }
  __syncthreads();
}

struct HPre {
  bf16x8 qg[4], att, vt[2], kgt[2];
  float ebl[2];
};
__device__ __forceinline__ HPre m2h_load(const Params& p, int base, int vs, int w, int lane) {
  HPre d;
  const int lr = lane & 15;
  const bf16x8* qg = reinterpret_cast<const bf16x8*>(p.ws + H_QG + (size_t)base * 8192);
  const bf16x8* att = reinterpret_cast<const bf16x8*>(p.ws + H_ATT + (size_t)base * 2048);
  const bf16x8* vt = reinterpret_cast<const bf16x8*>(p.ws + H_VT + (size_t)base * 8192);
  const bf16x8* kgt = reinterpret_cast<const bf16x8*>(p.ws + H_KGT + (size_t)base * 8192);
  const float* ebl = reinterpret_cast<const float*>(p.ws + H_EBL) + (size_t)base * 128;
  const int ib = w >> 1;
#pragma unroll
  for (int ks = 0; ks < 4; ++ks) d.qg[ks] = qg[(ib * 4 + ks) * 64 + lane];
  d.att = att[ib * 64 + lane];
  d.vt[0] = vt[(vs * 2 + 0) * 64 + lane];
  d.vt[1] = vt[(vs * 2 + 1) * 64 + lane];
  d.kgt[0] = kgt[(2 * w) * 64 + lane];
  d.kgt[1] = kgt[(2 * w + 1) * 64 + lane];
  d.ebl[0] = ebl[(2 * w) * 16 + lr];
  d.ebl[1] = ebl[(2 * w + 1) * 16 + lr];
  return d;
}

__device__ __forceinline__ void m2_hgrn_item(const Params& p, int item, char* smem) {
  const int tid = VTID, lane = tid & 63, w = tid >> 6, lr = lane & 15, lq = lane >> 4;
  const int vs = item & 3, h = (item >> 2) & 3, b = item >> 4;
  u16* Sb = reinterpret_cast<u16*>(smem);
  for (int i = tid; i < 32 * 136; i += NTHR) Sb[i] = 0;
  f32x4 accS[2][2];
#pragma unroll
  for (int i = 0; i < 2; ++i)
#pragma unroll
    for (int j = 0; j < 2; ++j) accS[i][j] = (f32x4){0.f, 0.f, 0.f, 0.f};
  u16* OB = reinterpret_cast<u16*>(reinterpret_cast<char*>(p.out) + YB_OB);
  const int ib = w >> 1, vb = w & 1;
  HPre cur = m2h_load(p, (b * 64 + 0) * 4 + h, vs, w, lane), nxt = cur;
  __syncthreads();
  for (int n = 0; n < 64; ++n) {
    if (n + 1 < 64) nxt = m2h_load(p, (b * 64 + n + 1) * 4 + h, vs, w, lane);
    const u16* Sc = Sb + (n & 1) * (32 * 136);
    u16* Sn = Sb + ((n + 1) & 1) * (32 * 136);
    {
      f32x4 o = (f32x4){0.f, 0.f, 0.f, 0.f};
#pragma unroll
      for (int ks = 0; ks < 4; ++ks) o = mfma16(cur.qg[ks], lds_frag(Sc, 136, vb * 16, ks * 32, lane), o);
      o = mfma16(cur.att, vb ? cur.vt[1] : cur.vt[0], o);
#pragma unroll
      for (int j = 0; j < 4; ++j) {
        int tok = b * 2048 + n * 32 + ib * 16 + 4 * lq + j;
        OB[(size_t)tok * 512 + h * 128 + vs * 32 + vb * 16 + lr] = f2bf(o[j]);
      }
    }
#pragma unroll
    for (int v2 = 0; v2 < 2; ++v2)
#pragma unroll
      for (int dd = 0; dd < 2; ++dd) {
#pragma unroll
        for (int j = 0; j < 4; ++j) accS[v2][dd][j] *= cur.ebl[dd];
        accS[v2][dd] = mfma16(cur.vt[v2], cur.kgt[dd], accS[v2][dd]);
#pragma unroll
        for (int j = 0; j < 4; ++j) Sn[(v2 * 16 + 4 * lq + j) * 136 + (2 * w + dd) * 16 + lr] = f2bf(accS[v2][dd][j]);
      }
    lds_barrier();
    cur = nxt;
  }
  float* outp = p.out + O_HGRNP + (size_t)(b * 4 + h) * 16384;
#pragma unroll
  for (int v2 = 0; v2 < 2; ++v2)
#pragma unroll
    for (int dd = 0; dd < 2; ++dd) {
      int e = (2 * w + dd) * 16 + lr, v0 = vs * 32 + v2 * 16 + 4 * lq;
      *reinterpret_cast<float4*>(outp + (size_t)e * 128 + v0) =
          make_float4(accS[v2][dd][0], accS[v2][dd][1], accS[v2][dd][2], accS[v2][dd][3]);
    }
  __syncthreads();
}

__device__ __forceinline__ void ms_delta_item(const Params& p, int item, char* smem) {
  const int tid = VTID, lane = tid & 63, w = tid >> 6;
  const int h = item & 3, b = item >> 2;
  const int R0 = TP + b * 4;
  float* qkv = reinterpret_cast<float*>(smem);
  float* red = reinterpret_cast<float*>(smem + 6144);
  const u16* Zp = reinterpret_cast<const u16*>(p.ws + Z1);
  for (int c = tid; c < 384; c += NTHR) {
    int col = c < 128 ? h * 128 + c : (c < 256 ? 512 + h * 128 + c - 128 : 1024 + h * 128 + c - 256);
    float xs[7];
#pragma unroll
    for (int j = 0; j < 3; ++j) xs[j] = p.cache_conv[(size_t)(b * 3 + j) * 1536 + col];
#pragma unroll
    for (int t = 0; t < 4; ++t) xs[3 + t] = bf2f(Zp[(size_t)(R0 + t) * 3072 + col]);
    float wc[4];
#pragma unroll
    for (int j = 0; j < 4; ++j) wc[j] = p.w_conv_a[j * 1536 + col];
#pragma unroll
    for (int t = 0; t < 4; ++t) {
      float y = xs[t] * wc[0] + xs[t + 1] * wc[1] + xs[t + 2] * wc[2] + xs[t + 3] * wc[3];
      qkv[t * 384 + c] = silu_f(y);
    }
  }
  __syncthreads();
  {
    const int t = w;
    float q0 = qkv[t * 384 + lane], q1 = qkv[t * 384 + 64 + lane];
    float k0 = qkv[t * 384 + 128 + lane], k1 = qkv[t * 384 + 192 + lane];
    float qs = wave_sum(q0 * q0 + q1 * q1), ks = wave_sum(k0 * k0 + k1 * k1);
    float qn = rsqrtf(qs + EPS) * 0.08838834764831845f, kn = rsqrtf(ks + EPS);
    qkv[t * 384 + lane] = q0 * qn; qkv[t * 384 + 64 + lane] = q1 * qn;
    qkv[t * 384 + 128 + lane] = k0 * kn; qkv[t * 384 + 192 + lane] = k1 * kn;
  }
  __syncthreads();
  const int e = tid & 127, dh = tid >> 7;
  float S[64];
  const float* s0 = p.state_delta + (size_t)(b * 4 + h) * 16384 + (size_t)(dh * 64) * 128 + e;
#pragma unroll
  for (int dd = 0; dd < 64; ++dd) S[dd] = s0[(size_t)dd * 128];
  const float* gdec = reinterpret_cast<const float*>(p.ws + SM_GDEC);
  const float* betap = reinterpret_cast<const float*>(p.ws + SM_BETA);
  u16* OA = reinterpret_cast<u16*>(reinterpret_cast<char*>(p.out) + YB_OA);
  for (int t = 0; t < 4; ++t) {
    const float a = __expf(gdec[(size_t)(R0 + t) * 4 + h]), bt = betap[(size_t)(R0 + t) * 4 + h];
    const float* qv = qkv + t * 384 + dh * 64;
    const float* kv = qkv + t * 384 + 128 + dh * 64;
    float rp = 0.f;
#pragma unroll
    for (int dd = 0; dd < 64; ++dd) rp += S[dd] * kv[dd];
    red[((t * 2 + 0) * 2 + dh) * 128 + e] = rp;
    __syncthreads();
    float r = a * (red[((t * 2 + 0) * 2 + 0) * 128 + e] + red[((t * 2 + 0) * 2 + 1) * 128 + e]);
    float u = bt * (qkv[t * 384 + 256 + e] - r);
    float op = 0.f;
#pragma unroll
    for (int dd = 0; dd < 64; ++dd) {
      S[dd] = a * S[dd] + kv[dd] * u;
      op += S[dd] * qv[dd];
    }
    red[((t * 2 + 1) * 2 + dh) * 128 + e] = op;
    __syncthreads();
    if (dh == 0) {
      float o = red[((t * 2 + 1) * 2 + 0) * 128 + e] + red[((t * 2 + 1) * 2 + 1) * 128 + e];
      OA[(size_t)(R0 + t) * 512 + h * 128 + e] = f2bf(o);
    }
  }
  float* so = p.out + O_DELTAS + (size_t)(b * 4 + h) * 16384 + (size_t)(dh * 64) * 128 + e;
#pragma unroll
  for (int dd = 0; dd < 64; ++dd) so[(size_t)dd * 128] = S[dd];
  __syncthreads();
}

__device__ __forceinline__ void ms_hgrn_item(const Params& p, int item, char* smem) {
  const int tid = VTID;
  const int h = item & 3, b = item >> 2;
  const int R0 = TP + b * 4;
  float* qs = reinterpret_cast<float*>(smem);
  float* fs = qs + 512;
  float* vsm = fs + 512;
  float* red = vsm + 512;
  const u16* Zp = reinterpret_cast<const u16*>(p.ws + Z1);
  for (int i = tid; i < 512; i += NTHR) {
    int t = i >> 7, e = i & 127, he = h * 128 + e;
    const u16* zr = Zp + (size_t)(R0 + t) * 3072;
    float lb = sigmoid_f(p.lb_logits[he] - p.lb_logits[512 + he]);
    qs[i] = silu_f(bf2f(zr[1536 + he]));
    fs[i] = lb + (1.f - lb) * sigmoid_f(bf2f(zr[2048 + he]));
    vsm[i] = bf2f(zr[2560 + he]);
  }
  __syncthreads();
  const int v = tid & 127, eh = tid >> 7;
  float S[64];
  const float* s0 = p.state_hgrn + (size_t)(b * 4 + h) * 16384 + (size_t)(eh * 64) * 128 + v;
#pragma unroll
  for (int ee = 0; ee < 64; ++ee) S[ee] = s0[(size_t)ee * 128];
  u16* OB = reinterpret_cast<u16*>(reinterpret_cast<char*>(p.out) + YB_OB);
  for (int t = 0; t < 4; ++t) {
    const float vv = vsm[t * 128 + v];
    const float* ft = fs + t * 128 + eh * 64;
    const float* qt = qs + t * 128 + eh * 64;
    float op = 0.f;
#pragma unroll
    for (int ee = 0; ee < 64; ++ee) {
      float f = ft[ee];
      S[ee] = f * S[ee] + (1.f - f) * vv;
      op += S[ee] * qt[ee];
    }
    red[(t * 2 + eh) * 128 + v] = op;
    __syncthreads();
    if (eh == 0) OB[(size_t)(R0 + t) * 512 + h * 128 + v] = f2bf(red[(t * 2) * 128 + v] + red[(t * 2 + 1) * 128 + v]);
  }
  float* so = p.out + O_HGRNS + (size_t)(b * 4 + h) * 16384 + (size_t)(eh * 64) * 128 + v;
#pragma unroll
  for (int ee = 0; ee < 64; ++ee) so[(size_t)ee * 128] = S[ee];
  __syncthreads();
}

__device__ __forceinline__ void ffn_weight_chunks(const Params& p, float* tl, int v0, int nv) {
  for (int item = v0; item < 704 + 352; item += nv) {
    if (item < 704) {
      int blk = item >> 2, k0 = (item & 3) * 256;
      int grp = blk >> 3, sub = blk & 7, up = sub >> 2;
      wt_chunk((up ? p.w_ffn_up : p.w_ffn_gate) + grp * 128 + (sub & 3) * 32, DFF, 1024,
               reinterpret_cast<u16*>(p.ws + W_GU) + (size_t)blk * 32 * 1024, p.g_ffn, tl, k0);
    } else {
      int q = item - 704;
      int n = (q / 11) * 32, k0 = (q % 11) * 256;
      wt_chunk(p.w_ffn_down + n, 1024, DFF, reinterpret_cast<u16*>(p.ws + W_DOWN) + (size_t)n * DFF, nullptr, tl, k0);
    }
  }
}

__device__ __forceinline__ void phase_m3(const Params& p, char* smem, int bid, int nb) {
  const int tid = VTID, lane = tid & 63, w = tid >> 6;
  float* tl = reinterpret_cast<float*>(smem);
  const int NWT = 0;
  const int NTASK = (2 * TT) / 4;
  for (int item = bid; item < NWT + NTASK; item += nb) {
    {
      int task = (item - NWT) * 4 + w;
      int tok = task >> 1, br = task & 1;
      u16* o = reinterpret_cast<u16*>(reinterpret_cast<char*>(p.out) + (br ? YB_OB : YB_OA)) + (size_t)tok * 512 + lane * 8;
      const u16* og = z2row(p, tok) + 2048 + br * 512 + lane * 8;
      const float* g = (br ? p.g_out_b : p.g_out_a) + (lane & 15) * 8;
      uint4 ov = *reinterpret_cast<const uint4*>(o), gv = *reinterpret_cast<const uint4*>(og);
      unsigned oo[4] = {ov.x, ov.y, ov.z, ov.w}, gg[4] = {gv.x, gv.y, gv.z, gv.w};
      float x[8], y[8];
#pragma unroll
      for (int j = 0; j < 4; ++j) { x[2 * j] = lo2f(oo[j]); x[2 * j + 1] = hi2f(oo[j]); y[2 * j] = lo2f(gg[j]); y[2 * j + 1] = hi2f(gg[j]); }
      float ss = 0.f;
#pragma unroll
      for (int j = 0; j < 8; ++j) ss += x[j] * x[j];
      DPP_ADD(ss, 0xB1, 0xf); DPP_ADD(ss, 0x4E, 0xf); DPP_ADD(ss, 0x141, 0xf); DPP_ADD(ss, 0x140, 0xf);
      float rstd = rsqrtf(ss * (1.f / 128.f) + EPS);
      unsigned r[4];
#pragma unroll
      for (int j = 0; j < 4; ++j)
        r[j] = pack2(x[2 * j] * rstd * g[2 * j] * silu_f(y[2 * j]), x[2 * j + 1] * rstd * g[2 * j + 1] * silu_f(y[2 * j + 1]));
      *reinterpret_cast<uint4*>(o) = make_uint4(r[0], r[1], r[2], r[3]);
    }
  }
}

__device__ __forceinline__ void phase_fixup(const Params& p, int bid, int nb) {
  const float* haloG = reinterpret_cast<const float*>(p.ws + HALO_G);
  const float* headG = reinterpret_cast<const float*>(p.ws + HEAD_G);
  const float* headU = reinterpret_cast<const float*>(p.ws + HEAD_U);
  u16* ACTp = reinterpret_cast<u16*>(p.ws + ACT);
  const int total = 256 * 2 * DFF;
  for (int i = bid * NTHR + VTID; i < total; i += nb * NTHR) {
    int ch = i % DFF, rr = (i / DFF) & 1, blk = i / (2 * DFF);
    if ((blk & 31) == 0) continue;
    float g0 = headG[(size_t)(blk * 2 + rr) * DFF + ch], u = headU[(size_t)(blk * 2 + rr) * DFF + ch];
    float gm1, gm2;
    if (rr == 0) { gm1 = haloG[(size_t)((blk - 1) * 2 + 1) * DFF + ch]; gm2 = haloG[(size_t)((blk - 1) * 2 + 0) * DFF + ch]; }
    else { gm1 = headG[(size_t)(blk * 2 + 0) * DFF + ch]; gm2 = haloG[(size_t)((blk - 1) * 2 + 1) * DFF + ch]; }
    float gc = p.w_ffn_conv[ch] * gm2 + p.w_ffn_conv[DFF + ch] * gm1 + p.w_ffn_conv[2 * DFF + ch] * g0;
    ACTp[(size_t)(blk * 64 + rr) * DFF + ch] = f2bf(silu_f(gc) * u);
  }
}

__device__ __forceinline__ void phase_final(const Params& p, int bid, int nb) {
  const int tid = VTID, lane = tid & 63, w = tid >> 6;
  for (int row = bid * 4 + w; row < TP; row += nb * 8) {
    const int rowB = row + nb * 4;
    const bool hasB = rowB < TP;
    float* ya = p.out + O_YP + (size_t)row * DM;
    float* yb = p.out + O_YP + (size_t)(hasB ? rowB : row) * DM;
    float4 xa[4], xb[4];
#pragma unroll
    for (int i = 0; i < 4; ++i) xa[i] = *reinterpret_cast<const float4*>(ya + i * 256 + lane * 4);
#pragma unroll
    for (int i = 0; i < 4; ++i) xb[i] = *reinterpret_cast<const float4*>(yb + i * 256 + lane * 4);
    float sa = 0.f, sb = 0.f;
#pragma unroll
    for (int i = 0; i < 4; ++i) {
      sa += xa[i].x * xa[i].x + xa[i].y * xa[i].y + xa[i].z * xa[i].z + xa[i].w * xa[i].w;
      sb += xb[i].x * xb[i].x + xb[i].y * xb[i].y + xb[i].z * xb[i].z + xb[i].w * xb[i].w;
    }
    sa = wave_sum(sa); sb = wave_sum(sb);
    const float ra = rsqrtf(sa * (1.f / DM) + EPS), rb = rsqrtf(sb * (1.f / DM) + EPS);
#pragma unroll
    for (int i = 0; i < 4; ++i) {
      float4 g = *reinterpret_cast<const float4*>(p.g_final + i * 256 + lane * 4);
      *reinterpret_cast<float4*>(ya + i * 256 + lane * 4) = make_float4(xa[i].x * ra * g.x, xa[i].y * ra * g.y, xa[i].z * ra * g.z, xa[i].w * ra * g.w);
      if (hasB) *reinterpret_cast<float4*>(yb + i * 256 + lane * 4) = make_float4(xb[i].x * rb * g.x, xb[i].y * rb * g.y, xb[i].z * rb * g.z, xb[i].w * rb * g.w);
    }
  }
  for (int row = TP + bid * 4 + w; row < TT; row += nb * 4) {
    float* y = p.out + O_YP + (size_t)row * DM;
    float4 xv[4];
    float ss = 0.f;
    const float* part = reinterpret_cast<const float*>(p.ws + PART) + (size_t)(row - TP) * 1024;
#pragma unroll
    for (int i = 0; i < 4; ++i) {
      xv[i] = *reinterpret_cast<const float4*>(y + i * 256 + lane * 4);
      for (int ks = 0; ks < 11; ++ks) {
        float4 pv = *reinterpret_cast<const float4*>(part + (size_t)ks * TS * 1024 + i * 256 + lane * 4);
        xv[i].x += pv.x; xv[i].y += pv.y; xv[i].z += pv.z; xv[i].w += pv.w;
      }
      ss += xv[i].x * xv[i].x + xv[i].y * xv[i].y + xv[i].z * xv[i].z + xv[i].w * xv[i].w;
    }
    ss = wave_sum(ss);
    float rstd = rsqrtf(ss * (1.f / DM) + EPS);
#pragma unroll
    for (int i = 0; i < 4; ++i) {
      float4 g = *reinterpret_cast<const float4*>(p.g_final + i * 256 + lane * 4);
      *reinterpret_cast<float4*>(y + i * 256 + lane * 4) =
          make_float4(xv[i].x * rstd * g.x, xv[i].y * rstd * g.y, xv[i].z * rstd * g.z, xv[i].w * rstd * g.w);
    }
  }
}

constexpr int NPHASE = 13;
__device__ __forceinline__ void run_phase(const Params& p, int ph, char* smem_all) {
  int half = threadIdx.x >> 8;
  asm volatile("" : "+v"(half));
  const int bid = blockIdx.x * 2 + half, nb = gridDim.x * 2;
  char* smem = smem_all + half * SMEM_HALF;
  LAS unsigned char* lds = (LAS unsigned char*)smem_all;
  const u16* HB = reinterpret_cast<const u16*>(reinterpret_cast<const char*>(p.out) + YB_H);
  switch (ph) {
    case 0: phase_prep(p, smem, bid, nb, 0); break;
    case 1: {
      { pg8::SchedStatic S; S.init(TS, 3072, 24, (int)blockIdx.x, 64);
        gemm_phase8<EPI_Z1>(p, HB, reinterpret_cast<const u16*>(p.ws + W_MAIN), 1024, 1024, lds, S); }
      phase_prep(p, smem, bid, nb, 1);
    } break;
    case 2: { pg8::SchedStatic S; S.init(TP, 3072, (int)gridDim.x, (int)blockIdx.x, 0); gemm_phase8<EPI_Z1>(p, HB, reinterpret_cast<const u16*>(p.ws + W_MAIN), 1024, 1024, lds, S); } break;
    case 3:
      for (int it = bid; it < 1024; it += nb) m1_delta_item(p, it, smem);
      for (int it = bid; it < 2048; it += nb) m1_hgrn_item(p, it, smem);
      break;
    case 4: {
      const int g = blockIdx.x;
      if (g < 128) {
        const int gg = g & 63, xcd = gg & 7, j = gg >> 3;
        const int q = xcd + 8 * (j >> 1), es = 2 * (j & 1) + half;
        if (g < 64) m2_delta_item(p, q * 4 + es, smem); else m2_hgrn_item(p, q * 4 + es, smem);
      } else {
        const int nrest = (gridDim.x - 128) * 2, v0 = (g - 128) * 2 + half;
        for (int it = v0; it < 1024; it += nrest) {
          if (it < 512) ms_delta_item(p, it, smem); else ms_hgrn_item(p, it - 512, smem);
        }
        __syncthreads();
        { pg8::SchedStatic S; S.init(TS, 3072, 24, g - 128, 64);
          gemm_phase8<EPI_Z2>(p, HB, reinterpret_cast<const u16*>(p.ws + W_G2), 1024, 1024, lds, S); }
        __syncthreads();
        ffn_weight_chunks(p, reinterpret_cast<float*>(smem), v0, nrest);
      }
    } break;
    case 5: { pg8::SchedStatic S; S.init(TP, 3072, (int)gridDim.x, (int)blockIdx.x, 0); gemm_phase8<EPI_Z2>(p, HB, reinterpret_cast<const u16*>(p.ws + W_G2), 1024, 1024, lds, S); } break;
    case 6: phase_m3(p, smem, bid, nb); break;
    case 7: {
      const u16* OA = reinterpret_cast<const u16*>(reinterpret_cast<const char*>(p.out) + YB_OA);
      const u16* OB = reinterpret_cast<const u16*>(reinterpret_cast<const char*>(p.out) + YB_OB);
      { pg8::SchedStatic S; S.init(TT, 1024, (int)gridDim.x, (int)blockIdx.x, 0); gemm_phase8<EPI_MIXA>(p, OA, reinterpret_cast<const u16*>(p.ws + W_A), 512, 512, lds, S);
      gemm_phase8<EPI_MIXB>(p, OB, reinterpret_cast<const u16*>(p.ws + W_B), 512, 512, lds, S); }
    } break;
    case 8: { pg8::SchedStatic S; S.init(TT, 1024, (int)gridDim.x, (int)blockIdx.x, 0); gemm_phase8<EPI_WOUT>(p, reinterpret_cast<const u16*>(p.ws + MIX), reinterpret_cast<const u16*>(p.ws + W_OUT), 1024, 1024, lds, S); } break;
    case 9: {
      { pg8::SchedStatic S; S.init(TP, 5632, (int)gridDim.x, (int)blockIdx.x, 0);
        gemm_phase8<EPI_FFN1>(p, reinterpret_cast<const u16*>(p.ws + X1B), reinterpret_cast<const u16*>(p.ws + W_GU), 1024, 1024, lds, S); }
      { pg8::SchedStatic S; S.init(TS, 5632, (int)gridDim.x, (int)gridDim.x - 1 - (int)blockIdx.x, 64);
        gemm_phase8<EPI_FFN1S>(p, reinterpret_cast<const u16*>(p.ws + X1B), reinterpret_cast<const u16*>(p.ws + W_GU), 1024, 1024, lds, S); }
    } break;
    case 10: phase_fixup(p, bid, nb); break;
    case 11: {
      { pg8::SchedStatic S; S.init(TP, 1024, (int)gridDim.x, (int)blockIdx.x, 0);
        gemm_phase8<EPI_FFN2>(p, reinterpret_cast<const u16*>(p.ws + ACT), reinterpret_cast<const u16*>(p.ws + W_DOWN), DFF, DFF, lds, S); }
      { pg8::SchedSplit S; S.init(2, 4, 11, (int)gridDim.x, (int)blockIdx.x, 64);
        gemm_phase8<EPI_FFN2S>(p, reinterpret_cast<const u16*>(p.ws + ACT), reinterpret_cast<const u16*>(p.ws + W_DOWN), DFF, 256, lds, S); }
    } break;
    case 12: phase_final(p, bid, nb); break;
  }
}

__global__ void __launch_bounds__(512, 2) k_main(Params p, int ph0, int ph1) {
  extern __shared__ __attribute__((aligned(16))) char smem[];
  volatile LAS unsigned* xst = (volatile LAS unsigned*)(smem + 2 * SMEM_HALF);
  if (threadIdx.x == 0) { xst[0] = 0u; xst[1] = 0u; }
  __syncthreads();
  XcdBarrier xb = xcd_barrier_post(reinterpret_cast<unsigned*>(p.ws + BAR_OFF), xst);
  if (ph1 < 0) cg::this_grid().sync();
#define PHASE_STEP(N)                                        \
  if (ph0 <= N && N < ph1) run_phase(p, N, smem);            \
  if (ph0 <= N && N + 1 < ph1) xcd_barrier(xb);
  PHASE_STEP(0) PHASE_STEP(1) PHASE_STEP(2) PHASE_STEP(3) PHASE_STEP(4) PHASE_STEP(5)
  PHASE_STEP(6) PHASE_STEP(7) PHASE_STEP(8) PHASE_STEP(9) PHASE_STEP(10) PHASE_STEP(11) PHASE_STEP(12)
#undef PHASE_STEP
}

extern "C" void kernel_launch(void* const* d_in, const int* in_sizes, int n_in, void* d_out, int out_size, void* d_ws,
                              size_t ws_size, hipStream_t stream) {
  static int grid_blocks = 0;
  if (!grid_blocks) {
    hipFuncSetAttribute((const void*)k_main, hipFuncAttributeMaxDynamicSharedMemorySize, SMEM_BYTES);
    int dev = 0, cus = 0, per_cu = 0;
    hipGetDevice(&dev);
    hipDeviceGetAttribute(&cus, hipDeviceAttributeMultiprocessorCount, dev);
    hipOccupancyMaxActiveBlocksPerMultiprocessor(&per_cu, k_main, 512, SMEM_BYTES);
    if (per_cu > 1) per_cu = 1;
    if (per_cu < 1) per_cu = 1;
    grid_blocks = cus * per_cu;
  }
  Params p{};
  const float** f = reinterpret_cast<const float**>(&p);
  for (int i = 0; i < 23; ++i) f[i] = reinterpret_cast<const float*>(d_in[i]);
  p.out = reinterpret_cast<float*>(d_out);
  p.ws = reinterpret_cast<char*>(d_ws);
  if (ws_size < WS_NEED) fprintf(stderr, "workspace too small: %zu < %zu\n", ws_size, (size_t)WS_NEED);
  hipMemsetAsync(p.ws + BAR_OFF, 0, 16384, stream);
#if MULTI_LAUNCH
  for (int ph = 0; ph < NPHASE; ++ph) {
    hipLaunchKernelGGL(k_main, dim3(grid_blocks), dim3(512), SMEM_BYTES, stream, p, ph, ph + 1);
  }
#else
  int ph0 = 0, ph1 = NPHASE;
  void* args[] = {&p, &ph0, &ph1};
  hipError_t e = hipLaunchCooperativeKernel((void*)k_main, dim3(grid_blocks), dim3(512), args, SMEM_BYTES, stream);
  if (e != hipSuccess) fprintf(stderr, "cooperative launch failed: %s (grid %d)\n", hipGetErrorString(e), grid_blocks);
#endif
}
```
